# Optimizing an MI355X kernel written in HIP

```python
import math
import jax, jax.numpy as jnp
from jax import lax
import numpy as np

D_MODEL = 1024
BATCH = 4
SEQ = 4096
DEPTH = 2

GRID_W = 64
N_HEADS = 16
N_KV_HEADS = 4
HEAD_DIM = D_MODEL // N_HEADS
GROUP = N_HEADS // N_KV_HEADS
Q_BLOCK = 128
ROPE_THETA = 10000.0
ATTN_QKV = N_HEADS * HEAD_DIM + 2 * N_KV_HEADS * HEAD_DIM
GLA_HEADS = 4
GLA_DK = D_MODEL // 2 // GLA_HEADS
GLA_DV = D_MODEL // GLA_HEADS
GLA_QK = GLA_HEADS * GLA_DK
GLA_V = GLA_HEADS * GLA_DV
GATE_RANK = 16
GATE_TAU = 16.0
GLA_CHUNK = 64
GLA_IN = 2 * GLA_QK + 2 * GLA_V + 2 * GATE_RANK
D_FF = 4 * D_MODEL
N_MIXERS = 2
N_ATTN = (DEPTH + 1) // 2
N_GLA = DEPTH // 2
EPS = 1e-6

kernel_name = 'hybrid_gqa_axialrope_bigla_sqrelu'


def rmsnorm(x, g):
    x32 = x.astype(jnp.float32)
    y = x32 * lax.rsqrt(jnp.mean(x32 * x32, axis=-1, keepdims=True) + EPS)
    return (y * g.astype(jnp.float32)).astype(x.dtype)


def rope_angles(pos, dim):
    inv = ROPE_THETA ** (-jnp.arange(0, dim, 2, dtype=jnp.float32) / dim)
    ang = pos.astype(jnp.float32)[:, None] * inv[None, :]
    return jnp.cos(ang), jnp.sin(ang)


def apply_rot(x, cos, sin):
    half = x.shape[-1] // 2
    x32 = x.astype(jnp.float32)
    x1, x2 = x32[..., :half], x32[..., half:]
    c = cos[None, :, None, :]
    s = sin[None, :, None, :]
    return jnp.concatenate([x1 * c - x2 * s, x2 * c + x1 * s], axis=-1).astype(x.dtype)


def axial_rope(x, rope):
    cr, sr, cc, sc = rope
    half = HEAD_DIM // 2
    return jnp.concatenate([apply_rot(x[..., :half], cr, sr), apply_rot(x[..., half:], cc, sc)], axis=-1)


def attention_mixer(h, w_qkv, q_g, k_g, w_o, rope):
    B, S, _ = h.shape
    qkv = h @ w_qkv
    q, k, v = jnp.split(qkv, [N_HEADS * HEAD_DIM, (N_HEADS + N_KV_HEADS) * HEAD_DIM], axis=-1)
    q = rmsnorm(q.reshape(B, S, N_HEADS, HEAD_DIM), q_g)
    k = rmsnorm(k.reshape(B, S, N_KV_HEADS, HEAD_DIM), k_g)
    v = v.reshape(B, S, N_KV_HEADS, HEAD_DIM)
    q = axial_rope(q, rope)
    k = axial_rope(k, rope)
    n_blk = S // Q_BLOCK
    qb = jnp.moveaxis(q.reshape(B, n_blk, Q_BLOCK, N_KV_HEADS, GROUP, HEAD_DIM), 1, 0)
    scale = 1.0 / math.sqrt(HEAD_DIM)

    def block(qblk):
        s = jnp.einsum('bqhgd,bkhd->bhgqk', qblk, k, preferred_element_type=jnp.float32) * scale
        p = jax.nn.softmax(s, axis=-1).astype(v.dtype)
        return jnp.einsum('bhgqk,bkhd->bqhgd', p, v)

    o = lax.map(block, qb)
    o = jnp.moveaxis(o, 0, 1).reshape(B, S, N_HEADS * HEAD_DIM)
    return o @ w_o


def gla_chunked(q, k, v, logg):
    B, S, H, DK = q.shape
    DV = v.shape[-1]
    N = S // GLA_CHUNK
    to_c = lambda t: t.reshape(B, N, GLA_CHUNK, H, t.shape[-1]).transpose(0, 3, 1, 2, 4)
    q, k, v, logg = to_c(q), to_c(k), to_c(v), to_c(logg)
    b = jnp.cumsum(logg, axis=3)
    qe = q * jnp.exp(b)
    ke = k * jnp.exp(-b)
    mask = jnp.tril(jnp.ones((GLA_CHUNK, GLA_CHUNK), dtype=bool))
    a = jnp.einsum('bhncd,bhnjd->bhncj', qe, ke)
    a = jnp.where(mask, a, 0.0)
    o_intra = jnp.einsum('bhncj,bhnjv->bhncv', a, v)
    b_last = b[..., -1:, :]
    kd = k * jnp.exp(b_last - b)
    chunk_kv = jnp.einsum('bhncd,bhncv->bhndv', kd, v)
    decay = jnp.exp(b_last[..., 0, :])

    def step(state, inp):
        dec, ckv = inp
        return dec[..., None] * state + ckv, state

    init = jnp.zeros((B, H, DK, DV), jnp.float32)
    _, s_before = lax.scan(step, init, (jnp.moveaxis(decay, 2, 0), jnp.moveaxis(chunk_kv, 2, 0)))
    s_before = jnp.moveaxis(s_before, 0, 2)
    o = o_intra + jnp.einsum('bhncd,bhndv->bhncv', qe, s_before)
    return o.transpose(0, 2, 3, 1, 4).reshape(B, S, H, DV)


def gla_mixer(h, w_in, w_gate_up, b_gate, out_g, w_o):
    B, S, _ = h.shape
    f32 = jnp.float32
    proj = h @ w_in
    q, k, v, r, z = jnp.split(proj, [GLA_QK, 2 * GLA_QK, 2 * GLA_QK + GLA_V, 2 * GLA_QK + 2 * GLA_V], axis=-1)
    q = q.astype(f32).reshape(B, S, GLA_HEADS, GLA_DK) * (GLA_DK ** -0.5)
    k = k.astype(f32).reshape(B, S, GLA_HEADS, GLA_DK)
    v = v.astype(f32).reshape(B, S, GLA_HEADS, GLA_DV)
    z = z.astype(f32).reshape(B, S, 2, GATE_RANK)
    logit = jnp.einsum('bsir,ire->bsie', z, w_gate_up.astype(f32)) + b_gate.astype(f32)
    logg = (jax.nn.log_sigmoid(logit) / GATE_TAU).reshape(B, S, 2, GLA_HEADS, GLA_DK)
    o_f = gla_chunked(q, k, v, logg[:, :, 0])
    flip = lambda t: jnp.flip(t, axis=1)
    o_b = flip(gla_chunked(flip(q), flip(k), flip(v), flip(logg[:, :, 1])))
    o = rmsnorm(o_f + o_b, out_g).reshape(B, S, GLA_V)
    o = o * jax.nn.silu(r.astype(f32))
    return o.astype(h.dtype) @ w_o


def sq_relu_mlp(h, w_in, w_out):
    return jnp.square(jax.nn.relu(h @ w_in)) @ w_out


def setup_inputs(seed: int = 0) -> dict:
    key = jax.random.key(seed)
    ks = jax.random.split(key, 16)
    nrm = lambda k, shape, fan_in: jax.random.normal(k, shape, jnp.float32) * (fan_in ** -0.5)
    gain = lambda k, shape: 1.0 + 0.05 * jax.random.normal(k, shape, jnp.float32)
    return {
        'x': jax.random.normal(ks[0], (BATCH, SEQ, D_MODEL), jnp.float32),
        'norm_mix': gain(ks[1], (DEPTH, D_MODEL)),
        'norm_mlp': gain(ks[2], (DEPTH, D_MODEL)),
        'attn_w_qkv': nrm(ks[3], (N_ATTN, D_MODEL, ATTN_QKV), D_MODEL),
        'attn_q_norm': gain(ks[4], (N_ATTN, HEAD_DIM)),
        'attn_k_norm': gain(ks[5], (N_ATTN, HEAD_DIM)),
        'attn_w_o': nrm(ks[6], (N_ATTN, N_HEADS * HEAD_DIM, D_MODEL), N_HEADS * HEAD_DIM),
        'gla_w_in': nrm(ks[7], (N_GLA, D_MODEL, GLA_IN), D_MODEL),
        'gla_w_gate_up': nrm(ks[8], (N_GLA, 2, GATE_RANK, GLA_QK), GATE_RANK),
        'gla_b_gate': 0.1 * jax.random.normal(ks[9], (N_GLA, 2, GLA_QK), jnp.float32),
        'gla_out_norm': gain(ks[10], (N_GLA, GLA_DV)),
        'gla_w_o': nrm(ks[11], (N_GLA, GLA_V, D_MODEL), GLA_V),
        'mlp_w_in': nrm(ks[12], (DEPTH, D_MODEL, D_FF), D_MODEL),
        'mlp_w_out': nrm(ks[13], (DEPTH, D_FF, D_MODEL), D_FF),
        'final_norm': gain(ks[14], (D_MODEL,)),
    }


def reference(x, norm_mix, norm_mlp, attn_w_qkv, attn_q_norm, attn_k_norm, attn_w_o,
              gla_w_in, gla_w_gate_up, gla_b_gate, gla_out_norm, gla_w_o,
              mlp_w_in, mlp_w_out, final_norm):
    S = x.shape[1]
    rows = S // GRID_W
    row = jnp.repeat(jnp.arange(rows, dtype=jnp.int32), GRID_W)
    col = jnp.tile(jnp.arange(GRID_W, dtype=jnp.int32), rows)
    cr, sr = rope_angles(row, HEAD_DIM // 2)
    cc, sc = rope_angles(col, HEAD_DIM // 2)
    rope = (cr, sr, cc, sc)
    h = x
    for i in range(DEPTH):
        j = i // N_MIXERS
        hn = rmsnorm(h, norm_mix[i])
        if i % N_MIXERS == 0:
            h = h + attention_mixer(hn, attn_w_qkv[j], attn_q_norm[j], attn_k_norm[j], attn_w_o[j], rope)
        else:
            h = h + gla_mixer(hn, gla_w_in[j], gla_w_gate_up[j], gla_b_gate[j], gla_out_norm[j], gla_w_o[j])
        h = h + sq_relu_mlp(rmsnorm(h, norm_mlp[i]), mlp_w_in[i], mlp_w_out[i])
    return rmsnorm(h, final_norm)
```

```cpp
#include <hip/hip_runtime.h>
#include <cstdio>
#include <cstdint>

#define GAS __attribute__((address_space(1)))
#define LAS __attribute__((address_space(3)))
typedef unsigned short bf16_t;
typedef short bf16x8 __attribute__((ext_vector_type(8)));
typedef float f32x4 __attribute__((ext_vector_type(4)));
typedef float f32x2 __attribute__((ext_vector_type(2)));
typedef unsigned u32x4 __attribute__((ext_vector_type(4)));
typedef unsigned u32x2 __attribute__((ext_vector_type(2)));

constexpr int BATCH = 4, SEQ = 4096, D = 1024, M = BATCH * SEQ;
constexpr int NH = 16, NKV = 4, HD = 64, QKV_N = 1536, KVP = NKV * HD;
constexpr int GH = 4, GDK = 128, GDV = 256, GQK = 512, GV = 1024, RANK = 16, GIN = 3104, CH = 64, NCH = SEQ / CH;
constexpr int FF = 4096;
constexpr float EPS = 1e-6f;
constexpr float C2 = 0.125f * 1.4426950408889634f;
constexpr int NWAVES = 8, NTHREADS = 512;
constexpr int NPHASES = 14;

constexpr size_t MiB = 1u << 20;
constexpr size_t WS_CTL = 0, CTL_ZERO_BYTES = 1 * MiB;
constexpr size_t WS_ROPE = 1 * MiB;
constexpr size_t WS_SSQ = 2 * MiB;
constexpr size_t WS_Z = 7 * MiB;
constexpr size_t WS_DECAY = 11 * MiB;
constexpr size_t WS_W = 12 * MiB;
constexpr size_t W_QKV = WS_W, W_O0 = W_QKV + 3 * MiB, W_1A = W_O0 + 2 * MiB, W_2A = W_1A + 8 * MiB, W_GIN = W_2A + 8 * MiB,
                 W_O1 = W_GIN + 6 * MiB + 128 * 1024, W_1B = W_O1 + 2 * MiB, W_2B = W_1B + 8 * MiB, W_END = W_2B + 8 * MiB;
constexpr size_t WS_XB = 58 * MiB;
constexpr size_t WS_BIG = 90 * MiB;
constexpr size_t WS_QK = 218 * MiB;
constexpr size_t WS_END = 250 * MiB;
static_assert(W_END <= WS_XB, "weights fit");

__device__ __forceinline__ unsigned f2bf(float f) { unsigned u = __builtin_bit_cast(unsigned, f); return (u + 0x7fffu + ((u >> 16) & 1u)) >> 16; }
__device__ __forceinline__ unsigned pk2(float lo, float hi) { return f2bf(lo) | (f2bf(hi) << 16); }
__device__ __forceinline__ float bf2f(unsigned short u) { return __uint_as_float((unsigned)u << 16); }
__device__ __forceinline__ float bflo(unsigned w) { return __uint_as_float(w << 16); }
__device__ __forceinline__ float bfhi(unsigned w) { return __uint_as_float(w & 0xffff0000u); }
#define LDS_WAIT() asm volatile("s_waitcnt lgkmcnt(0)" ::: "memory")
#define VM_WAIT() asm volatile("s_waitcnt vmcnt(0)" ::: "memory")
__device__ __forceinline__ float wave_sum(float v) {
#pragma unroll
    for (int o = 1; o < 64; o <<= 1) v += __shfl_xor(v, o);
    return v;
}
__device__ __forceinline__ float rstd_from_slots(const float* ssq, int row) {
    const f32x4* p = (const f32x4*)(ssq + (size_t)row * 16);
    const f32x4 a = p[0], b = p[1], c = p[2], d = p[3];
    const float s = (((a.x + a.y) + (a.z + a.w)) + ((b.x + b.y) + (b.z + b.w))) + (((c.x + c.y) + (c.z + c.w)) + ((d.x + d.y) + (d.z + d.w)));
    return 1.0f / sqrtf(s * (1.0f / D) + EPS);
}

#define RLX_AGENT __ATOMIC_RELAXED, __HIP_MEMORY_SCOPE_AGENT
#define XB_TMO      128
#define XB_XCNT(j)  (256  + 64 * (j))
#define XB_XSUB(j)  (1280 + 64 * (j))
#define XB_XGEN(j)  (2304 + 64 * (j))
#define XB_TOP      3328
#define XB_TOPGEN   3392
#define XCD_BAR_WORDS 3456
#define XB_SPIN_CAP (1u << 22)
__device__ __forceinline__ unsigned xb_ld(unsigned* p)              { return __hip_atomic_load(p, __ATOMIC_RELAXED, __HIP_MEMORY_SCOPE_AGENT); }
__device__ __forceinline__ unsigned xb_add(unsigned* p, unsigned v) { return __hip_atomic_fetch_add(p, v, __ATOMIC_RELAXED, __HIP_MEMORY_SCOPE_AGENT); }
__device__ __forceinline__ unsigned xb_xcc_id() { return (unsigned)__builtin_amdgcn_s_getreg((3 << 11) | 20) & 0xFu; }
#define XB_SPIN(cond, bar) do { unsigned _sp = 0; while (cond) { __builtin_amdgcn_s_sleep(1); \
    if ((++_sp & 255u) == 0u) { if (xb_ld(&(bar)[XB_TMO])) break; if (_sp > XB_SPIN_CAP) { atomicAdd(&(bar)[XB_TMO], 1u); break; } } } } while (0)
struct XcdBarrier { unsigned* bar; unsigned x; volatile LAS unsigned* st; };
__device__ __forceinline__ XcdBarrier xcd_barrier_post(unsigned* bar, volatile LAS unsigned* st) {
    XcdBarrier b; b.bar = bar; b.x = xb_xcc_id(); b.st = st;
    if (threadIdx.x == 0) (void)xb_add(&bar[XB_XCNT(b.x)], 1u);
    return b;
}
__device__ __forceinline__ void xcd_barrier_complete(unsigned* bar, unsigned x, unsigned& nloc, unsigned& nx) {
    const unsigned G = gridDim.x * gridDim.y * gridDim.z;
    unsigned sum, cnt, mine, sp = 0u;
    for (;;) {
        sum = 0u; cnt = 0u; mine = 0u;
#pragma unroll
        for (unsigned j = 0; j < 16; ++j) { const unsigned c = xb_ld(&bar[XB_XCNT(j)]); sum += c; cnt += (c > 0u) ? 1u : 0u; mine = (j == x) ? c : mine; }
        if (sum == G) break;
        __builtin_amdgcn_s_sleep(1);
        if ((++sp & 255u) == 0u) { if (xb_ld(&bar[XB_TMO])) break; if (sp > XB_SPIN_CAP) { atomicAdd(&bar[XB_TMO], 1u); break; } }
    }
    nloc = mine > 0u ? mine : 1u; nx = cnt > 0u ? cnt : 1u;
}
__device__ __forceinline__ void xcd_barrier(const XcdBarrier& b) {
    asm volatile("s_waitcnt vmcnt(0)" ::: "memory");
    __syncthreads();
    if (threadIdx.x == 0) {
        unsigned* bar = b.bar;
        __builtin_amdgcn_s_waitcnt(0);
        unsigned nloc = b.st[0], nx = b.st[1];
        if (nloc == 0u) { xcd_barrier_complete(bar, b.x, nloc, nx); b.st[0] = nloc; b.st[1] = nx; }
        const unsigned old = xb_add(&bar[XB_XSUB(b.x)], 1u);
        const unsigned gen = old / nloc;
        if (old + 1u == (gen + 1u) * nloc) {
            __builtin_amdgcn_fence(__ATOMIC_RELEASE, "agent");
            asm volatile("s_waitcnt vmcnt(0)" ::: "memory");
            const unsigned og = xb_add(&bar[XB_TOP], 1u);
            const unsigned tg = og / nx;
            if (og + 1u == (tg + 1u) * nx) xb_add(&bar[XB_TOPGEN], 1u);
            else XB_SPIN(xb_ld(&bar[XB_TOPGEN]) == tg, bar);
            __builtin_amdgcn_fence(__ATOMIC_ACQUIRE, "agent");
            xb_add(&bar[XB_XGEN(b.x)], 1u);
            asm volatile("s_waitcnt vmcnt(0)" ::: "memory");
        } else {
            XB_SPIN(xb_ld(&bar[XB_XGEN(b.x)]) == gen, bar);
            __builtin_amdgcn_fence(__ATOMIC_ACQUIRE, "agent");
            asm volatile("s_waitcnt vmcnt(0)" ::: "memory");
        }
    }
    __syncthreads();
}

constexpr int RING_BYTES = 131072;
constexpr int LDSCTL_OFF = RING_BYTES, MISC_OFF = LDSCTL_OFF + 320;
constexpr int LDS_BYTES = 147456;

__device__ __forceinline__ void transpose_item(const float* W, const float* g, int K, int N, bf16_t* WT, LAS float* scr, int item, int lane) {
    const int nblk = N / 32, kb = item / nblk, nb = item % nblk, k0 = 64 * kb, n0 = 32 * nb;
#pragma unroll 8
    for (int i = 0; i < 32; ++i) { const int kk = 2 * i + (lane >> 5); const float gv = g ? g[k0 + kk] : 1.0f;
        scr[kk * 33 + (lane & 31)] = W[(size_t)(k0 + kk) * N + n0 + (lane & 31)] * gv; }
    LDS_WAIT(); asm volatile("" ::: "memory");
    const int c = lane & 7;
#pragma unroll
    for (int j = 0; j < 4; ++j) { const int n = (lane >> 3) + 8 * j; const LAS float* s = scr + (8 * c) * 33 + n;
        u32x4 o; o.x = pk2(s[0 * 33], s[1 * 33]); o.y = pk2(s[2 * 33], s[3 * 33]); o.z = pk2(s[4 * 33], s[5 * 33]); o.w = pk2(s[6 * 33], s[7 * 33]);
        *(u32x4*)(WT + (size_t)(n0 + n) * K + k0 + 8 * c) = o; }
    LDS_WAIT(); asm volatile("" ::: "memory");
}
__device__ __forceinline__ void sincos_d(double x, double& s, double& c) {
    const double TWO_PI = 6.283185307179586476925286766559;
    const double n = __builtin_rint(x / TWO_PI);
    const double r = x - n * TWO_PI, r2 = r * r;
    double ts = 1.0, tc = 1.0;
#pragma unroll
    for (int k = 13; k >= 1; --k) { ts = 1.0 - ts * r2 / (double)((2 * k) * (2 * k + 1)); tc = 1.0 - tc * r2 / (double)((2 * k - 1) * (2 * k)); }
    s = r * ts; c = tc;
}

template <class Epi>
__device__ __forceinline__ void gemm_simple(const bf16_t* A, const bf16_t* Bt, int Mrows, int N, int K, const Epi& E, int gw, int ngw, int lane) {
    const int fr = lane & 15, fq = lane >> 4;
    const int ntn = N / 64, ntm = Mrows / 32, ntiles = ntn * ntm;
    for (int t = gw; t < ntiles; t += ngw) {
        const int tn = t % ntn, tm = t / ntn;
        f32x4 acc[2][4];
#pragma unroll
        for (int m = 0; m < 2; ++m)
#pragma unroll
            for (int n = 0; n < 4; ++n) acc[m][n] = (f32x4){0.f, 0.f, 0.f, 0.f};
        const bf16_t* Ap = A + (size_t)(tm * 32 + fr) * K + fq * 8;
        const bf16_t* Bp = Bt + (size_t)(tn * 64 + fr) * K + fq * 8;
        for (int k0 = 0; k0 < K; k0 += 32) {
            bf16x8 a[2], b[4];
            a[0] = *(const bf16x8*)(Ap + k0); a[1] = *(const bf16x8*)(Ap + (size_t)16 * K + k0);
#pragma unroll
            for (int n = 0; n < 4; ++n) b[n] = *(const bf16x8*)(Bp + (size_t)n * 16 * K + k0);
#pragma unroll
            for (int m = 0; m < 2; ++m)
#pragma unroll
                for (int n = 0; n < 4; ++n) acc[m][n] = __builtin_amdgcn_mfma_f32_16x16x32_bf16(b[n], a[m], acc[m][n], 0, 0, 0);
        }
        E(tm * 32, tn * 64, acc, fr, fq);
    }
}

struct EpiQKV {
    const float* ssq; const float* qg; const float* kg; const f32x2* rope; bf16_t* Q; bf16_t* Kb; bf16_t* Vb;
    __device__ __forceinline__ void operator()(int row0, int col0, f32x4 (&acc)[2][4], int fr, int fq) const {
#pragma unroll
        for (int m = 0; m < 2; ++m) {
            const int row = row0 + 16 * m + fr; const float rs = rstd_from_slots(ssq, row);
            f32x4 v[4];
#pragma unroll
            for (int n = 0; n < 4; ++n) v[n] = acc[m][n] * rs;
            if (col0 < 1280) {
                const bool isq = col0 < 1024; const float* g = isq ? qg : kg;
                float ss = 0.f;
#pragma unroll
                for (int n = 0; n < 4; ++n) ss += (v[n].x * v[n].x + v[n].y * v[n].y) + (v[n].z * v[n].z + v[n].w * v[n].w);
                ss += __shfl_xor(ss, 16); ss += __shfl_xor(ss, 32);
                const float r = 1.0f / sqrtf(ss * (1.0f / 64.0f) + EPS);
#pragma unroll
                for (int n = 0; n < 4; ++n) { const f32x4 gv = *(const f32x4*)(g + 16 * n + 4 * fq); v[n] = v[n] * r * gv; }
                const int t = row % SEQ, prow = t >> 6, pcol = t & 63;
                const float sc = isq ? C2 : 1.0f;
#pragma unroll
                for (int hh = 0; hh < 2; ++hh) {
                    const int pos = hh == 0 ? prow : pcol;
                    f32x4 x1 = v[2 * hh], x2 = v[2 * hh + 1], o1, o2;
#pragma unroll
                    for (int j = 0; j < 4; ++j) { const f32x2 cs = rope[pos * 16 + 4 * fq + j];
                        o1[j] = (x1[j] * cs.x - x2[j] * cs.y) * sc; o2[j] = (x2[j] * cs.x + x1[j] * cs.y) * sc; }
                    v[2 * hh] = o1; v[2 * hh + 1] = o2;
                }
            }
            bf16_t* dst;
            if (col0 < 1024) dst = Q + (size_t)row * D + col0;
            else if (col0 < 1280) dst = Kb + (size_t)row * KVP + (col0 - 1024);
            else dst = Vb + (size_t)row * KVP + (col0 - 1280);
#pragma unroll
            for (int n = 0; n < 4; ++n) { u32x2 w; w.x = pk2(v[n].x, v[n].y); w.y = pk2(v[n].z, v[n].w); *(u32x2*)(dst + 16 * n + 4 * fq) = w; }
        }
    }
};
struct EpiRes {
    const float* base; float* out; bf16_t* xb; float* ssq;
    __device__ __forceinline__ void operator()(int row0, int col0, f32x4 (&acc)[2][4], int fr, int fq) const {
#pragma unroll
        for (int m = 0; m < 2; ++m) {
            const int row = row0 + 16 * m + fr; float ss = 0.f;
#pragma unroll
            for (int n = 0; n < 4; ++n) { const size_t off = (size_t)row * D + col0 + 16 * n + 4 * fq;
                const f32x4 h = *(const f32x4*)(base + off) + acc[m][n]; *(f32x4*)(out + off) = h;
                ss += (h.x * h.x + h.y * h.y) + (h.z * h.z + h.w * h.w);
                if (xb) { u32x2 w; w.x = pk2(h.x, h.y); w.y = pk2(h.z, h.w); *(u32x2*)(xb + off) = w; } }
            ss += __shfl_xor(ss, 16); ss += __shfl_xor(ss, 32);
            if (ssq && fq == 0) ssq[(size_t)row * 16 + (col0 >> 6)] = ss;
        }
    }
};
struct EpiUp {
    const float* ssq; bf16_t* HB;
    __device__ __forceinline__ void operator()(int row0, int col0, f32x4 (&acc)[2][4], int fr, int fq) const {
#pragma unroll
        for (int m = 0; m < 2; ++m) {
            const int row = row0 + 16 * m + fr; const float rs = rstd_from_slots(ssq, row);
#pragma unroll
            for (int n = 0; n < 4; ++n) { f32x4 v = acc[m][n] * rs;
#pragma unroll
                for (int j = 0; j < 4; ++j) { const float t = fmaxf(v[j], 0.f); v[j] = t * t; }
                u32x2 w; w.x = pk2(v.x, v.y); w.y = pk2(v.z, v.w); *(u32x2*)(HB + (size_t)row * FF + col0 + 16 * n + 4 * fq) = w; }
        }
    }
};
struct EpiGin {
    const float* ssq; bf16_t* q; bf16_t* k; bf16_t* v; bf16_t* r;
    __device__ __forceinline__ void operator()(int row0, int col0, f32x4 (&acc)[2][4], int fr, int fq) const {
#pragma unroll
        for (int m = 0; m < 2; ++m) {
            const int row = row0 + 16 * m + fr; float rs = rstd_from_slots(ssq, row);
            bf16_t* dst;
            if (col0 < 512) { dst = q + (size_t)row * GQK + col0; rs *= 0.08838834764831845f; }
            else if (col0 < 1024) dst = k + (size_t)row * GQK + (col0 - 512);
            else if (col0 < 2048) dst = v + (size_t)row * GV + (col0 - 1024);
            else dst = r + (size_t)row * GV + (col0 - 2048);
#pragma unroll
            for (int n = 0; n < 4; ++n) { const f32x4 x = acc[m][n] * rs; u32x2 w; w.x = pk2(x.x, x.y); w.y = pk2(x.z, x.w); *(u32x2*)(dst + 16 * n + 4 * fq) = w; }
        }
    }
};
struct EpiZ {
    const float* ssq; float* Z;
    __device__ __forceinline__ void operator()(int row0, int col0, f32x4 (&acc)[2][4], int fr, int fq) const {
#pragma unroll
        for (int m = 0; m < 2; ++m) {
            const int row = row0 + 16 * m + fr; const float rs = rstd_from_slots(ssq, row);
#pragma unroll
            for (int n = 0; n < 4; ++n) *(f32x4*)(Z + (size_t)row * 64 + col0 + 16 * n + 4 * fq) = acc[m][n] * rs;
        }
    }
};

__device__ __forceinline__ void attn_simple(const bf16_t* Q, const bf16_t* Kb, const bf16_t* Vb, bf16_t* O, int gw, int ngw, int lane) {
    const int fr = lane & 15, fq = lane >> 4;
    for (int u = gw; u < BATCH * NH * (SEQ / 16); u += ngw) {
        const int qt = u & 255, h = (u >> 8) & 15, b = u >> 12, kvh = h >> 2;
        const size_t rowbase = (size_t)b * SEQ;
        const bf16_t* Qp = Q + (rowbase + qt * 16 + fr) * D + h * HD + fq * 8;
        bf16x8 qf[2]; qf[0] = *(const bf16x8*)Qp; qf[1] = *(const bf16x8*)(Qp + 32);
        const bf16_t* Kh = Kb + rowbase * KVP + kvh * HD;
        const bf16_t* Vh = Vb + rowbase * KVP + kvh * HD;
        float mrun = -1e30f, lrun = 0.f;
        f32x4 oacc[4];
#pragma unroll
        for (int dt = 0; dt < 4; ++dt) oacc[dt] = (f32x4){0.f, 0.f, 0.f, 0.f};
        for (int kt = 0; kt < SEQ / 64; ++kt) {
            const int key0 = kt * 64;
            f32x4 sT[4];
#pragma unroll
            for (int blk = 0; blk < 4; ++blk) {
                const int key = key0 + 32 * (blk >> 1) + 8 * (fr >> 2) + 4 * (blk & 1) + (fr & 3);
                const bf16_t* kp = Kh + (size_t)key * KVP + fq * 8;
                const bf16x8 k0 = *(const bf16x8*)kp, k1 = *(const bf16x8*)(kp + 32);
                f32x4 z = (f32x4){0.f, 0.f, 0.f, 0.f};
                z = __builtin_amdgcn_mfma_f32_16x16x32_bf16(k0, qf[0], z, 0, 0, 0);
                z = __builtin_amdgcn_mfma_f32_16x16x32_bf16(k1, qf[1], z, 0, 0, 0);
                sT[blk] = z;
            }
            float mx = sT[0][0];
#pragma unroll
            for (int blk = 0; blk < 4; ++blk)
#pragma unroll
                for (int r = 0; r < 4; ++r) mx = fmaxf(mx, sT[blk][r]);
            mx = fmaxf(mx, __shfl_xor(mx, 16)); mx = fmaxf(mx, __shfl_xor(mx, 32));
            const float mnew = fmaxf(mrun, mx), alpha = __builtin_amdgcn_exp2f(mrun - mnew); mrun = mnew;
            float ps = 0.f; bf16x8 pf[2];
#pragma unroll
            for (int ks = 0; ks < 2; ++ks) {
                float p[8];
#pragma unroll
                for (int j = 0; j < 8; ++j) { p[j] = __builtin_amdgcn_exp2f(sT[2 * ks + (j >> 2)][j & 3] - mnew); ps += p[j]; }
                u32x4 w; w.x = pk2(p[0], p[1]); w.y = pk2(p[2], p[3]); w.z = pk2(p[4], p[5]); w.w = pk2(p[6], p[7]);
                pf[ks] = __builtin_bit_cast(bf16x8, w);
            }
            lrun = lrun * alpha + ps;
#pragma unroll
            for (int dt = 0; dt < 4; ++dt) oacc[dt] = oacc[dt] * alpha;
#pragma unroll
            for (int ks = 0; ks < 2; ++ks)
#pragma unroll
                for (int dt = 0; dt < 4; ++dt) {
                    const bf16_t* vp = Vh + (size_t)(key0 + 32 * ks + 8 * fq) * KVP + dt * 16 + fr;
                    bf16x8 vf;
#pragma unroll
                    for (int e = 0; e < 8; ++e) vf[e] = (short)vp[(size_t)e * KVP];
                    oacc[dt] = __builtin_amdgcn_mfma_f32_16x16x32_bf16(vf, pf[ks], oacc[dt], 0, 0, 0);
                }
        }
        lrun += __shfl_xor(lrun, 16); lrun += __shfl_xor(lrun, 32);
        const float inv = 1.0f / lrun;
        bf16_t* Op = O + (rowbase + qt * 16 + fr) * D + h * HD + 4 * fq;
#pragma unroll
        for (int dt = 0; dt < 4; ++dt) { const f32x4 o = oacc[dt] * inv; u32x2 w; w.x = pk2(o.x, o.y); w.y = pk2(o.z, o.w); *(u32x2*)(Op + dt * 16) = w; }
    }
}

__device__ __forceinline__ void gla_pre(const bf16_t* q, const bf16_t* k, const float* Z, const float* wgu, const float* bgate, bf16_t* qe, bf16_t* ke, float* decay, int wg, int nwg, int tid) {
    const int c = tid, h = c >> 7, d = c & 127;
    for (int it = wg; it < BATCH * NCH * 2; it += nwg) {
        const int dir = it & 1, n = (it >> 1) & (NCH - 1), b = it >> 7;
        float w[RANK];
#pragma unroll
        for (int r = 0; r < RANK; ++r) w[r] = wgu[((size_t)dir * RANK + r) * GQK + c];
        const float bg = bgate[dir * GQK + c];
        float bsum = 0.f;
        bf16_t* qed = qe + (size_t)dir * M * GQK; bf16_t* ked = ke + (size_t)dir * M * GQK;
        for (int s = 0; s < CH; ++s) {
            const int i = dir == 0 ? s : (CH - 1 - s);
            const size_t tok = (size_t)b * SEQ + n * CH + i;
            const f32x4* zp = (const f32x4*)(Z + tok * 64 + dir * RANK);
            const f32x4 z0 = zp[0], z1 = zp[1], z2 = zp[2], z3 = zp[3];
            float logit = bg;
            logit += z0.x * w[0] + z0.y * w[1] + z0.z * w[2] + z0.w * w[3];
            logit += z1.x * w[4] + z1.y * w[5] + z1.z * w[6] + z1.w * w[7];
            logit += z2.x * w[8] + z2.y * w[9] + z2.z * w[10] + z2.w * w[11];
            logit += z3.x * w[12] + z3.y * w[13] + z3.z * w[14] + z3.w * w[15];
            const float lg = (fminf(logit, 0.f) - log1pf(expf(-fabsf(logit)))) * (1.0f / 16.0f);
            bsum += lg;
            const float eb = expf(bsum), enb = expf(-bsum);
            qed[tok * GQK + c] = (bf16_t)f2bf(bf2f(q[tok * GQK + c]) * eb);
            ked[tok * GQK + c] = (bf16_t)f2bf(bf2f(k[tok * GQK + c]) * enb);
        }
        decay[((((size_t)b * GH + h) * 2 + dir) * NCH + n) * GDK + d] = expf(bsum);
    }
}

__device__ __forceinline__ void gla_scan_simple(const bf16_t* qe, const bf16_t* ke, const bf16_t* v, const float* decay, bf16_t* of, bf16_t* ob, LAS unsigned char* lds, int wg, int nwg, int tid) {
    LAS float* qeL = (LAS float*)lds;
    LAS float* keL = qeL + 64 * 129;
    LAS float* vL = keL + 64 * 129;
    LAS float* AL = vL + 64 * 33;
    LAS float* SL = AL + 64 * 65;
    LAS float* dL = SL + 128 * 33;
    for (int it = wg; it < BATCH * GH * 2 * 8; it += nwg) {
        const int js = it & 7, dir = (it >> 3) & 1, h = (it >> 4) & 3, b = it >> 6;
        const bf16_t* qed = qe + (size_t)dir * M * GQK; const bf16_t* ked = ke + (size_t)dir * M * GQK;
        bf16_t* od = dir == 0 ? of : ob;
        for (int e = tid; e < 128 * 33; e += NTHREADS) SL[e] = 0.f;
        __syncthreads();
        for (int st = 0; st < NCH; ++st) {
            const int n = dir == 0 ? st : (NCH - 1 - st);
            const size_t tok0 = (size_t)b * SEQ + n * CH;
            {
                const int i = tid >> 3, ds = (tid & 7) * 16;
                const u32x4* qp = (const u32x4*)(qed + (tok0 + i) * GQK + h * GDK + ds);
                const u32x4* kp = (const u32x4*)(ked + (tok0 + i) * GQK + h * GDK + ds);
#pragma unroll
                for (int hh = 0; hh < 2; ++hh) { const u32x4 a = qp[hh], c = kp[hh];
#pragma unroll
                    for (int j = 0; j < 4; ++j) { qeL[i * 129 + ds + hh * 8 + 2 * j] = bflo(a[j]); qeL[i * 129 + ds + hh * 8 + 2 * j + 1] = bfhi(a[j]);
                                                  keL[i * 129 + ds + hh * 8 + 2 * j] = bflo(c[j]); keL[i * 129 + ds + hh * 8 + 2 * j + 1] = bfhi(c[j]); } }
                if (tid < 256) { const int iv = tid >> 2, vs = (tid & 3) * 8;
                    const u32x4 a = *(const u32x4*)(v + (tok0 + iv) * GV + h * GDV + js * 32 + vs);
#pragma unroll
                    for (int j = 0; j < 4; ++j) { vL[iv * 33 + vs + 2 * j] = bflo(a[j]); vL[iv * 33 + vs + 2 * j + 1] = bfhi(a[j]); } }
                if (tid < 128) dL[tid] = decay[((((size_t)b * GH + h) * 2 + dir) * NCH + n) * GDK + tid];
            }
            __syncthreads();
            {
                const int i = tid >> 3, jg = tid & 7;
                float a[8];
#pragma unroll
                for (int e = 0; e < 8; ++e) a[e] = 0.f;
                for (int d = 0; d < GDK; ++d) { const float qv = qeL[i * 129 + d];
#pragma unroll
                    for (int e = 0; e < 8; ++e) a[e] += qv * keL[(jg + 8 * e) * 129 + d]; }
#pragma unroll
                for (int e = 0; e < 8; ++e) { const int j = jg + 8 * e; const bool keep = dir == 0 ? (j <= i) : (j >= i); AL[i * 65 + j] = keep ? a[e] : 0.f; }
            }
            __syncthreads();
            {
                const int i = tid >> 3, vg = (tid & 7) * 4;
                float o[4] = {0.f, 0.f, 0.f, 0.f};
                for (int j = 0; j < CH; ++j) { const float a = AL[i * 65 + j];
#pragma unroll
                    for (int e = 0; e < 4; ++e) o[e] += a * vL[j * 33 + vg + e]; }
                for (int d = 0; d < GDK; ++d) { const float qv = qeL[i * 129 + d];
#pragma unroll
                    for (int e = 0; e < 4; ++e) o[e] += qv * SL[d * 33 + vg + e]; }
                u32x2 w; w.x = pk2(o[0], o[1]); w.y = pk2(o[2], o[3]);
                *(u32x2*)(od + (tok0 + i) * GV + h * GDV + js * 32 + vg) = w;
            }
            __syncthreads();
            {
                const int d = tid >> 2, vg = (tid & 3) * 8;
                float s[8];
#pragma unroll
                for (int e = 0; e < 8; ++e) s[e] = SL[d * 33 + vg + e];
                for (int j = 0; j < CH; ++j) { const float kv = keL[j * 129 + d];
#pragma unroll
                    for (int e = 0; e < 8; ++e) s[e] += kv * vL[j * 33 + vg + e]; }
                const float dc = dL[d];
#pragma unroll
                for (int e = 0; e < 8; ++e) SL[d * 33 + vg + e] = dc * s[e];
            }
            __syncthreads();
        }
    }
}

__device__ __forceinline__ void gla_combine(bf16_t* of, const bf16_t* ob, const bf16_t* r, const float* og, int gw, int ngw, int lane) {
    for (int row = gw; row < M; row += ngw) {
        const size_t off = (size_t)row * GV + lane * 16;
        const u32x4 a0 = *(const u32x4*)(of + off), a1 = *(const u32x4*)(of + off + 8);
        const u32x4 b0 = *(const u32x4*)(ob + off), b1 = *(const u32x4*)(ob + off + 8);
        const u32x4 r0 = *(const u32x4*)(r + off), r1 = *(const u32x4*)(r + off + 8);
        float o[16], rr[16];
#pragma unroll
        for (int j = 0; j < 4; ++j) { o[2 * j] = bflo(a0[j]) + bflo(b0[j]); o[2 * j + 1] = bfhi(a0[j]) + bfhi(b0[j]); o[8 + 2 * j] = bflo(a1[j]) + bflo(b1[j]); o[8 + 2 * j + 1] = bfhi(a1[j]) + bfhi(b1[j]);
            rr[2 * j] = bflo(r0[j]); rr[2 * j + 1] = bfhi(r0[j]); rr[8 + 2 * j] = bflo(r1[j]); rr[8 + 2 * j + 1] = bfhi(r1[j]); }
        float ss = 0.f;
#pragma unroll
        for (int j = 0; j < 16; ++j) ss += o[j] * o[j];
        ss += __shfl_xor(ss, 1); ss += __shfl_xor(ss, 2); ss += __shfl_xor(ss, 4); ss += __shfl_xor(ss, 8);
        const float rs = 1.0f / sqrtf(ss * (1.0f / GDV) + EPS);
        const int dv0 = (lane & 15) * 16;
        float g[16];
#pragma unroll
        for (int j = 0; j < 16; ++j) { const float y = o[j] * rs * og[dv0 + j]; const float x = rr[j]; g[j] = y * x / (1.0f + __expf(-x)); }
        u32x4 w0, w1;
#pragma unroll
        for (int j = 0; j < 4; ++j) { w0[j] = pk2(g[2 * j], g[2 * j + 1]); w1[j] = pk2(g[8 + 2 * j], g[8 + 2 * j + 1]); }
        *(u32x4*)(of + off) = w0; *(u32x4*)(of + off + 8) = w1;
    }
}

struct Args { const float* in[15]; float* out; unsigned char* ws; int ph_lo, ph_hi; };
static_assert(sizeof(Args) == 15 * 8 + 8 + 8 + 8, "Args has no padding");

__global__ void __launch_bounds__(NTHREADS, 2) fwd_kernel(Args args) {
    extern __shared__ __attribute__((aligned(16))) unsigned char lds_raw[];
    LAS unsigned char* lds = (LAS unsigned char*)lds_raw;
    const int tid = threadIdx.x, lane = tid & 63, wave = __builtin_amdgcn_readfirstlane(tid >> 6);
    const int G = gridDim.x, wg = blockIdx.x;
    const int gw = wg * NWAVES + wave, ngw = G * NWAVES;
    unsigned char* ws = args.ws;
    const float* x = args.in[0]; const float* norm_mix = args.in[1]; const float* norm_mlp = args.in[2];
    const float* attn_w_qkv = args.in[3]; const float* attn_qn = args.in[4]; const float* attn_kn = args.in[5]; const float* attn_w_o = args.in[6];
    const float* gla_w_in = args.in[7]; const float* gla_wgu = args.in[8]; const float* gla_bg = args.in[9]; const float* gla_on = args.in[10]; const float* gla_w_o = args.in[11];
    const float* mlp_w_in = args.in[12]; const float* mlp_w_out = args.in[13]; const float* final_norm = args.in[14];
    float* out = args.out;
    f32x2* ROPE = (f32x2*)(ws + WS_ROPE);
    float* SSQ0 = (float*)(ws + WS_SSQ); float* SSQ1 = SSQ0 + (size_t)M * 16; float* SSQ2 = SSQ1 + (size_t)M * 16; float* SSQ3 = SSQ2 + (size_t)M * 16;
    float* Zb = (float*)(ws + WS_Z); float* DEC = (float*)(ws + WS_DECAY);
    bf16_t* Wqkv = (bf16_t*)(ws + W_QKV); bf16_t* Wo0 = (bf16_t*)(ws + W_O0); bf16_t* W1a = (bf16_t*)(ws + W_1A); bf16_t* W2a = (bf16_t*)(ws + W_2A);
    bf16_t* Wgin = (bf16_t*)(ws + W_GIN); bf16_t* Wo1 = (bf16_t*)(ws + W_O1); bf16_t* W1b = (bf16_t*)(ws + W_1B); bf16_t* W2b = (bf16_t*)(ws + W_2B);
    bf16_t* XB = (bf16_t*)(ws + WS_XB);
    bf16_t* Qb = (bf16_t*)(ws + WS_BIG); bf16_t* Kb = (bf16_t*)(ws + WS_BIG + 32 * MiB); bf16_t* Vb = (bf16_t*)(ws + WS_BIG + 40 * MiB);
    bf16_t* HB = (bf16_t*)(ws + WS_BIG);
    bf16_t* Gv = (bf16_t*)(ws + WS_BIG); bf16_t* Gr = (bf16_t*)(ws + WS_BIG + 32 * MiB); bf16_t* Gqe = (bf16_t*)(ws + WS_BIG + 64 * MiB); bf16_t* Gke = (bf16_t*)(ws + WS_BIG + 96 * MiB);
    bf16_t* Gq = (bf16_t*)(ws + WS_QK); bf16_t* Gk = (bf16_t*)(ws + WS_QK + 16 * MiB);
    bf16_t* Gof = (bf16_t*)(ws + WS_QK); bf16_t* Gob = (bf16_t*)(ws + WS_XB);

    for (int u = tid; u < (LDS_BYTES - LDSCTL_OFF) / 4; u += NTHREADS) ((LAS unsigned*)(lds + LDSCTL_OFF))[u] = 0u;
    __syncthreads();
    volatile LAS unsigned* MISC = (volatile LAS unsigned*)(lds + MISC_OFF);
    const int lo = args.ph_lo, hi = args.ph_hi;
    const bool multi = (hi - lo) > 1;
    XcdBarrier bar; bar.bar = (unsigned*)(ws + WS_CTL) + 4096; bar.x = 0; bar.st = nullptr;
    if (multi) bar = xcd_barrier_post((unsigned*)(ws + WS_CTL) + 4096, MISC + 8);
#define IN(k) (lo <= (k) && (k) < hi)
#define SEAM(k) do { if (IN(k) && IN((k) + 1)) xcd_barrier(bar); } while (0)

    if (IN(0)) {
        LAS float* scr = (LAS float*)(lds + wave * 16384);
        constexpr int I_QKV = 16 * 48, I_O = 16 * 32, I_1 = 16 * 128, I_2 = 64 * 32, I_GIN = 16 * 97;
        constexpr int NITEMS = I_QKV + I_O + I_1 + I_2 + I_GIN + I_O + I_1 + I_2;
        for (int it = gw; it < NITEMS; it += ngw) {
            int r = it;
            if (r < I_QKV) { transpose_item(attn_w_qkv, norm_mix, D, QKV_N, Wqkv, scr, r, lane); continue; } r -= I_QKV;
            if (r < I_O) { transpose_item(attn_w_o, nullptr, D, D, Wo0, scr, r, lane); continue; } r -= I_O;
            if (r < I_1) { transpose_item(mlp_w_in, norm_mlp, D, FF, W1a, scr, r, lane); continue; } r -= I_1;
            if (r < I_2) { transpose_item(mlp_w_out, nullptr, FF, D, W2a, scr, r, lane); continue; } r -= I_2;
            if (r < I_GIN) { transpose_item(gla_w_in, norm_mix + D, D, GIN, Wgin, scr, r, lane); continue; } r -= I_GIN;
            if (r < I_O) { transpose_item(gla_w_o, nullptr, D, D, Wo1, scr, r, lane); continue; } r -= I_O;
            if (r < I_1) { transpose_item(mlp_w_in + (size_t)D * FF, norm_mlp + D, D, FF, W1b, scr, r, lane); continue; } r -= I_1;
            transpose_item(mlp_w_out + (size_t)FF * D, nullptr, FF, D, W2b, scr, r, lane);
        }
        for (int e = gw * 64 + lane; e < 32 * D / 8; e += ngw * 64) *(u32x4*)(Wgin + (size_t)GIN * D + (size_t)e * 8) = (u32x4){0u, 0u, 0u, 0u};
        for (int m = gw; m < M; m += ngw) {
            const f32x4* xr = (const f32x4*)(x + (size_t)m * D) + lane;
            f32x4 v[4]; float s = 0.f;
#pragma unroll
            for (int j = 0; j < 4; ++j) { v[j] = xr[64 * j]; s += (v[j].x * v[j].x + v[j].y * v[j].y) + (v[j].z * v[j].z + v[j].w * v[j].w); }
            s = wave_sum(s);
            u32x2* o8 = (u32x2*)(XB + (size_t)m * D) + lane;
#pragma unroll
            for (int j = 0; j < 4; ++j) { u32x2 w; w.x = pk2(v[j].x, v[j].y); w.y = pk2(v[j].z, v[j].w); o8[64 * j] = w; }
            if (lane < 16) SSQ0[(size_t)m * 16 + lane] = lane == 0 ? s : 0.f;
        }
        if (wg == 0) {
            for (int e = tid; e < 64 * 16; e += NTHREADS) {
                const int pos = e >> 4, i = e & 15;
                const double base4[4] = {1.0, 0.56234132519034908, 0.31622776601683794, 0.17782794100389228};
                double invd = (i & 3) == 0 ? base4[0] : (i & 3) == 1 ? base4[1] : (i & 3) == 2 ? base4[2] : base4[3];
                invd *= (i >> 2) == 0 ? 1.0 : (i >> 2) == 1 ? 0.1 : (i >> 2) == 2 ? 0.01 : 0.001;
                const float invf = (float)invd; const float ang = (float)pos * invf;
                double s, c; sincos_d((double)ang, s, c);
                ROPE[e] = (f32x2){(float)c, (float)s};
            }
        }
    }
    SEAM(0);
    if (IN(1)) { EpiQKV E{SSQ0, attn_qn, attn_kn, ROPE, Qb, Kb, Vb}; gemm_simple(XB, Wqkv, M, QKV_N, D, E, gw, ngw, lane); }
    SEAM(1);
    if (IN(2)) attn_simple(Qb, Kb, Vb, Qb, gw, ngw, lane);
    SEAM(2);
    if (IN(3)) { EpiRes E{x, out, XB, SSQ1}; gemm_simple(Qb, Wo0, M, D, D, E, gw, ngw, lane); }
    SEAM(3);
    if (IN(4)) { EpiUp E{SSQ1, HB}; gemm_simple(XB, W1a, M, FF, D, E, gw, ngw, lane); }
    SEAM(4);
    if (IN(5)) { EpiRes E{out, out, XB, SSQ2}; gemm_simple(HB, W2a, M, D, FF, E, gw, ngw, lane); }
    SEAM(5);
    if (IN(6)) { EpiGin E{SSQ2, Gq, Gk, Gv, Gr}; gemm_simple(XB, Wgin, M, 3072, D, E, gw, ngw, lane);
                 EpiZ Ez{SSQ2, Zb}; gemm_simple(XB, Wgin + (size_t)3072 * D, M, 64, D, Ez, gw, ngw, lane); }
    SEAM(6);
    if (IN(7)) gla_pre(Gq, Gk, Zb, gla_wgu, gla_bg, Gqe, Gke, DEC, wg, G, tid);
    SEAM(7);
    if (IN(8)) gla_scan_simple(Gqe, Gke, Gv, DEC, Gof, Gob, lds, wg, G, tid);
    SEAM(8);
    if (IN(9)) gla_combine(Gof, Gob, Gr, gla_on, gw, ngw, lane);
    SEAM(9);
    if (IN(10)) { EpiRes E{out, out, XB, SSQ3}; gemm_simple(Gof, Wo1, M, D, D, E, gw, ngw, lane); }
    SEAM(10);
    if (IN(11)) { EpiUp E{SSQ3, HB}; gemm_simple(XB, W1b, M, FF, D, E, gw, ngw, lane); }
    SEAM(11);
    if (IN(12)) { EpiRes E{out, out, nullptr, nullptr}; gemm_simple(HB, W2b, M, D, FF, E, gw, ngw, lane); }
    SEAM(12);
    if (IN(13)) {
        for (int m = gw; m < M; m += ngw) {
            f32x4* xr = (f32x4*)(out + (size_t)m * D) + lane;
            f32x4 v[4]; float s = 0.f;
#pragma unroll
            for (int j = 0; j < 4; ++j) { v[j] = xr[64 * j]; s += (v[j].x * v[j].x + v[j].y * v[j].y) + (v[j].z * v[j].z + v[j].w * v[j].w); }
            s = wave_sum(s);
            const float rs = 1.0f / sqrtf(s * (1.0f / D) + EPS);
#pragma unroll
            for (int j = 0; j < 4; ++j) { const f32x4 g = *((const f32x4*)final_norm + lane + 64 * j); xr[64 * j] = v[j] * rs * g; }
        }
    }
#undef IN
#undef SEAM
}

#ifndef MK_SINGLE
#define MK_SINGLE 0
#endif
extern "C" void kernel_launch(void* const* d_in, const int* in_sizes, int n_in, void* d_out, int out_size, void* d_ws, size_t ws_size, hipStream_t stream) {
    static int grid = 0;
    if (grid == 0) {
        if (n_in != 15 || in_sizes[0] != M * D || out_size != M * D || ws_size < WS_END) { fprintf(stderr, "kernel_launch: unexpected shapes (n_in %d, in0 %d, out %d, ws %zu)\n", n_in, n_in > 0 ? in_sizes[0] : -1, out_size, ws_size); grid = -1; return; }
        int dev = 0, cus = 0, per_cu = 0;
        if (hipGetDevice(&dev) != hipSuccess || hipDeviceGetAttribute(&cus, hipDeviceAttributeMultiprocessorCount, dev) != hipSuccess) { grid = -1; return; }
        if (hipFuncSetAttribute((const void*)fwd_kernel, hipFuncAttributeMaxDynamicSharedMemorySize, LDS_BYTES) != hipSuccess) { fprintf(stderr, "kernel_launch: hipFuncSetAttribute failed\n"); grid = -1; return; }
        if (hipOccupancyMaxActiveBlocksPerMultiprocessor(&per_cu, (const void*)fwd_kernel, NTHREADS, LDS_BYTES) != hipSuccess || per_cu < 1) { fprintf(stderr, "kernel_launch: occupancy query says %d\n", per_cu); }
        (void)hipGetLastError();
        grid = cus;
    }
    if (grid < 0) return;
    (void)hipMemsetAsync((char*)d_ws + WS_CTL, 0, CTL_ZERO_BYTES, stream);
    Args a{};
    for (int i = 0; i < 15; ++i) a.in[i] = (const float*)d_in[i];
    a.out = (float*)d_out; a.ws = (unsigned char*)d_ws;
#if MK_SINGLE
    a.ph_lo = 0; a.ph_hi = NPHASES;
    hipLaunchKernelGGL(fwd_kernel, dim3(grid), dim3(NTHREADS), LDS_BYTES, stream, a);
#else
    for (int p = 0; p < NPHASES; ++p) { a.ph_lo = p; a.ph_hi = p + 1; hipLaunchKernelGGL(fwd_kernel, dim3(grid), dim3(NTHREADS), LDS_BYTES, stream, a); }
#endif
}
```

```cpp
#include <hip/hip_runtime.h>
#include <cstdio>
#include <cstdint>

#define GAS __attribute__((address_space(1)))
#define LAS __attribute__((address_space(3)))
typedef unsigned short bf16_t;
typedef short bf16x8 __attribute__((ext_vector_type(8)));
typedef float f32x4 __attribute__((ext_vector_type(4)));
typedef float f32x2 __attribute__((ext_vector_type(2)));
typedef unsigned u32x4 __attribute__((ext_vector_type(4)));
typedef unsigned u32x2 __attribute__((ext_vector_type(2)));

constexpr int BATCH = 4, SEQ = 4096, D = 1024, M = BATCH * SEQ;
constexpr int NH = 16, NKV = 4, HD = 64, QKV_N = 1536, KVP = NKV * HD;
constexpr int GH = 4, GDK = 128, GDV = 256, GQK = 512, GV = 1024, RANK = 16, GIN = 3104, CH = 64, NCH = SEQ / CH;
constexpr int FF = 4096;
constexpr float EPS = 1e-6f;
constexpr float C2 = 0.125f * 1.4426950408889634f;
constexpr int NWAVES = 8, NTHREADS = 512;
constexpr int NPHASES = 14;

constexpr size_t MiB = 1u << 20;
constexpr size_t WS_CTL = 0, CTL_ZERO_BYTES = 1 * MiB;
constexpr size_t WS_ROPE = 1 * MiB;
constexpr size_t WS_SSQ = 2 * MiB;
constexpr size_t WS_Z = 7 * MiB;
constexpr size_t WS_DECAY = 11 * MiB;
constexpr size_t WS_W = 12 * MiB;
constexpr size_t W_QKV = WS_W, W_O0 = W_QKV + 3 * MiB, W_1A = W_O0 + 2 * MiB, W_2A = W_1A + 8 * MiB, W_GIN = W_2A + 8 * MiB,
                 W_O1 = W_GIN + 6 * MiB + 128 * 1024, W_1B = W_O1 + 2 * MiB, W_2B = W_1B + 8 * MiB, W_END = W_2B + 8 * MiB;
constexpr size_t WS_XB = 58 * MiB;
constexpr size_t WS_BIG = 90 * MiB;
constexpr size_t WS_QK = 218 * MiB;
constexpr size_t WS_END = 250 * MiB;
static_assert(W_END <= WS_XB, "weights fit");

__device__ __forceinline__ unsigned f2bf(float f) { unsigned u = __builtin_bit_cast(unsigned, f); return (u + 0x7fffu + ((u >> 16) & 1u)) >> 16; }
__device__ __forceinline__ unsigned pk2(float lo, float hi) { return f2bf(lo) | (f2bf(hi) << 16); }
__device__ __forceinline__ float bf2f(unsigned short u) { return __uint_as_float((unsigned)u << 16); }
__device__ __forceinline__ float bflo(unsigned w) { return __uint_as_float(w << 16); }
__device__ __forceinline__ float bfhi(unsigned w) { return __uint_as_float(w & 0xffff0000u); }
#define LDS_WAIT() asm volatile("s_waitcnt lgkmcnt(0)" ::: "memory")
#define VM_WAIT() asm volatile("s_waitcnt vmcnt(0)" ::: "memory")
__device__ __forceinline__ float wave_sum(float v) {
#pragma unroll
    for (int o = 1; o < 64; o <<= 1) v += __shfl_xor(v, o);
    return v;
}
__device__ __forceinline__ float rstd_from_slots(const float* ssq, int row) {
    const f32x4* p = (const f32x4*)(ssq + (size_t)row * 16);
    const f32x4 a = p[0], b = p[1], c = p[2], d = p[3];
    const float s = (((a.x + a.y) + (a.z + a.w)) + ((b.x + b.y) + (b.z + b.w))) + (((c.x + c.y) + (c.z + c.w)) + ((d.x + d.y) + (d.z + d.w)));
    return 1.0f / sqrtf(s * (1.0f / D) + EPS);
}

#define RLX_AGENT __ATOMIC_RELAXED, __HIP_MEMORY_SCOPE_AGENT
#define XB_TMO      128
#define XB_XCNT(j)  (256  + 64 * (j))
#define XB_XSUB(j)  (1280 + 64 * (j))
#define XB_XGEN(j)  (2304 + 64 * (j))
#define XB_TOP      3328
#define XB_TOPGEN   3392
#define XCD_BAR_WORDS 3456
#define XB_SPIN_CAP (1u << 22)
__device__ __forceinline__ unsigned xb_ld(unsigned* p)              { return __hip_atomic_load(p, __ATOMIC_RELAXED, __HIP_MEMORY_SCOPE_AGENT); }
__device__ __forceinline__ unsigned xb_add(unsigned* p, unsigned v) { return __hip_atomic_fetch_add(p, v, __ATOMIC_RELAXED, __HIP_MEMORY_SCOPE_AGENT); }
__device__ __forceinline__ unsigned xb_xcc_id() { return (unsigned)__builtin_amdgcn_s_getreg((3 << 11) | 20) & 0xFu; }
#define XB_SPIN(cond, bar) do { unsigned _sp = 0; while (cond) { __builtin_amdgcn_s_sleep(1); \
    if ((++_sp & 255u) == 0u) { if (xb_ld(&(bar)[XB_TMO])) break; if (_sp > XB_SPIN_CAP) { atomicAdd(&(bar)[XB_TMO], 1u); break; } } } } while (0)
struct XcdBarrier { unsigned* bar; unsigned x; volatile LAS unsigned* st; };
__device__ __forceinline__ XcdBarrier xcd_barrier_post(unsigned* bar, volatile LAS unsigned* st) {
    XcdBarrier b; b.bar = bar; b.x = xb_xcc_id(); b.st = st;
    if (threadIdx.x == 0) (void)xb_add(&bar[XB_XCNT(b.x)], 1u);
    return b;
}
__device__ __forceinline__ void xcd_barrier_complete(unsigned* bar, unsigned x, unsigned& nloc, unsigned& nx) {
    const unsigned G = gridDim.x * gridDim.y * gridDim.z;
    unsigned sum, cnt, mine, sp = 0u;
    for (;;) {
        sum = 0u; cnt = 0u; mine = 0u;
#pragma unroll
        for (unsigned j = 0; j < 16; ++j) { const unsigned c = xb_ld(&bar[XB_XCNT(j)]); sum += c; cnt += (c > 0u) ? 1u : 0u; mine = (j == x) ? c : mine; }
        if (sum == G) break;
        __builtin_amdgcn_s_sleep(1);
        if ((++sp & 255u) == 0u) { if (xb_ld(&bar[XB_TMO])) break; if (sp > XB_SPIN_CAP) { atomicAdd(&bar[XB_TMO], 1u); break; } }
    }
    nloc = mine > 0u ? mine : 1u; nx = cnt > 0u ? cnt : 1u;
}
__device__ __forceinline__ void xcd_barrier(const XcdBarrier& b) {
    asm volatile("s_waitcnt vmcnt(0)" ::: "memory");
    __syncthreads();
    if (threadIdx.x == 0) {
        unsigned* bar = b.bar;
        __builtin_amdgcn_s_waitcnt(0);
        unsigned nloc = b.st[0], nx = b.st[1];
        if (nloc == 0u) { xcd_barrier_complete(bar, b.x, nloc, nx); b.st[0] = nloc; b.st[1] = nx; }
        const unsigned old = xb_add(&bar[XB_XSUB(b.x)], 1u);
        const unsigned gen = old / nloc;
        if (old + 1u == (gen + 1u) * nloc) {
            __builtin_amdgcn_fence(__ATOMIC_RELEASE, "agent");
            asm volatile("s_waitcnt vmcnt(0)" ::: "memory");
            const unsigned og = xb_add(&bar[XB_TOP], 1u);
            const unsigned tg = og / nx;
            if (og + 1u == (tg + 1u) * nx) xb_add(&bar[XB_TOPGEN], 1u);
            else XB_SPIN(xb_ld(&bar[XB_TOPGEN]) == tg, bar);
            __builtin_amdgcn_fence(__ATOMIC_ACQUIRE, "agent");
            xb_add(&bar[XB_XGEN(b.x)], 1u);
            asm volatile("s_waitcnt vmcnt(0)" ::: "memory");
        } else {
            XB_SPIN(xb_ld(&bar[XB_XGEN(b.x)]) == gen, bar);
            __builtin_amdgcn_fence(__ATOMIC_ACQUIRE, "agent");
            asm volatile("s_waitcnt vmcnt(0)" ::: "memory");
        }
    }
    __syncthreads();
}

constexpr int RING_BYTES = 131072;
constexpr int LDSCTL_OFF = RING_BYTES, MISC_OFF = LDSCTL_OFF + 320;
constexpr int LDS_BYTES = 147456;

__device__ __forceinline__ void transpose_item(const float* W, const float* g, int K, int N, bf16_t* WT, LAS float* scr, int item, int lane) {
    const int nblk = N / 32, kb = item / nblk, nb = item % nblk, k0 = 64 * kb, n0 = 32 * nb;
#pragma unroll 8
    for (int i = 0; i < 32; ++i) { const int kk = 2 * i + (lane >> 5); const float gv = g ? g[k0 + kk] : 1.0f;
        scr[kk * 33 + (lane & 31)] = W[(size_t)(k0 + kk) * N + n0 + (lane & 31)] * gv; }
    LDS_WAIT(); asm volatile("" ::: "memory");
    const int c = lane & 7;
#pragma unroll
    for (int j = 0; j < 4; ++j) { const int n = (lane >> 3) + 8 * j; const LAS float* s = scr + (8 * c) * 33 + n;
        u32x4 o; o.x = pk2(s[0 * 33], s[1 * 33]); o.y = pk2(s[2 * 33], s[3 * 33]); o.z = pk2(s[4 * 33], s[5 * 33]); o.w = pk2(s[6 * 33], s[7 * 33]);
        *(u32x4*)(WT + (size_t)(n0 + n) * K + k0 + 8 * c) = o; }
    LDS_WAIT(); asm volatile("" ::: "memory");
}
__device__ __forceinline__ void sincos_d(double x, double& s, double& c) {
    const double TWO_PI = 6.283185307179586476925286766559;
    const double n = __builtin_rint(x / TWO_PI);
    const double r = x - n * TWO_PI, r2 = r * r;
    double ts = 1.0, tc = 1.0;
#pragma unroll
    for (int k = 13; k >= 1; --k) { ts = 1.0 - ts * r2 / (double)((2 * k) * (2 * k + 1)); tc = 1.0 - tc * r2 / (double)((2 * k - 1) * (2 * k)); }
    s = r * ts; c = tc;
}

template <class Epi>
__device__ __forceinline__ void gemm_simple(const bf16_t* A, const bf16_t* Bt, int Mrows, int N, int K, const Epi& E, int gw, int ngw, int lane) {
    const int fr = lane & 15, fq = lane >> 4;
    const int ntn = N / 64, ntm = Mrows / 32, ntiles = ntn * ntm;
    for (int t = gw; t < ntiles; t += ngw) {
        const int tn = t % ntn, tm = t / ntn;
        f32x4 acc[2][4];
#pragma unroll
        for (int m = 0; m < 2; ++m)
#pragma unroll
            for (int n = 0; n < 4; ++n) acc[m][n] = (f32x4){0.f, 0.f, 0.f, 0.f};
        const bf16_t* Ap = A + (size_t)(tm * 32 + fr) * K + fq * 8;
        const bf16_t* Bp = Bt + (size_t)(tn * 64 + fr) * K + fq * 8;
        for (int k0 = 0; k0 < K; k0 += 32) {
            bf16x8 a[2], b[4];
            a[0] = *(const bf16x8*)(Ap + k0); a[1] = *(const bf16x8*)(Ap + (size_t)16 * K + k0);
#pragma unroll
            for (int n = 0; n < 4; ++n) b[n] = *(const bf16x8*)(Bp + (size_t)n * 16 * K + k0);
#pragma unroll
            for (int m = 0; m < 2; ++m)
#pragma unroll
                for (int n = 0; n < 4; ++n) acc[m][n] = __builtin_amdgcn_mfma_f32_16x16x32_bf16(b[n], a[m], acc[m][n], 0, 0, 0);
        }
        E(tm * 32, tn * 64, acc, fr, fq);
    }
}

struct EpiQKV {
    const float* ssq; const float* qg; const float* kg; const f32x2* rope; bf16_t* Q; bf16_t* Kb; bf16_t* Vb;
    __device__ __forceinline__ void operator()(int row0, int col0, f32x4 (&acc)[2][4], int fr, int fq) const {
#pragma unroll
        for (int m = 0; m < 2; ++m) {
            const int row = row0 + 16 * m + fr; const float rs = rstd_from_slots(ssq, row);
            f32x4 v[4];
#pragma unroll
            for (int n = 0; n < 4; ++n) v[n] = acc[m][n] * rs;
            if (col0 < 1280) {
                const bool isq = col0 < 1024; const float* g = isq ? qg : kg;
                float ss = 0.f;
#pragma unroll
                for (int n = 0; n < 4; ++n) ss += (v[n].x * v[n].x + v[n].y * v[n].y) + (v[n].z * v[n].z + v[n].w * v[n].w);
                ss += __shfl_xor(ss, 16); ss += __shfl_xor(ss, 32);
                const float r = 1.0f / sqrtf(ss * (1.0f / 64.0f) + EPS);
#pragma unroll
                for (int n = 0; n < 4; ++n) { const f32x4 gv = *(const f32x4*)(g + 16 * n + 4 * fq); v[n] = v[n] * r * gv; }
                const int t = row % SEQ, prow = t >> 6, pcol = t & 63;
                const float sc = isq ? C2 : 1.0f;
#pragma unroll
                for (int hh = 0; hh < 2; ++hh) {
                    const int pos = hh == 0 ? prow : pcol;
                    f32x4 x1 = v[2 * hh], x2 = v[2 * hh + 1], o1, o2;
#pragma unroll
                    for (int j = 0; j < 4; ++j) { const f32x2 cs = rope[pos * 16 + 4 * fq + j];
                        o1[j] = (x1[j] * cs.x - x2[j] * cs.y) * sc; o2[j] = (x2[j] * cs.x + x1[j] * cs.y) * sc; }
                    v[2 * hh] = o1; v[2 * hh + 1] = o2;
                }
            }
            bf16_t* dst;
            if (col0 < 1024) dst = Q + (size_t)row * D + col0;
            else if (col0 < 1280) dst = Kb + (size_t)row * KVP + (col0 - 1024);
            else dst = Vb + (size_t)row * KVP + (col0 - 1280);
#pragma unroll
            for (int n = 0; n < 4; ++n) { u32x2 w; w.x = pk2(v[n].x, v[n].y); w.y = pk2(v[n].z, v[n].w); *(u32x2*)(dst + 16 * n + 4 * fq) = w; }
        }
    }
};
struct EpiRes {
    const float* base; float* out; bf16_t* xb; float* ssq;
    __device__ __forceinline__ void operator()(int row0, int col0, f32x4 (&acc)[2][4], int fr, int fq) const {
#pragma unroll
        for (int m = 0; m < 2; ++m) {
            const int row = row0 + 16 * m + fr; float ss = 0.f;
#pragma unroll
            for (int n = 0; n < 4; ++n) { const size_t off = (size_t)row * D + col0 + 16 * n + 4 * fq;
                const f32x4 h = *(const f32x4*)(base + off) + acc[m][n]; *(f32x4*)(out + off) = h;
                ss += (h.x * h.x + h.y * h.y) + (h.z * h.z + h.w * h.w);
                if (xb) { u32x2 w; w.x = pk2(h.x, h.y); w.y = pk2(h.z, h.w); *(u32x2*)(xb + off) = w; } }
            ss += __shfl_xor(ss, 16); ss += __shfl_xor(ss, 32);
            if (ssq && fq == 0) ssq[(size_t)row * 16 + (col0 >> 6)] = ss;
        }
    }
};
struct EpiUp {
    const float* ssq; bf16_t* HB;
    __device__ __forceinline__ void operator()(int row0, int col0, f32x4 (&acc)[2][4], int fr, int fq) const {
#pragma unroll
        for (int m = 0; m < 2; ++m) {
            const int row = row0 + 16 * m + fr; const float rs = rstd_from_slots(ssq, row);
#pragma unroll
            for (int n = 0; n < 4; ++n) { f32x4 v = acc[m][n] * rs;
#pragma unroll
                for (int j = 0; j < 4; ++j) { const float t = fmaxf(v[j], 0.f); v[j] = t * t; }
                u32x2 w; w.x = pk2(v.x, v.y); w.y = pk2(v.z, v.w); *(u32x2*)(HB + (size_t)row * FF + col0 + 16 * n + 4 * fq) = w; }
        }
    }
};
struct EpiGin {
    const float* ssq; bf16_t* q; bf16_t* k; bf16_t* v; bf16_t* r;
    __device__ __forceinline__ void operator()(int row0, int col0, f32x4 (&acc)[2][4], int fr, int fq) const {
#pragma unroll
        for (int m = 0; m < 2; ++m) {
            const int row = row0 + 16 * m + fr; float rs = rstd_from_slots(ssq, row);
            bf16_t* dst;
            if (col0 < 512) { dst = q + (size_t)row * GQK + col0; rs *= 0.08838834764831845f; }
            else if (col0 < 1024) dst = k + (size_t)row * GQK + (col0 - 512);
            else if (col0 < 2048) dst = v + (size_t)row * GV + (col0 - 1024);
            else dst = r + (size_t)row * GV + (col0 - 2048);
#pragma unroll
            for (int n = 0; n < 4; ++n) { const f32x4 x = acc[m][n] * rs; u32x2 w; w.x = pk2(x.x, x.y); w.y = pk2(x.z, x.w); *(u32x2*)(dst + 16 * n + 4 * fq) = w; }
        }
    }
};
struct EpiZ {
    const float* ssq; float* Z;
    __device__ __forceinline__ void operator()(int row0, int col0, f32x4 (&acc)[2][4], int fr, int fq) const {
#pragma unroll
        for (int m = 0; m < 2; ++m) {
            const int row = row0 + 16 * m + fr; const float rs = rstd_from_slots(ssq, row);
#pragma unroll
            for (int n = 0; n < 4; ++n) *(f32x4*)(Z + (size_t)row * 64 + col0 + 16 * n + 4 * fq) = acc[m][n] * rs;
        }
    }
};

__device__ __forceinline__ void attn_simple(const bf16_t* Q, const bf16_t* Kb, const bf16_t* Vb, bf16_t* O, int gw, int ngw, int lane) {
    const int fr = lane & 15, fq = lane >> 4;
    for (int u = gw; u < BATCH * NH * (SEQ / 16); u += ngw) {
        const int qt = u & 255, h = (u >> 8) & 15, b = u >> 12, kvh = h >> 2;
        const size_t rowbase = (size_t)b * SEQ;
        const bf16_t* Qp = Q + (rowbase + qt * 16 + fr) * D + h * HD + fq * 8;
        bf16x8 qf[2]; qf[0] = *(const bf16x8*)Qp; qf[1] = *(const bf16x8*)(Qp + 32);
        const bf16_t* Kh = Kb + rowbase * KVP + kvh * HD;
        const bf16_t* Vh = Vb + rowbase * KVP + kvh * HD;
        float mrun = -1e30f, lrun = 0.f;
        f32x4 oacc[4];
#pragma unroll
        for (int dt = 0; dt < 4; ++dt) oacc[dt] = (f32x4){0.f, 0.f, 0.f, 0.f};
        for (int kt = 0; kt < SEQ / 64; ++kt) {
            const int key0 = kt * 64;
            f32x4 sT[4];
#pragma unroll
            for (int blk = 0; blk < 4; ++blk) {
                const int key = key0 + 32 * (blk >> 1) + 8 * (fr >> 2) + 4 * (blk & 1) + (fr & 3);
                const bf16_t* kp = Kh + (size_t)key * KVP + fq * 8;
                const bf16x8 k0 = *(const bf16x8*)kp, k1 = *(const bf16x8*)(kp + 32);
                f32x4 z = (f32x4){0.f, 0.f, 0.f, 0.f};
                z = __builtin_amdgcn_mfma_f32_16x16x32_bf16(k0, qf[0], z, 0, 0, 0);
                z = __builtin_amdgcn_mfma_f32_16x16x32_bf16(k1, qf[1], z, 0, 0, 0);
                sT[blk] = z;
            }
            float mx = sT[0][0];
#pragma unroll
            for (int blk = 0; blk < 4; ++blk)
#pragma unroll
                for (int r = 0; r < 4; ++r) mx = fmaxf(mx, sT[blk][r]);
            mx = fmaxf(mx, __shfl_xor(mx, 16)); mx = fmaxf(mx, __shfl_xor(mx, 32));
            const float mnew = fmaxf(mrun, mx), alpha = __builtin_amdgcn_exp2f(mrun - mnew); mrun = mnew;
            float ps = 0.f; bf16x8 pf[2];
#pragma unroll
            for (int ks = 0; ks < 2; ++ks) {
                float p[8];
#pragma unroll
                for (int j = 0; j < 8; ++j) { p[j] = __builtin_amdgcn_exp2f(sT[2 * ks + (j >> 2)][j & 3] - mnew); ps += p[j]; }
                u32x4 w; w.x = pk2(p[0], p[1]); w.y = pk2(p[2], p[3]); w.z = pk2(p[4], p[5]); w.w = pk2(p[6], p[7]);
                pf[ks] = __builtin_bit_cast(bf16x8, w);
            }
            lrun = lrun * alpha + ps;
#pragma unroll
            for (int dt = 0; dt < 4; ++dt) oacc[dt] = oacc[dt] * alpha;
#pragma unroll
            for (int ks = 0; ks < 2; ++ks)
#pragma unroll
                for (int dt = 0; dt < 4; ++dt) {
                    const bf16_t* vp = Vh + (size_t)(key0 + 32 * ks + 8 * fq) * KVP + dt * 16 + fr;
                    bf16x8 vf;
#pragma unroll
                    for (int e = 0; e < 8; ++e) vf[e] = (short)vp[(size_t)e * KVP];
                    oacc[dt] = __builtin_amdgcn_mfma_f32_16x16x32_bf16(vf, pf[ks], oacc[dt], 0, 0, 0);
                }
        }
        lrun += __shfl_xor(lrun, 16); lrun += __shfl_xor(lrun, 32);
        const float inv = 1.0f / lrun;
        bf16_t* Op = O + (rowbase + qt * 16 + fr) * D + h * HD + 4 * fq;
#pragma unroll
        for (int dt = 0; dt < 4; ++dt) { const f32x4 o = oacc[dt] * inv; u32x2 w; w.x = pk2(o.x, o.y); w.y = pk2(o.z, o.w); *(u32x2*)(Op + dt * 16) = w; }
    }
}

__device__ __forceinline__ void gla_pre(const bf16_t* q, const bf16_t* k, const float* Z, const float* wgu, const float* bgate, bf16_t* qe, bf16_t* ke, float* decay, int wg, int nwg, int tid) {
    const int c = tid, h = c >> 7, d = c & 127;
    for (int it = wg; it < BATCH * NCH * 2; it += nwg) {
        const int dir = it & 1, n = (it >> 1) & (NCH - 1), b = it >> 7;
        float w[RANK];
#pragma unroll
        for (int r = 0; r < RANK; ++r) w[r] = wgu[((size_t)dir * RANK + r) * GQK + c];
        const float bg = bgate[dir * GQK + c];
        float bsum = 0.f;
        bf16_t* qed = qe + (size_t)dir * M * GQK; bf16_t* ked = ke + (size_t)dir * M * GQK;
        for (int s = 0; s < CH; ++s) {
            const int i = dir == 0 ? s : (CH - 1 - s);
            const size_t tok = (size_t)b * SEQ + n * CH + i;
            const f32x4* zp = (const f32x4*)(Z + tok * 64 + dir * RANK);
            const f32x4 z0 = zp[0], z1 = zp[1], z2 = zp[2], z3 = zp[3];
            float logit = bg;
            logit += z0.x * w[0] + z0.y * w[1] + z0.z * w[2] + z0.w * w[3];
            logit += z1.x * w[4] + z1.y * w[5] + z1.z * w[6] + z1.w * w[7];
            logit += z2.x * w[8] + z2.y * w[9] + z2.z * w[10] + z2.w * w[11];
            logit += z3.x * w[12] + z3.y * w[13] + z3.z * w[14] + z3.w * w[15];
            const float lg = (fminf(logit, 0.f) - log1pf(expf(-fabsf(logit)))) * (1.0f / 16.0f);
            bsum += lg;
            const float eb = expf(bsum), enb = expf(-bsum);
            qed[tok * GQK + c] = (bf16_t)f2bf(bf2f(q[tok * GQK + c]) * eb);
            ked[tok * GQK + c] = (bf16_t)f2bf(bf2f(k[tok * GQK + c]) * enb);
        }
        decay[((((size_t)b * GH + h) * 2 + dir) * NCH + n) * GDK + d] = expf(bsum);
    }
}

__device__ __forceinline__ void gla_scan_simple(const bf16_t* qe, const bf16_t* ke, const bf16_t* v, const float* decay, bf16_t* of, bf16_t* ob, LAS unsigned char* lds, int wg, int nwg, int tid) {
    LAS float* qeL = (LAS float*)lds;
    LAS float* keL = qeL + 64 * 129;
    LAS float* vL = keL + 64 * 129;
    LAS float* AL = vL + 64 * 33;
    LAS float* SL = AL + 64 * 65;
    LAS float* dL = SL + 128 * 33;
    for (int it = wg; it < BATCH * GH * 2 * 8; it += nwg) {
        const int js = it & 7, dir = (it >> 3) & 1, h = (it >> 4) & 3, b = it >> 6;
        const bf16_t* qed = qe + (size_t)dir * M * GQK; const bf16_t* ked = ke + (size_t)dir * M * GQK;
        bf16_t* od = dir == 0 ? of : ob;
        for (int e = tid; e < 128 * 33; e += NTHREADS) SL[e] = 0.f;
        __syncthreads();
        for (int st = 0; st < NCH; ++st) {
            const int n = dir == 0 ? st : (NCH - 1 - st);
            const size_t tok0 = (size_t)b * SEQ + n * CH;
            {
                const int i = tid >> 3, ds = (tid & 7) * 16;
                const u32x4* qp = (const u32x4*)(qed + (tok0 + i) * GQK + h * GDK + ds);
                const u32x4* kp = (const u32x4*)(ked + (tok0 + i) * GQK + h * GDK + ds);
#pragma unroll
                for (int hh = 0; hh < 2; ++hh) { const u32x4 a = qp[hh], c = kp[hh];
#pragma unroll
                    for (int j = 0; j < 4; ++j) { qeL[i * 129 + ds + hh * 8 + 2 * j] = bflo(a[j]); qeL[i * 129 + ds + hh * 8 + 2 * j + 1] = bfhi(a[j]);
                                                  keL[i * 129 + ds + hh * 8 + 2 * j] = bflo(c[j]); keL[i * 129 + ds + hh * 8 + 2 * j + 1] = bfhi(c[j]); } }
                if (tid < 256) { const int iv = tid >> 2, vs = (tid & 3) * 8;
                    const u32x4 a = *(const u32x4*)(v + (tok0 + iv) * GV + h * GDV + js * 32 + vs);
#pragma unroll
                    for (int j = 0; j < 4; ++j) { vL[iv * 33 + vs + 2 * j] = bflo(a[j]); vL[iv * 33 + vs + 2 * j + 1] = bfhi(a[j]); } }
                if (tid < 128) dL[tid] = decay[((((size_t)b * GH + h) * 2 + dir) * NCH + n) * GDK + tid];
            }
            __syncthreads();
            {
                const int i = tid >> 3, jg = tid & 7;
                float a[8];
#pragma unroll
                for (int e = 0; e < 8; ++e) a[e] = 0.f;
                for (int d = 0; d < GDK; ++d) { const float qv = qeL[i * 129 + d];
#pragma unroll
                    for (int e = 0; e < 8; ++e) a[e] += qv * keL[(jg + 8 * e) * 129 + d]; }
#pragma unroll
                for (int e = 0; e < 8; ++e) { const int j = jg + 8 * e; const bool keep = dir == 0 ? (j <= i) : (j >= i); AL[i * 65 + j] = keep ? a[e] : 0.f; }
            }
            __syncthreads();
            {
                const int i = tid >> 3, vg = (tid & 7) * 4;
                float o[4] = {0.f, 0.f, 0.f, 0.f};
                for (int j = 0; j < CH; ++j) { const float a = AL[i * 65 + j];
#pragma unroll
                    for (int e = 0; e < 4; ++e) o[e] += a * vL[j * 33 + vg + e]; }
                for (int d = 0; d < GDK; ++d) { const float qv = qeL[i * 129 + d];
#pragma unroll
                    for (int e = 0; e < 4; ++e) o[e] += qv * SL[d * 33 + vg + e]; }
                u32x2 w; w.x = pk2(o[0], o[1]); w.y = pk2(o[2], o[3]);
                *(u32x2*)(od + (tok0 + i) * GV + h * GDV + js * 32 + vg) = w;
            }
            __syncthreads();
            {
                const int d = tid >> 2, vg = (tid & 3) * 8;
                float s[8];
#pragma unroll
                for (int e = 0; e < 8; ++e) s[e] = SL[d * 33 + vg + e];
                for (int j = 0; j < CH; ++j) { const float kv = keL[j * 129 + d];
#pragma unroll
                    for (int e = 0; e < 8; ++e) s[e] += kv * vL[j * 33 + vg + e]; }
                const float dc = dL[d];
#pragma unroll
                for (int e = 0; e < 8; ++e) SL[d * 33 + vg + e] = dc * s[e];
            }
            __syncthreads();
        }
    }
}

__device__ __forceinline__ void gla_combine(bf16_t* of, const bf16_t* ob, const bf16_t* r, const float* og, int gw, int ngw, int lane) {
    for (int row = gw; row < M; row += ngw) {
        const size_t off = (size_t)row * GV + lane * 16;
        const u32x4 a0 = *(const u32x4*)(of + off), a1 = *(const u32x4*)(of + off + 8);
        const u32x4 b0 = *(const u32x4*)(ob + off), b1 = *(const u32x4*)(ob + off + 8);
        const u32x4 r0 = *(const u32x4*)(r + off), r1 = *(const u32x4*)(r + off + 8);
        float o[16], rr[16];
#pragma unroll
        for (int j = 0; j < 4; ++j) { o[2 * j] = bflo(a0[j]) + bflo(b0[j]); o[2 * j + 1] = bfhi(a0[j]) + bfhi(b0[j]); o[8 + 2 * j] = bflo(a1[j]) + bflo(b1[j]); o[8 + 2 * j + 1] = bfhi(a1[j]) + bfhi(b1[j]);
            rr[2 * j] = bflo(r0[j]); rr[2 * j + 1] = bfhi(r0[j]); rr[8 + 2 * j] = bflo(r1[j]); rr[8 + 2 * j + 1] = bfhi(r1[j]); }
        float ss = 0.f;
#pragma unroll
        for (int j = 0; j < 16; ++j) ss += o[j] * o[j];
        ss += __shfl_xor(ss, 1); ss += __shfl_xor(ss, 2); ss += __shfl_xor(ss, 4); ss += __shfl_xor(ss, 8);
        const float rs = 1.0f / sqrtf(ss * (1.0f / GDV) + EPS);
        const int dv0 = (lane & 15) * 16;
        float g[16];
#pragma unroll
        for (int j = 0; j < 16; ++j) { const float y = o[j] * rs * og[dv0 + j]; const float x = rr[j]; g[j] = y * x / (1.0f + __expf(-x)); }
        u32x4 w0, w1;
#pragma unroll
        for (int j = 0; j < 4; ++j) { w0[j] = pk2(g[2 * j], g[2 * j + 1]); w1[j] = pk2(g[8 + 2 * j], g[8 + 2 * j + 1]); }
        *(u32x4*)(of + off) = w0; *(u32x4*)(of + off + 8) = w1;
    }
}

struct Args { const float* in[15]; float* out; unsigned char* ws; int ph_lo, ph_hi; };
static_assert(sizeof(Args) == 15 * 8 + 8 + 8 + 8, "Args has no padding");

__global__ void __launch_bounds__(NTHREADS, 2) fwd_kernel(Args args) {
    extern __shared__ __attribute__((aligned(16))) unsigned char lds_raw[];
    LAS unsigned char* lds = (LAS unsigned char*)lds_raw;
    const int tid = threadIdx.x, lane = tid & 63, wave = __builtin_amdgcn_readfirstlane(tid >> 6);
    const int G = gridDim.x, wg = blockIdx.x;
    const int gw = wg * NWAVES + wave, ngw = G * NWAVES;
    unsigned char* ws = args.ws;
    const float* x = args.in[0]; const float* norm_mix = args.in[1]; const float* norm_mlp = args.in[2];
    const float* attn_w_qkv = args.in[3]; const float* attn_qn = args.in[4]; const float* attn_kn = args.in[5]; const float* attn_w_o = args.in[6];
    const float* gla_w_in = args.in[7]; const float* gla_wgu = args.in[8]; const float* gla_bg = args.in[9]; const float* gla_on = args.in[10]; const float* gla_w_o = args.in[11];
    const float* mlp_w_in = args.in[12]; const float* mlp_w_out = args.in[13]; const float* final_norm = args.in[14];
    float* out = args.out;
    f32x2* ROPE = (f32x2*)(ws + WS_ROPE);
    float* SSQ0 = (float*)(ws + WS_SSQ); float* SSQ1 = SSQ0 + (size_t)M * 16; float* SSQ2 = SSQ1 + (size_t)M * 16; float* SSQ3 = SSQ2 + (size_t)M * 16;
    float* Zb = (float*)(ws + WS_Z); float* DEC = (float*)(ws + WS_DECAY);
    bf16_t* Wqkv = (bf16_t*)(ws + W_QKV); bf16_t* Wo0 = (bf16_t*)(ws + W_O0); bf16_t* W1a = (bf16_t*)(ws + W_1A); bf16_t* W2a = (bf16_t*)(ws + W_2A);
    bf16_t* Wgin = (bf16_t*)(ws + W_GIN); bf16_t* Wo1 = (bf16_t*)(ws + W_O1); bf16_t* W1b = (bf16_t*)(ws + W_1B); bf16_t* W2b = (bf16_t*)(ws + W_2B);
    bf16_t* XB = (bf16_t*)(ws + WS_XB);
    bf16_t* Qb = (bf16_t*)(ws + WS_BIG); bf16_t* Kb = (bf16_t*)(ws + WS_BIG + 32 * MiB); bf16_t* Vb = (bf16_t*)(ws + WS_BIG + 40 * MiB);
    bf16_t* HB = (bf16_t*)(ws + WS_BIG);
    bf16_t* Gv = (bf16_t*)(ws + WS_BIG); bf16_t* Gr = (bf16_t*)(ws + WS_BIG + 32 * MiB); bf16_t* Gqe = (bf16_t*)(ws + WS_BIG + 64 * MiB); bf16_t* Gke = (bf16_t*)(ws + WS_BIG + 96 * MiB);
    bf16_t* Gq = (bf16_t*)(ws + WS_QK); bf16_t* Gk = (bf16_t*)(ws + WS_QK + 16 * MiB);
    bf16_t* Gof = (bf16_t*)(ws + WS_QK); bf16_t* Gob = (bf16_t*)(ws + WS_XB);

    for (int u = tid; u < (LDS_BYTES - LDSCTL_OFF) / 4; u += NTHREADS) ((LAS unsigned*)(lds + LDSCTL_OFF))[u] = 0u;
    __syncthreads();
    volatile LAS unsigned* MISC = (volatile LAS unsigned*)(lds + MISC_OFF);
    const int lo = args.ph_lo, hi = args.ph_hi;
    const bool multi = (hi - lo) > 1;
    XcdBarrier bar; bar.bar = (unsigned*)(ws + WS_CTL) + 4096; bar.x = 0; bar.st = nullptr;
    if (multi) bar = xcd_barrier_post((unsigned*)(ws + WS_CTL) + 4096, MISC + 8);
#define IN(k) (lo <= (k) && (k) < hi)
#define SEAM(k) do { if (IN(k) && IN((k) + 1)) xcd_barrier(bar); } while (0)

    if (IN(0)) {
        LAS float* scr = (LAS float*)(lds + wave * 16384);
        constexpr int I_QKV = 16 * 48, I_O = 16 * 32, I_1 = 16 * 128, I_2 = 64 * 32, I_GIN = 16 * 97;
        constexpr int NITEMS = I_QKV + I_O + I_1 + I_2 + I_GIN + I_O + I_1 + I_2;
        for (int it = gw; it < NITEMS; it += ngw) {
            int r = it;
            if (r < I_QKV) { transpose_item(attn_w_qkv, norm_mix, D, QKV_N, Wqkv, scr, r, lane); continue; } r -= I_QKV;
            if (r < I_O) { transpose_item(attn_w_o, nullptr, D, D, Wo0, scr, r, lane); continue; } r -= I_O;
            if (r < I_1) { transpose_item(mlp_w_in, norm_mlp, D, FF, W1a, scr, r, lane); continue; } r -= I_1;
            if (r < I_2) { transpose_item(mlp_w_out, nullptr, FF, D, W2a, scr, r, lane); continue; } r -= I_2;
            if (r < I_GIN) { transpose_item(gla_w_in, norm_mix + D, D, GIN, Wgin, scr, r, lane); continue; } r -= I_GIN;
            if (r < I_O) { transpose_item(gla_w_o, nullptr, D, D, Wo1, scr, r, lane); continue; } r -= I_O;
            if (r < I_1) { transpose_item(mlp_w_in + (size_t)D * FF, norm_mlp + D, D, FF, W1b, scr, r, lane); continue; } r -= I_1;
            transpose_item(mlp_w_out + (size_t)FF * D, nullptr, FF, D, W2b, scr, r, lane);
        }
        for (int e = gw * 64 + lane; e < 32 * D / 8; e += ngw * 64) *(u32x4*)(Wgin + (size_t)GIN * D + (size_t)e * 8) = (u32x4){0u, 0u, 0u, 0u};
        for (int m = gw; m < M; m += ngw) {
            const f32x4* xr = (const f32x4*)(x + (size_t)m * D) + lane;
            f32x4 v[4]; float s = 0.f;
#pragma unroll
            for (int j = 0; j < 4; ++j) { v[j] = xr[64 * j]; s += (v[j].x * v[j].x + v[j].y * v[j].y) + (v[j].z * v[j].z + v[j].w * v[j].w); }
            s = wave_sum(s);
            u32x2* o8 = (u32x2*)(XB + (size_t)m * D) + lane;
#pragma unroll
            for (int j = 0; j < 4; ++j) { u32x2 w; w.x = pk2(v[j].x, v[j].y); w.y = pk2(v[j].z, v[j].w); o8[64 * j] = w; }
            if (lane < 16) SSQ0[(size_t)m * 16 + lane] = lane == 0 ? s : 0.f;
        }
        if (wg == 0) {
            for (int e = tid; e < 64 * 16; e += NTHREADS) {
                const int pos = e >> 4, i = e & 15;
                const double base4[4] = {1.0, 0.56234132519034908, 0.31622776601683794, 0.17782794100389228};
                double invd = (i & 3) == 0 ? base4[0] : (i & 3) == 1 ? base4[1] : (i & 3) == 2 ? base4[2] : base4[3];
                invd *= (i >> 2) == 0 ? 1.0 : (i >> 2) == 1 ? 0.1 : (i >> 2) == 2 ? 0.01 : 0.001;
                const float invf = (float)invd; const float ang = (float)pos * invf;
                double s, c; sincos_d((double)ang, s, c);
                ROPE[e] = (f32x2){(float)c, (float)s};
            }
        }
    }
    SEAM(0);
    if (IN(1)) { EpiQKV E{SSQ0, attn_qn, attn_kn, ROPE, Qb, Kb, Vb}; gemm_simple(XB, Wqkv, M, QKV_N, D, E, gw, ngw, lane); }
    SEAM(1);
    if (IN(2)) attn_simple(Qb, Kb, Vb, Qb, gw, ngw, lane);
    SEAM(2);
    if (IN(3)) { EpiRes E{x, out, XB, SSQ1}; gemm_simple(Qb, Wo0, M, D, D, E, gw, ngw, lane); }
    SEAM(3);
    if (IN(4)) { EpiUp E{SSQ1, HB}; gemm_simple(XB, W1a, M, FF, D, E, gw, ngw, lane); }
    SEAM(4);
    if (IN(5)) { EpiRes E{out, out, XB, SSQ2}; gemm_simple(HB, W2a, M, D, FF, E, gw, ngw, lane); }
    SEAM(5);
    if (IN(6)) { EpiGin E{SSQ2, Gq, Gk, Gv, Gr}; gemm_simple(XB, Wgin, M, 3072, D, E, gw, ngw, lane);
                 EpiZ Ez{SSQ2, Zb}; gemm_simple(XB, Wgin + (size_t)3072 * D, M, 64, D, Ez, gw, ngw, lane); }
    SEAM(6);
    if (IN(7)) gla_pre(Gq, Gk, Zb, gla_wgu, gla_bg, Gqe, Gke, DEC, wg, G, tid);
    SEAM(7);
    if (IN(8)) gla_scan_simple(Gqe, Gke, Gv, DEC, Gof, Gob, lds, wg, G, tid);
    SEAM(8);
    if (IN(9)) gla_combine(Gof, Gob, Gr, gla_on, gw, ngw, lane);
    SEAM(9);
    if (IN(10)) { EpiRes E{out, out, XB, SSQ3}; gemm_simple(Gof, Wo1, M, D, D, E, gw, ngw, lane); }
    SEAM(10);
    if (IN(11)) { EpiUp E{SSQ3, HB}; gemm_simple(XB, W1b, M, FF, D, E, gw, ngw, lane); }
    SEAM(11);
    if (IN(12)) { EpiRes E{out, out, nullptr, nullptr}; gemm_simple(HB, W2b, M, D, FF, E, gw, ngw, lane); }
    SEAM(12);
    if (IN(13)) {
        for (int m = gw; m < M; m += ngw) {
            f32x4* xr = (f32x4*)(out + (size_t)m * D) + lane;
            f32x4 v[4]; float s = 0.f;
#pragma unroll
            for (int j = 0; j < 4; ++j) { v[j] = xr[64 * j]; s += (v[j].x * v[j].x + v[j].y * v[j].y) + (v[j].z * v[j].z + v[j].w * v[j].w); }
            s = wave_sum(s);
            const float rs = 1.0f / sqrtf(s * (1.0f / D) + EPS);
#pragma unroll
            for (int j = 0; j < 4; ++j) { const f32x4 g = *((const f32x4*)final_norm + lane + 64 * j); xr[64 * j] = v[j] * rs * g; }
        }
    }
#undef IN
#undef SEAM
}

#ifndef MK_SINGLE
#define MK_SINGLE 1
#endif
extern "C" void kernel_launch(void* const* d_in, const int* in_sizes, int n_in, void* d_out, int out_size, void* d_ws, size_t ws_size, hipStream_t stream) {
    static int grid = 0;
    if (grid == 0) {
        if (n_in != 15 || in_sizes[0] != M * D || out_size != M * D || ws_size < WS_END) { fprintf(stderr, "kernel_launch: unexpected shapes (n_in %d, in0 %d, out %d, ws %zu)\n", n_in, n_in > 0 ? in_sizes[0] : -1, out_size, ws_size); grid = -1; return; }
        int dev = 0, cus = 0, per_cu = 0;
        if (hipGetDevice(&dev) != hipSuccess || hipDeviceGetAttribute(&cus, hipDeviceAttributeMultiprocessorCount, dev) != hipSuccess) { grid = -1; return; }
        if (hipFuncSetAttribute((const void*)fwd_kernel, hipFuncAttributeMaxDynamicSharedMemorySize, LDS_BYTES) != hipSuccess) { fprintf(stderr, "kernel_launch: hipFuncSetAttribute failed\n"); grid = -1; return; }
        if (hipOccupancyMaxActiveBlocksPerMultiprocessor(&per_cu, (const void*)fwd_kernel, NTHREADS, LDS_BYTES) != hipSuccess || per_cu < 1) { fprintf(stderr, "kernel_launch: occupancy query says %d\n", per_cu); }
        (void)hipGetLastError();
        grid = cus;
    }
    if (grid < 0) return;
    (void)hipMemsetAsync((char*)d_ws + WS_CTL, 0, CTL_ZERO_BYTES, stream);
    Args a{};
    for (int i = 0; i < 15; ++i) a.in[i] = (const float*)d_in[i];
    a.out = (float*)d_out; a.ws = (unsigned char*)d_ws;
#if MK_SINGLE
    a.ph_lo = 0; a.ph_hi = NPHASES;
    hipLaunchKernelGGL(fwd_kernel, dim3(grid), dim3(NTHREADS), LDS_BYTES, stream, a);
#else
    for (int p = 0; p < NPHASES; ++p) { a.ph_lo = p; a.ph_hi = p + 1; hipLaunchKernelGGL(fwd_kernel, dim3(grid), dim3(NTHREADS), LDS_BYTES, stream, a); }
#endif
}
```

```cpp
#include <hip/hip_runtime.h>
#include <cstdio>
#include <cstdint>

#define GAS __attribute__((address_space(1)))
#define LAS __attribute__((address_space(3)))
typedef unsigned short bf16_t;
typedef short bf16x8 __attribute__((ext_vector_type(8)));
typedef float f32x4 __attribute__((ext_vector_type(4)));
typedef float f32x2 __attribute__((ext_vector_type(2)));
typedef unsigned u32x4 __attribute__((ext_vector_type(4)));
typedef unsigned u32x2 __attribute__((ext_vector_type(2)));

constexpr int BATCH = 4, SEQ = 4096, D = 1024, M = BATCH * SEQ;
constexpr int NH = 16, NKV = 4, HD = 64, QKV_N = 1536, KVP = NKV * HD;
constexpr int GH = 4, GDK = 128, GDV = 256, GQK = 512, GV = 1024, RANK = 16, GIN = 3104, CH = 64, NCH = SEQ / CH;
constexpr int FF = 4096;
constexpr float EPS = 1e-6f;
constexpr float C2 = 0.125f * 1.4426950408889634f;
constexpr int NWAVES = 8, NTHREADS = 512;
constexpr int NPHASES = 14;

constexpr size_t MiB = 1u << 20;
constexpr size_t WS_CTL = 0, CTL_ZERO_BYTES = 1 * MiB;
constexpr size_t WS_ROPE = 1 * MiB;
constexpr size_t WS_SSQ = 2 * MiB;
constexpr size_t WS_Z = 7 * MiB;
constexpr size_t WS_DECAY = 11 * MiB;
constexpr size_t WS_W = 12 * MiB;
constexpr size_t W_QKV = WS_W, W_O0 = W_QKV + 3 * MiB, W_1A = W_O0 + 2 * MiB, W_2A = W_1A + 8 * MiB, W_GIN = W_2A + 8 * MiB,
                 W_O1 = W_GIN + 6 * MiB + 128 * 1024, W_1B = W_O1 + 2 * MiB, W_2B = W_1B + 8 * MiB, W_END = W_2B + 8 * MiB;
constexpr size_t WS_XB = 58 * MiB;
constexpr size_t WS_BIG = 90 * MiB;
constexpr size_t WS_QK = 218 * MiB;
constexpr size_t WS_END = 250 * MiB;
static_assert(W_END <= WS_XB, "weights fit");

__device__ __forceinline__ unsigned f2bf(float f) { unsigned u = __builtin_bit_cast(unsigned, f); return (u + 0x7fffu + ((u >> 16) & 1u)) >> 16; }
__device__ __forceinline__ unsigned pk2(float lo, float hi) { return f2bf(lo) | (f2bf(hi) << 16); }
__device__ __forceinline__ float bf2f(unsigned short u) { return __uint_as_float((unsigned)u << 16); }
__device__ __forceinline__ float bflo(unsigned w) { return __uint_as_float(w << 16); }
__device__ __forceinline__ float bfhi(unsigned w) { return __uint_as_float(w & 0xffff0000u); }
#define LDS_WAIT() asm volatile("s_waitcnt lgkmcnt(0)" ::: "memory")
#define VM_WAIT() asm volatile("s_waitcnt vmcnt(0)" ::: "memory")
__device__ __forceinline__ float wave_sum(float v) {
#pragma unroll
    for (int o = 1; o < 64; o <<= 1) v += __shfl_xor(v, o);
    return v;
}
__device__ __forceinline__ float rstd_from_slots(const float* ssq, int row) {
    const f32x4* p = (const f32x4*)(ssq + (size_t)row * 16);
    const f32x4 a = p[0], b = p[1], c = p[2], d = p[3];
    const float s = (((a.x + a.y) + (a.z + a.w)) + ((b.x + b.y) + (b.z + b.w))) + (((c.x + c.y) + (c.z + c.w)) + ((d.x + d.y) + (d.z + d.w)));
    return 1.0f / sqrtf(s * (1.0f / D) + EPS);
}

#define RLX_AGENT __ATOMIC_RELAXED, __HIP_MEMORY_SCOPE_AGENT
#define XB_TMO      128
#define XB_XCNT(j)  (256  + 64 * (j))
#define XB_XSUB(j)  (1280 + 64 * (j))
#define XB_XGEN(j)  (2304 + 64 * (j))
#define XB_TOP      3328
#define XB_TOPGEN   3392
#define XCD_BAR_WORDS 3456
#define XB_SPIN_CAP (1u << 22)
__device__ __forceinline__ unsigned xb_ld(unsigned* p)              { return __hip_atomic_load(p, __ATOMIC_RELAXED, __HIP_MEMORY_SCOPE_AGENT); }
__device__ __forceinline__ unsigned xb_add(unsigned* p, unsigned v) { return __hip_atomic_fetch_add(p, v, __ATOMIC_RELAXED, __HIP_MEMORY_SCOPE_AGENT); }
__device__ __forceinline__ unsigned xb_xcc_id() { return (unsigned)__builtin_amdgcn_s_getreg((3 << 11) | 20) & 0xFu; }
#define XB_SPIN(cond, bar) do { unsigned _sp = 0; while (cond) { __builtin_amdgcn_s_sleep(1); \
    if ((++_sp & 255u) == 0u) { if (xb_ld(&(bar)[XB_TMO])) break; if (_sp > XB_SPIN_CAP) { atomicAdd(&(bar)[XB_TMO], 1u); break; } } } } while (0)
struct XcdBarrier { unsigned* bar; unsigned x; volatile LAS unsigned* st; };
__device__ __forceinline__ XcdBarrier xcd_barrier_post(unsigned* bar, volatile LAS unsigned* st) {
    XcdBarrier b; b.bar = bar; b.x = xb_xcc_id(); b.st = st;
    if (threadIdx.x == 0) (void)xb_add(&bar[XB_XCNT(b.x)], 1u);
    return b;
}
__device__ __forceinline__ void xcd_barrier_complete(unsigned* bar, unsigned x, unsigned& nloc, unsigned& nx) {
    const unsigned G = gridDim.x * gridDim.y * gridDim.z;
    unsigned sum, cnt, mine, sp = 0u;
    for (;;) {
        sum = 0u; cnt = 0u; mine = 0u;
#pragma unroll
        for (unsigned j = 0; j < 16; ++j) { const unsigned c = xb_ld(&bar[XB_XCNT(j)]); sum += c; cnt += (c > 0u) ? 1u : 0u; mine = (j == x) ? c : mine; }
        if (sum == G) break;
        __builtin_amdgcn_s_sleep(1);
        if ((++sp & 255u) == 0u) { if (xb_ld(&bar[XB_TMO])) break; if (sp > XB_SPIN_CAP) { atomicAdd(&bar[XB_TMO], 1u); break; } }
    }
    nloc = mine > 0u ? mine : 1u; nx = cnt > 0u ? cnt : 1u;
}
__device__ __forceinline__ void xcd_barrier(const XcdBarrier& b) {
    asm volatile("s_waitcnt vmcnt(0)" ::: "memory");
    __syncthreads();
    if (threadIdx.x == 0) {
        unsigned* bar = b.bar;
        __builtin_amdgcn_s_waitcnt(0);
        unsigned nloc = b.st[0], nx = b.st[1];
        if (nloc == 0u) { xcd_barrier_complete(bar, b.x, nloc, nx); b.st[0] = nloc; b.st[1] = nx; }
        const unsigned old = xb_add(&bar[XB_XSUB(b.x)], 1u);
        const unsigned gen = old / nloc;
        if (old + 1u == (gen + 1u) * nloc) {
            __builtin_amdgcn_fence(__ATOMIC_RELEASE, "agent");
            asm volatile("s_waitcnt vmcnt(0)" ::: "memory");
            const unsigned og = xb_add(&bar[XB_TOP], 1u);
            const unsigned tg = og / nx;
            if (og + 1u == (tg + 1u) * nx) xb_add(&bar[XB_TOPGEN], 1u);
            else XB_SPIN(xb_ld(&bar[XB_TOPGEN]) == tg, bar);
            __builtin_amdgcn_fence(__ATOMIC_ACQUIRE, "agent");
            xb_add(&bar[XB_XGEN(b.x)], 1u);
            asm volatile("s_waitcnt vmcnt(0)" ::: "memory");
        } else {
            XB_SPIN(xb_ld(&bar[XB_XGEN(b.x)]) == gen, bar);
            __builtin_amdgcn_fence(__ATOMIC_ACQUIRE, "agent");
            asm volatile("s_waitcnt vmcnt(0)" ::: "memory");
        }
    }
    __syncthreads();
}

constexpr int RING_BYTES = 131072;
constexpr int LDSCTL_OFF = RING_BYTES, MISC_OFF = LDSCTL_OFF + 320;
constexpr int LDS_BYTES = 147456;

namespace pg8 {
#define PG8_LAS __attribute__((address_space(3)))
typedef unsigned short bf16_t;
typedef short bf16x8 __attribute__((ext_vector_type(8)));
typedef float f32x4 __attribute__((ext_vector_type(4)));
typedef unsigned u32x4 __attribute__((ext_vector_type(4)));
constexpr int BM = 256, BK = 64, HALF = 128, HTB = HALF * BK * 2  , STAGE_BYTES = 8 * HTB, NXCD = 8, WGM = 8;

__host__ __device__ __forceinline__ int lds_byte(int r, int c) { const int st = (r >> 4) * 2 + (c >> 5), rr = r & 15, cc = c & 31, ob = rr * 64 + cc * 2; return st * 1024 + (ob ^ (((ob >> 9) & 1) << 5)); }
__host__ __device__ __forceinline__ void stage_rc(int b, int& R, int& C) { const int st = b / 1024, sb = b % 1024, swz = sb ^ (((sb >> 9) & 1) << 5); R = (st >> 1) * 16 + swz / 64; C = (st & 1) * 32 + (swz % 64) / 2; }
__host__ __device__ __forceinline__ int perm32(int rho) { const int n = rho >> 4, i = rho & 15; return 8 * (i >> 2) + 4 * n + (i & 3); }

struct Unit { int pm, pn; };
struct Gemm { const bf16_t* A; const bf16_t* Bt; int M, N, K; };

struct StaticOrder {
    int nM, nN, nwg, G, c;
    __host__ __device__ void init(int M, int N, int G_, int c_) { nM = M / BM; nN = N / BM; nwg = nM * nN; G = G_; c = c_; }
    __host__ __device__ bool next(int i, Unit& u) const {
        const long L = (long)i * G + c; if (L >= nwg) return false;
        int wgid = (int)L; { const int q = nwg / NXCD, r = nwg % NXCD, xcd = wgid % NXCD, off = wgid / NXCD; wgid = (xcd < r ? xcd * (q + 1) : r * (q + 1) + (xcd - r) * q) + off; }
        const int nig = WGM * nN, gid = wgid / nig, fm = gid * WGM, gsz = (nM - fm) < WGM ? (nM - fm) : WGM;
        u.pm = fm + ((wgid % nig) % gsz); u.pn = (wgid % nig) / gsz; return true;
    }
    __device__ __forceinline__ void a_ready(const Unit&) const {}
    __device__ __forceinline__ void done(const Unit&) const {}
};
__device__ __forceinline__ unsigned cvt_pk_bf16(float lo, float hi) { unsigned r; asm volatile("v_cvt_pk_bf16_f32 %0, %1, %2" : "=v"(r) : "v"(lo), "v"(hi)); return r; }
typedef float f32x2 __attribute__((ext_vector_type(2)));
template <class Epi, class Sched, bool ALIGN_EPI = false, bool SP2 = false>
__device__ __forceinline__ void gemm_phase(PG8_LAS unsigned char* lds, const Gemm g, const Sched& S, const Epi& E, const int tid) {
    const int wid = __builtin_amdgcn_readfirstlane(tid >> 6), lane = tid & 63, wr = wid >> 2, wc = wid & 3, fr = lane & 15, fq = lane >> 4;
    const int K = g.K, nt = K / BK;
    unsigned voffA[2], voffB[2];
#pragma unroll
    for (int i = 0; i < 2; ++i) { int R, C; stage_rc(tid * 16 + i * 8192, R, C); const int Rb = Epi::BMODE == 1 ? ((R & ~31) + perm32(R & 31)) : Epi::BMODE == 2 ? (64 * (R >> 5) + (R & 31)) : R;
        voffA[i] = (unsigned)(R * K + C) * 2u; voffB[i] = (unsigned)(Rb * K + C) * 2u; }
    const size_t kstep = (size_t)(BK * 2);
    const size_t hstep = (size_t)HALF * K * 2;
    const size_t tstep = 2 * hstep;
    const size_t bhstep = Epi::BMODE == 2 ? (size_t)32 * K * 2 : hstep;
    const unsigned ldsw = (unsigned)wid * 1024u;
    const int aoff = lds_byte(wr * 64 + fr, fq * 8), boff = lds_byte(wc * 32 + fr, fq * 8);
#define PG8_SA(b, h) (((b) * 2 + (h)) * HTB)
#define PG8_SB(b, h) ((4 + (b) * 2 + (h)) * HTB)
#define PG8_STAGE(bufoff, gbase, voff) do { _Pragma("unroll") for (int _i = 0; _i < 2; ++_i) \
        __builtin_amdgcn_global_load_lds((const unsigned*)((const char*)(gbase) + (voff)[_i]), (PG8_LAS unsigned*)(lds + (bufoff) + ldsw + _i * 8192), 16, 0, 0); } while (0)
#define PG8_LDA(dst, b, h) do { _Pragma("unroll") for (int m = 0; m < 4; ++m) _Pragma("unroll") for (int k = 0; k < 2; ++k) dst[m][k] = *(const PG8_LAS bf16x8*)(lds + PG8_SA(b, h) + aoff + m * 2048 + k * 1024); } while (0)
#define PG8_LDB(dst, b, h) do { _Pragma("unroll") for (int n = 0; n < 2; ++n) _Pragma("unroll") for (int k = 0; k < 2; ++k) dst[n][k] = *(const PG8_LAS bf16x8*)(lds + PG8_SB(b, h) + boff + n * 2048 + k * 1024); } while (0)
#define PG8_MMA(ai, bj, At, Bt) do { __builtin_amdgcn_s_setprio(1); _Pragma("unroll") for (int m = 0; m < 4; ++m) _Pragma("unroll") for (int n = 0; n < 2; ++n) _Pragma("unroll") for (int k = 0; k < 2; ++k) \
        acc[ai][bj][m][n] = __builtin_amdgcn_mfma_f32_16x16x32_bf16(Bt[n][k], At[m][k], acc[ai][bj][m][n], 0, 0, 0); __builtin_amdgcn_s_setprio(0); } while (0)
#define PG8_WAIT_V(n) asm volatile("s_waitcnt vmcnt(" #n ")" ::: "memory")
#define PG8_WAIT_L(n) asm volatile("s_waitcnt lgkmcnt(" #n ")" ::: "memory")
#define PG8_BAR __builtin_amdgcn_s_barrier()
#define PG8_SCHED __builtin_amdgcn_sched_barrier(0)
    Unit cur, nxt; int ui = 0;
    if (!S.next(0, cur)) return;
    f32x4 acc[2][2][4][2];
#pragma unroll
    for (int a = 0; a < 2; ++a)
#pragma unroll
        for (int b = 0; b < 2; ++b)
#pragma unroll
            for (int m = 0; m < 4; ++m)
#pragma unroll
                for (int n = 0; n < 2; ++n) acc[a][b][m][n] = (f32x4){0.f, 0.f, 0.f, 0.f};
    bf16x8 At[4][2], B0[2][2], B1[2][2];
    const char* cA = (const char*)g.A + (size_t)cur.pm * tstep; const char* cB = (const char*)g.Bt + (size_t)cur.pn * tstep;
    S.a_ready(cur);
    if constexpr (SP2) {
        PG8_STAGE(PG8_SB(0, 0), cB, voffB); PG8_STAGE(PG8_SB(0, 1), cB + bhstep, voffB); PG8_STAGE(PG8_SA(0, 0), cA, voffA); PG8_STAGE(PG8_SA(0, 1), cA + hstep, voffA);
        if (wr == 1) PG8_BAR;
        PG8_WAIT_V(2); PG8_BAR;
        PG8_STAGE(PG8_SB(1, 0), cB + kstep, voffB); PG8_STAGE(PG8_SA(1, 0), cA + kstep, voffA); PG8_STAGE(PG8_SB(1, 1), cB + bhstep + kstep, voffB);
        PG8_WAIT_V(6); PG8_BAR;
    } else {
        PG8_STAGE(PG8_SB(0, 0), cB, voffB); PG8_STAGE(PG8_SA(0, 0), cA, voffA); PG8_STAGE(PG8_SB(0, 1), cB + bhstep, voffB); PG8_STAGE(PG8_SA(0, 1), cA + hstep, voffA);
        if (wr == 1) PG8_BAR;
        PG8_WAIT_V(4); PG8_BAR;
        PG8_STAGE(PG8_SB(1, 0), cB + kstep, voffB); PG8_STAGE(PG8_SA(1, 0), cA + kstep, voffA); PG8_STAGE(PG8_SB(1, 1), cB + bhstep + kstep, voffB);
        PG8_WAIT_V(6); PG8_BAR;
    }
    for (;;) {
        const bool has_next = S.next(ui + 1, nxt);
        const char* nA = has_next ? (const char*)g.A + (size_t)nxt.pm * tstep : cA; const char* nB = has_next ? (const char*)g.Bt + (size_t)nxt.pn * tstep : cB;
        for (int t = 0; t < nt; t += 2) {
            const bool last = (t == nt - 2);
            const char* a1 = cA + (size_t)(t + 1) * kstep;
            const char* a2 = last ? nA : cA + (size_t)(t + 2) * kstep; const char* b2 = last ? nB : cB + (size_t)(t + 2) * kstep;
            const char* a3 = a2 + kstep; const char* b3 = b2 + kstep;
            if (last && has_next) S.a_ready(nxt);
            if constexpr (SP2) {
            PG8_LDB(B0, 0, 0); PG8_LDB(B1, 0, 1); PG8_SCHED; PG8_LDA(At, 0, 0); PG8_STAGE(PG8_SA(1, 1), a1 + hstep, voffA);
            PG8_WAIT_V(8); PG8_WAIT_L(0); PG8_BAR; PG8_MMA(0, 0, At, B0); PG8_MMA(0, 1, At, B1); PG8_BAR; PG8_SCHED;
            PG8_LDA(At, 0, 1); PG8_STAGE(PG8_SB(0, 0), b2, voffB); PG8_STAGE(PG8_SB(0, 1), b2 + bhstep, voffB); PG8_STAGE(PG8_SA(0, 0), a2, voffA);
            PG8_WAIT_V(8); PG8_WAIT_L(0); PG8_BAR; PG8_MMA(1, 0, At, B0); PG8_MMA(1, 1, At, B1); PG8_BAR; PG8_SCHED;
            PG8_LDB(B0, 1, 0); PG8_LDB(B1, 1, 1); PG8_SCHED; PG8_LDA(At, 1, 0); PG8_STAGE(PG8_SA(0, 1), a2 + hstep, voffA);
            PG8_WAIT_V(8); PG8_WAIT_L(0); PG8_BAR; PG8_MMA(0, 0, At, B0); PG8_MMA(0, 1, At, B1); PG8_BAR; PG8_SCHED;
            PG8_LDA(At, 1, 1); PG8_STAGE(PG8_SB(1, 0), b3, voffB); PG8_STAGE(PG8_SB(1, 1), b3 + bhstep, voffB); PG8_STAGE(PG8_SA(1, 0), a3, voffA);
            PG8_WAIT_V(8); PG8_WAIT_L(0); PG8_BAR; PG8_MMA(1, 0, At, B0); PG8_MMA(1, 1, At, B1); PG8_BAR; PG8_SCHED;
            } else {
            PG8_LDB(B0, 0, 0); PG8_SCHED; PG8_LDA(At, 0, 0); PG8_STAGE(PG8_SA(1, 1), a1 + hstep, voffA);
            PG8_WAIT_L(8); PG8_BAR; PG8_WAIT_L(0); PG8_MMA(0, 0, At, B0); PG8_BAR; PG8_SCHED;
            PG8_LDB(B1, 0, 1); PG8_STAGE(PG8_SB(0, 0), b2, voffB);
            PG8_BAR; PG8_WAIT_L(0); PG8_MMA(0, 1, At, B1); PG8_BAR;
            PG8_LDA(At, 0, 1); PG8_STAGE(PG8_SA(0, 0), a2, voffA);
            PG8_BAR; PG8_WAIT_L(0); PG8_MMA(1, 0, At, B0); PG8_BAR; PG8_SCHED;
            PG8_STAGE(PG8_SB(0, 1), b2 + bhstep, voffB);
            PG8_WAIT_V(6); PG8_BAR; PG8_MMA(1, 1, At, B1); PG8_BAR;
            PG8_LDB(B0, 1, 0); PG8_SCHED; PG8_LDA(At, 1, 0); PG8_STAGE(PG8_SA(0, 1), a2 + hstep, voffA);
            PG8_WAIT_L(8); PG8_BAR; PG8_WAIT_L(0); PG8_MMA(0, 0, At, B0); PG8_BAR; PG8_SCHED;
            PG8_LDB(B1, 1, 1); PG8_STAGE(PG8_SB(1, 0), b3, voffB);
            PG8_BAR; PG8_WAIT_L(0); PG8_MMA(0, 1, At, B1); PG8_BAR;
            PG8_LDA(At, 1, 1); PG8_STAGE(PG8_SA(1, 0), a3, voffA);
            PG8_BAR; PG8_WAIT_L(0); PG8_MMA(1, 0, At, B0); PG8_BAR; PG8_SCHED;
            PG8_STAGE(PG8_SB(1, 1), b3 + bhstep, voffB);
            PG8_WAIT_V(6); PG8_BAR; PG8_MMA(1, 1, At, B1); PG8_BAR;
            }
        }
        if constexpr (ALIGN_EPI) { if (wr == 0) PG8_BAR; }
        if constexpr (!Epi::AFTER_DRAIN) { E(acc, cur, wr, wc, fr, fq); S.done(cur); }
        if (!has_next) break;
#pragma unroll
        for (int a = 0; a < 2; ++a)
#pragma unroll
            for (int b = 0; b < 2; ++b)
#pragma unroll
                for (int m = 0; m < 4; ++m)
#pragma unroll
                    for (int n = 0; n < 2; ++n) acc[a][b][m][n] = (f32x4){0.f, 0.f, 0.f, 0.f};
        cur = nxt; cA = nA; cB = nB; ++ui;
        if constexpr (ALIGN_EPI) { if (wr == 1) PG8_BAR; }
    }
    PG8_WAIT_V(0);
    if constexpr (!ALIGN_EPI) { if (wr == 0) PG8_BAR; }
    PG8_BAR;
    if constexpr (Epi::AFTER_DRAIN) { E.fused(acc, cur, wr, wc, fr, fq, lds, wid, lane); S.done(cur); }
#undef PG8_SA
#undef PG8_SB
#undef PG8_STAGE
#undef PG8_LDA
#undef PG8_LDB
#undef PG8_MMA
#undef PG8_WAIT_V
#undef PG8_WAIT_L
#undef PG8_BAR
#undef PG8_SCHED
}
}

namespace pg8 {
typedef unsigned u32x2 __attribute__((ext_vector_type(2)));
struct EpiQKV8 {
    static constexpr int BMODE = 2; static constexpr bool PERM = false, AFTER_DRAIN = false;
    const float* ssq; const float* qg; const float* kg; const ::f32x2* rope; bf16_t* Q; bf16_t* Kb; bf16_t* Vb;
    __device__ __forceinline__ void operator()(const f32x4 (&acc)[2][2][4][2], const Unit& u, int wr, int wc, int fr, int fq) const {
        const int pn = u.pn;
#pragma unroll
        for (int ai = 0; ai < 2; ++ai)
#pragma unroll
            for (int m = 0; m < 4; ++m) {
                const int row = u.pm * BM + ai * HALF + wr * 64 + m * 16 + fr; const float rs = rstd_from_slots(ssq, row);
                f32x4 v[2][2];
#pragma unroll
                for (int bj = 0; bj < 2; ++bj)
#pragma unroll
                    for (int n = 0; n < 2; ++n) v[bj][n] = acc[ai][bj][m][n] * rs;
                if (pn < 5) {
                    const bool isq = pn < 4; const float* g = isq ? qg : kg;
                    float ss = 0.f;
#pragma unroll
                    for (int bj = 0; bj < 2; ++bj)
#pragma unroll
                        for (int n = 0; n < 2; ++n) ss += (v[bj][n].x * v[bj][n].x + v[bj][n].y * v[bj][n].y) + (v[bj][n].z * v[bj][n].z + v[bj][n].w * v[bj][n].w);
                    ss += __shfl_xor(ss, 16); ss += __shfl_xor(ss, 32);
                    const float r = 1.0f / sqrtf(ss * (1.0f / 64.0f) + EPS);
#pragma unroll
                    for (int bj = 0; bj < 2; ++bj)
#pragma unroll
                        for (int n = 0; n < 2; ++n) { const f32x4 gv = *(const f32x4*)(g + 32 * bj + 16 * n + 4 * fq); v[bj][n] = v[bj][n] * r * gv; }
                    const int t = row % SEQ, prow = t >> 6, pcol = t & 63;
                    const float sc = isq ? C2 : 1.0f;
#pragma unroll
                    for (int bj = 0; bj < 2; ++bj) {
                        const int pos = bj == 0 ? prow : pcol;
                        const f32x4 cs01 = *(const f32x4*)(rope + pos * 16 + 4 * fq), cs23 = *(const f32x4*)(rope + pos * 16 + 4 * fq + 2);
                        const float cc[4] = {cs01.x, cs01.z, cs23.x, cs23.z}, sn[4] = {cs01.y, cs01.w, cs23.y, cs23.w};
                        const f32x4 x1 = v[bj][0], x2 = v[bj][1]; f32x4 o1, o2;
#pragma unroll
                        for (int j = 0; j < 4; ++j) { o1[j] = (x1[j] * cc[j] - x2[j] * sn[j]) * sc; o2[j] = (x2[j] * cc[j] + x1[j] * sn[j]) * sc; }
                        v[bj][0] = o1; v[bj][1] = o2;
                    }
                }
                bf16_t* dst = pn < 4 ? Q + (size_t)row * D + pn * 256 + wc * 64 : pn == 4 ? Kb + (size_t)row * KVP + wc * 64 : Vb + (size_t)row * KVP + wc * 64;
#pragma unroll
                for (int bj = 0; bj < 2; ++bj)
#pragma unroll
                    for (int n = 0; n < 2; ++n) { u32x2 w; w.x = cvt_pk_bf16(v[bj][n].x, v[bj][n].y); w.y = cvt_pk_bf16(v[bj][n].z, v[bj][n].w); *(u32x2*)(dst + 32 * bj + 16 * n + 4 * fq) = w; }
            }
    }
};
struct EpiRes8 {
    static constexpr int BMODE = 0; static constexpr bool PERM = false, AFTER_DRAIN = false;
    const float* base; float* out; bf16_t* xb; float* ssq;
    __device__ __forceinline__ void operator()(const f32x4 (&acc)[2][2][4][2], const Unit& u, int wr, int wc, int fr, int fq) const {
        const int col0 = u.pn * BM + wc * 32 + 4 * fq;
#pragma unroll
        for (int ai = 0; ai < 2; ++ai)
#pragma unroll
            for (int m = 0; m < 4; ++m) {
                const int row = u.pm * BM + ai * HALF + wr * 64 + m * 16 + fr; float ss = 0.f;
#pragma unroll
                for (int bj = 0; bj < 2; ++bj)
#pragma unroll
                    for (int n = 0; n < 2; ++n) { const size_t off = (size_t)row * D + col0 + bj * HALF + n * 16;
                        const f32x4 h = *(const f32x4*)(base + off) + acc[ai][bj][m][n]; *(f32x4*)(out + off) = h;
                        ss += (h.x * h.x + h.y * h.y) + (h.z * h.z + h.w * h.w);
                        if (xb) { u32x2 w; w.x = cvt_pk_bf16(h.x, h.y); w.y = cvt_pk_bf16(h.z, h.w); *(u32x2*)(xb + off) = w; } }
                ss += __shfl_xor(ss, 16); ss += __shfl_xor(ss, 32);
                if (ssq && fq == 0) ssq[(size_t)row * 16 + u.pn * 4 + wc] = ss;
                asm volatile("" ::: "memory");
            }
    }
};
struct EpiUp8 {
    static constexpr int BMODE = 1; static constexpr bool PERM = true, AFTER_DRAIN = false;
    const float* ssq; bf16_t* HB;
    __device__ __forceinline__ void operator()(const f32x4 (&acc)[2][2][4][2], const Unit& u, int wr, int wc, int fr, int fq) const {
        const int col0 = u.pn * BM + wc * 32 + 8 * fq;
#pragma unroll
        for (int ai = 0; ai < 2; ++ai)
#pragma unroll
            for (int m = 0; m < 4; ++m) {
                const int row = u.pm * BM + ai * HALF + wr * 64 + m * 16 + fr; const float rs = rstd_from_slots(ssq, row);
                bf16_t* rowp = HB + (size_t)row * FF + col0;
#pragma unroll
                for (int bj = 0; bj < 2; ++bj) { f32x4 v0 = acc[ai][bj][m][0] * rs, v1 = acc[ai][bj][m][1] * rs;
#pragma unroll
                    for (int j = 0; j < 4; ++j) { const float a = fmaxf(v0[j], 0.f), b = fmaxf(v1[j], 0.f); v0[j] = a * a; v1[j] = b * b; }
                    u32x4 w; w.x = cvt_pk_bf16(v0[0], v0[1]); w.y = cvt_pk_bf16(v0[2], v0[3]); w.z = cvt_pk_bf16(v1[0], v1[1]); w.w = cvt_pk_bf16(v1[2], v1[3]);
                    *(u32x4*)(rowp + bj * HALF) = w; }
            }
    }
};
struct EpiGin8 {
    static constexpr int BMODE = 1; static constexpr bool PERM = true, AFTER_DRAIN = false;
    const float* ssq; bf16_t* q; bf16_t* k; bf16_t* v; bf16_t* r;
    __device__ __forceinline__ void operator()(const f32x4 (&acc)[2][2][4][2], const Unit& u, int wr, int wc, int fr, int fq) const {
        const int pn = u.pn;
        bf16_t* basep; int ld, ct; float sc = 1.0f;
        if (pn < 2) { basep = q; ld = GQK; ct = pn; sc = 0.08838834764831845f; } else if (pn < 4) { basep = k; ld = GQK; ct = pn - 2; } else if (pn < 8) { basep = v; ld = GV; ct = pn - 4; } else { basep = r; ld = GV; ct = pn - 8; }
        const int col0 = ct * BM + wc * 32 + 8 * fq;
#pragma unroll
        for (int ai = 0; ai < 2; ++ai)
#pragma unroll
            for (int m = 0; m < 4; ++m) {
                const int row = u.pm * BM + ai * HALF + wr * 64 + m * 16 + fr; const float rs = rstd_from_slots(ssq, row) * sc;
                bf16_t* rowp = basep + (size_t)row * ld + col0;
#pragma unroll
                for (int bj = 0; bj < 2; ++bj) { const f32x4 v0 = acc[ai][bj][m][0] * rs, v1 = acc[ai][bj][m][1] * rs;
                    u32x4 w; w.x = cvt_pk_bf16(v0[0], v0[1]); w.y = cvt_pk_bf16(v0[2], v0[3]); w.z = cvt_pk_bf16(v1[0], v1[1]); w.w = cvt_pk_bf16(v1[2], v1[3]);
                    *(u32x4*)(rowp + bj * HALF) = w; }
            }
    }
};
}

__device__ __forceinline__ void transpose_item(const float* W, const float* g, int K, int N, bf16_t* WT, LAS float* scr, int item, int lane) {
    const int nblk = N / 32, kb = item / nblk, nb = item % nblk, k0 = 64 * kb, n0 = 32 * nb;
#pragma unroll 8
    for (int i = 0; i < 32; ++i) { const int kk = 2 * i + (lane >> 5); const float gv = g ? g[k0 + kk] : 1.0f;
        scr[kk * 33 + (lane & 31)] = W[(size_t)(k0 + kk) * N + n0 + (lane & 31)] * gv; }
    LDS_WAIT(); asm volatile("" ::: "memory");
    const int c = lane & 7;
#pragma unroll
    for (int j = 0; j < 4; ++j) { const int n = (lane >> 3) + 8 * j; const LAS float* s = scr + (8 * c) * 33 + n;
        u32x4 o; o.x = pk2(s[0 * 33], s[1 * 33]); o.y = pk2(s[2 * 33], s[3 * 33]); o.z = pk2(s[4 * 33], s[5 * 33]); o.w = pk2(s[6 * 33], s[7 * 33]);
        *(u32x4*)(WT + (size_t)(n0 + n) * K + k0 + 8 * c) = o; }
    LDS_WAIT(); asm volatile("" ::: "memory");
}
__device__ __forceinline__ void sincos_d(double x, double& s, double& c) {
    const double TWO_PI = 6.283185307179586476925286766559;
    const double n = __builtin_rint(x / TWO_PI);
    const double r = x - n * TWO_PI, r2 = r * r;
    double ts = 1.0, tc = 1.0;
#pragma unroll
    for (int k = 13; k >= 1; --k) { ts = 1.0 - ts * r2 / (double)((2 * k) * (2 * k + 1)); tc = 1.0 - tc * r2 / (double)((2 * k - 1) * (2 * k)); }
    s = r * ts; c = tc;
}

template <class Epi>
__device__ __forceinline__ void gemm_simple(const bf16_t* A, const bf16_t* Bt, int Mrows, int N, int K, const Epi& E, int gw, int ngw, int lane) {
    const int fr = lane & 15, fq = lane >> 4;
    const int ntn = N / 64, ntm = Mrows / 32, ntiles = ntn * ntm;
    for (int t = gw; t < ntiles; t += ngw) {
        const int tn = t % ntn, tm = t / ntn;
        f32x4 acc[2][4];
#pragma unroll
        for (int m = 0; m < 2; ++m)
#pragma unroll
            for (int n = 0; n < 4; ++n) acc[m][n] = (f32x4){0.f, 0.f, 0.f, 0.f};
        const bf16_t* Ap = A + (size_t)(tm * 32 + fr) * K + fq * 8;
        const bf16_t* Bp = Bt + (size_t)(tn * 64 + fr) * K + fq * 8;
        for (int k0 = 0; k0 < K; k0 += 32) {
            bf16x8 a[2], b[4];
            a[0] = *(const bf16x8*)(Ap + k0); a[1] = *(const bf16x8*)(Ap + (size_t)16 * K + k0);
#pragma unroll
            for (int n = 0; n < 4; ++n) b[n] = *(const bf16x8*)(Bp + (size_t)n * 16 * K + k0);
#pragma unroll
            for (int m = 0; m < 2; ++m)
#pragma unroll
                for (int n = 0; n < 4; ++n) acc[m][n] = __builtin_amdgcn_mfma_f32_16x16x32_bf16(b[n], a[m], acc[m][n], 0, 0, 0);
        }
        E(tm * 32, tn * 64, acc, fr, fq);
    }
}

struct EpiQKV {
    const float* ssq; const float* qg; const float* kg; const f32x2* rope; bf16_t* Q; bf16_t* Kb; bf16_t* Vb;
    __device__ __forceinline__ void operator()(int row0, int col0, f32x4 (&acc)[2][4], int fr, int fq) const {
#pragma unroll
        for (int m = 0; m < 2; ++m) {
            const int row = row0 + 16 * m + fr; const float rs = rstd_from_slots(ssq, row);
            f32x4 v[4];
#pragma unroll
            for (int n = 0; n < 4; ++n) v[n] = acc[m][n] * rs;
            if (col0 < 1280) {
                const bool isq = col0 < 1024; const float* g = isq ? qg : kg;
                float ss = 0.f;
#pragma unroll
                for (int n = 0; n < 4; ++n) ss += (v[n].x * v[n].x + v[n].y * v[n].y) + (v[n].z * v[n].z + v[n].w * v[n].w);
                ss += __shfl_xor(ss, 16); ss += __shfl_xor(ss, 32);
                const float r = 1.0f / sqrtf(ss * (1.0f / 64.0f) + EPS);
#pragma unroll
                for (int n = 0; n < 4; ++n) { const f32x4 gv = *(const f32x4*)(g + 16 * n + 4 * fq); v[n] = v[n] * r * gv; }
                const int t = row % SEQ, prow = t >> 6, pcol = t & 63;
                const float sc = isq ? C2 : 1.0f;
#pragma unroll
                for (int hh = 0; hh < 2; ++hh) {
                    const int pos = hh == 0 ? prow : pcol;
                    f32x4 x1 = v[2 * hh], x2 = v[2 * hh + 1], o1, o2;
#pragma unroll
                    for (int j = 0; j < 4; ++j) { const f32x2 cs = rope[pos * 16 + 4 * fq + j];
                        o1[j] = (x1[j] * cs.x - x2[j] * cs.y) * sc; o2[j] = (x2[j] * cs.x + x1[j] * cs.y) * sc; }
                    v[2 * hh] = o1; v[2 * hh + 1] = o2;
                }
            }
            bf16_t* dst;
            if (col0 < 1024) dst = Q + (size_t)row * D + col0;
            else if (col0 < 1280) dst = Kb + (size_t)row * KVP + (col0 - 1024);
            else dst = Vb + (size_t)row * KVP + (col0 - 1280);
#pragma unroll
            for (int n = 0; n < 4; ++n) { u32x2 w; w.x = pk2(v[n].x, v[n].y); w.y = pk2(v[n].z, v[n].w); *(u32x2*)(dst + 16 * n + 4 * fq) = w; }
        }
    }
};
struct EpiRes {
    const float* base; float* out; bf16_t* xb; float* ssq;
    __device__ __forceinline__ void operator()(int row0, int col0, f32x4 (&acc)[2][4], int fr, int fq) const {
#pragma unroll
        for (int m = 0; m < 2; ++m) {
            const int row = row0 + 16 * m + fr; float ss = 0.f;
#pragma unroll
            for (int n = 0; n < 4; ++n) { const size_t off = (size_t)row * D + col0 + 16 * n + 4 * fq;
                const f32x4 h = *(const f32x4*)(base + off) + acc[m][n]; *(f32x4*)(out + off) = h;
                ss += (h.x * h.x + h.y * h.y) + (h.z * h.z + h.w * h.w);
                if (xb) { u32x2 w; w.x = pk2(h.x, h.y); w.y = pk2(h.z, h.w); *(u32x2*)(xb + off) = w; } }
            ss += __shfl_xor(ss, 16); ss += __shfl_xor(ss, 32);
            if (ssq && fq == 0) ssq[(size_t)row * 16 + (col0 >> 6)] = ss;
        }
    }
};
struct EpiUp {
    const float* ssq; bf16_t* HB;
    __device__ __forceinline__ void operator()(int row0, int col0, f32x4 (&acc)[2][4], int fr, int fq) const {
#pragma unroll
        for (int m = 0; m < 2; ++m) {
            const int row = row0 + 16 * m + fr; const float rs = rstd_from_slots(ssq, row);
#pragma unroll
            for (int n = 0; n < 4; ++n) { f32x4 v = acc[m][n] * rs;
#pragma unroll
                for (int j = 0; j < 4; ++j) { const float t = fmaxf(v[j], 0.f); v[j] = t * t; }
                u32x2 w; w.x = pk2(v.x, v.y); w.y = pk2(v.z, v.w); *(u32x2*)(HB + (size_t)row * FF + col0 + 16 * n + 4 * fq) = w; }
        }
    }
};
struct EpiGin {
    const float* ssq; bf16_t* q; bf16_t* k; bf16_t* v; bf16_t* r;
    __device__ __forceinline__ void operator()(int row0, int col0, f32x4 (&acc)[2][4], int fr, int fq) const {
#pragma unroll
        for (int m = 0; m < 2; ++m) {
            const int row = row0 + 16 * m + fr; float rs = rstd_from_slots(ssq, row);
            bf16_t* dst;
            if (col0 < 512) { dst = q + (size_t)row * GQK + col0; rs *= 0.08838834764831845f; }
            else if (col0 < 1024) dst = k + (size_t)row * GQK + (col0 - 512);
            else if (col0 < 2048) dst = v + (size_t)row * GV + (col0 - 1024);
            else dst = r + (size_t)row * GV + (col0 - 2048);
#pragma unroll
            for (int n = 0; n < 4; ++n) { const f32x4 x = acc[m][n] * rs; u32x2 w; w.x = pk2(x.x, x.y); w.y = pk2(x.z, x.w); *(u32x2*)(dst + 16 * n + 4 * fq) = w; }
        }
    }
};
struct EpiZ {
    const float* ssq; float* Z;
    __device__ __forceinline__ void operator()(int row0, int col0, f32x4 (&acc)[2][4], int fr, int fq) const {
#pragma unroll
        for (int m = 0; m < 2; ++m) {
            const int row = row0 + 16 * m + fr; const float rs = rstd_from_slots(ssq, row);
#pragma unroll
            for (int n = 0; n < 4; ++n) *(f32x4*)(Z + (size_t)row * 64 + col0 + 16 * n + 4 * fq) = acc[m][n] * rs;
        }
    }
};

__device__ __forceinline__ void attn_simple(const bf16_t* Q, const bf16_t* Kb, const bf16_t* Vb, bf16_t* O, int gw, int ngw, int lane) {
    const int fr = lane & 15, fq = lane >> 4;
    for (int u = gw; u < BATCH * NH * (SEQ / 16); u += ngw) {
        const int qt = u & 255, h = (u >> 8) & 15, b = u >> 12, kvh = h >> 2;
        const size_t rowbase = (size_t)b * SEQ;
        const bf16_t* Qp = Q + (rowbase + qt * 16 + fr) * D + h * HD + fq * 8;
        bf16x8 qf[2]; qf[0] = *(const bf16x8*)Qp; qf[1] = *(const bf16x8*)(Qp + 32);
        const bf16_t* Kh = Kb + rowbase * KVP + kvh * HD;
        const bf16_t* Vh = Vb + rowbase * KVP + kvh * HD;
        float mrun = -1e30f, lrun = 0.f;
        f32x4 oacc[4];
#pragma unroll
        for (int dt = 0; dt < 4; ++dt) oacc[dt] = (f32x4){0.f, 0.f, 0.f, 0.f};
        for (int kt = 0; kt < SEQ / 64; ++kt) {
            const int key0 = kt * 64;
            f32x4 sT[4];
#pragma unroll
            for (int blk = 0; blk < 4; ++blk) {
                const int key = key0 + 32 * (blk >> 1) + 8 * (fr >> 2) + 4 * (blk & 1) + (fr & 3);
                const bf16_t* kp = Kh + (size_t)key * KVP + fq * 8;
                const bf16x8 k0 = *(const bf16x8*)kp, k1 = *(const bf16x8*)(kp + 32);
                f32x4 z = (f32x4){0.f, 0.f, 0.f, 0.f};
                z = __builtin_amdgcn_mfma_f32_16x16x32_bf16(k0, qf[0], z, 0, 0, 0);
                z = __builtin_amdgcn_mfma_f32_16x16x32_bf16(k1, qf[1], z, 0, 0, 0);
                sT[blk] = z;
            }
            float mx = sT[0][0];
#pragma unroll
            for (int blk = 0; blk < 4; ++blk)
#pragma unroll
                for (int r = 0; r < 4; ++r) mx = fmaxf(mx, sT[blk][r]);
            mx = fmaxf(mx, __shfl_xor(mx, 16)); mx = fmaxf(mx, __shfl_xor(mx, 32));
            const float mnew = fmaxf(mrun, mx), alpha = __builtin_amdgcn_exp2f(mrun - mnew); mrun = mnew;
            float ps = 0.f; bf16x8 pf[2];
#pragma unroll
            for (int ks = 0; ks < 2; ++ks) {
                float p[8];
#pragma unroll
                for (int j = 0; j < 8; ++j) { p[j] = __builtin_amdgcn_exp2f(sT[2 * ks + (j >> 2)][j & 3] - mnew); ps += p[j]; }
                u32x4 w; w.x = pk2(p[0], p[1]); w.y = pk2(p[2], p[3]); w.z = pk2(p[4], p[5]); w.w = pk2(p[6], p[7]);
                pf[ks] = __builtin_bit_cast(bf16x8, w);
            }
            lrun = lrun * alpha + ps;
#pragma unroll
            for (int dt = 0; dt < 4; ++dt) oacc[dt] = oacc[dt] * alpha;
#pragma unroll
            for (int ks = 0; ks < 2; ++ks)
#pragma unroll
                for (int dt = 0; dt < 4; ++dt) {
                    const bf16_t* vp = Vh + (size_t)(key0 + 32 * ks + 8 * fq) * KVP + dt * 16 + fr;
                    bf16x8 vf;
#pragma unroll
                    for (int e = 0; e < 8; ++e) vf[e] = (short)vp[(size_t)e * KVP];
                    oacc[dt] = __builtin_amdgcn_mfma_f32_16x16x32_bf16(vf, pf[ks], oacc[dt], 0, 0, 0);
                }
        }
        lrun += __shfl_xor(lrun, 16); lrun += __shfl_xor(lrun, 32);
        const float inv = 1.0f / lrun;
        bf16_t* Op = O + (rowbase + qt * 16 + fr) * D + h * HD + 4 * fq;
#pragma unroll
        for (int dt = 0; dt < 4; ++dt) { const f32x4 o = oacc[dt] * inv; u32x2 w; w.x = pk2(o.x, o.y); w.y = pk2(o.z, o.w); *(u32x2*)(Op + dt * 16) = w; }
    }
}

__device__ __forceinline__ void gla_pre(const bf16_t* q, const bf16_t* k, const float* Z, const float* wgu, const float* bgate, bf16_t* qe, bf16_t* ke, float* decay, int wg, int nwg, int tid) {
    const int c = tid, h = c >> 7, d = c & 127;
    for (int it = wg; it < BATCH * NCH * 2; it += nwg) {
        const int dir = it & 1, n = (it >> 1) & (NCH - 1), b = it >> 7;
        float w[RANK];
#pragma unroll
        for (int r = 0; r < RANK; ++r) w[r] = wgu[((size_t)dir * RANK + r) * GQK + c];
        const float bg = bgate[dir * GQK + c];
        float bsum = 0.f;
        bf16_t* qed = qe + (size_t)dir * M * GQK; bf16_t* ked = ke + (size_t)dir * M * GQK;
        for (int s = 0; s < CH; ++s) {
            const int i = dir == 0 ? s : (CH - 1 - s);
            const size_t tok = (size_t)b * SEQ + n * CH + i;
            const f32x4* zp = (const f32x4*)(Z + tok * 64 + dir * RANK);
            const f32x4 z0 = zp[0], z1 = zp[1], z2 = zp[2], z3 = zp[3];
            float logit = bg;
            logit += z0.x * w[0] + z0.y * w[1] + z0.z * w[2] + z0.w * w[3];
            logit += z1.x * w[4] + z1.y * w[5] + z1.z * w[6] + z1.w * w[7];
            logit += z2.x * w[8] + z2.y * w[9] + z2.z * w[10] + z2.w * w[11];
            logit += z3.x * w[12] + z3.y * w[13] + z3.z * w[14] + z3.w * w[15];
            const float lg = (fminf(logit, 0.f) - log1pf(expf(-fabsf(logit)))) * (1.0f / 16.0f);
            bsum += lg;
            const float eb = expf(bsum), enb = expf(-bsum);
            qed[tok * GQK + c] = (bf16_t)f2bf(bf2f(q[tok * GQK + c]) * eb);
            ked[tok * GQK + c] = (bf16_t)f2bf(bf2f(k[tok * GQK + c]) * enb);
        }
        decay[((((size_t)b * GH + h) * 2 + dir) * NCH + n) * GDK + d] = expf(bsum);
    }
}

__device__ __forceinline__ void gla_scan_simple(const bf16_t* qe, const bf16_t* ke, const bf16_t* v, const float* decay, bf16_t* of, bf16_t* ob, LAS unsigned char* lds, int wg, int nwg, int tid) {
    LAS float* qeL = (LAS float*)lds;
    LAS float* keL = qeL + 64 * 129;
    LAS float* vL = keL + 64 * 129;
    LAS float* AL = vL + 64 * 33;
    LAS float* SL = AL + 64 * 65;
    LAS float* dL = SL + 128 * 33;
    for (int it = wg; it < BATCH * GH * 2 * 8; it += nwg) {
        const int js = it & 7, dir = (it >> 3) & 1, h = (it >> 4) & 3, b = it >> 6;
        const bf16_t* qed = qe + (size_t)dir * M * GQK; const bf16_t* ked = ke + (size_t)dir * M * GQK;
        bf16_t* od = dir == 0 ? of : ob;
        for (int e = tid; e < 128 * 33; e += NTHREADS) SL[e] = 0.f;
        __syncthreads();
        for (int st = 0; st < NCH; ++st) {
            const int n = dir == 0 ? st : (NCH - 1 - st);
            const size_t tok0 = (size_t)b * SEQ + n * CH;
            {
                const int i = tid >> 3, ds = (tid & 7) * 16;
                const u32x4* qp = (const u32x4*)(qed + (tok0 + i) * GQK + h * GDK + ds);
                const u32x4* kp = (const u32x4*)(ked + (tok0 + i) * GQK + h * GDK + ds);
#pragma unroll
                for (int hh = 0; hh < 2; ++hh) { const u32x4 a = qp[hh], c = kp[hh];
#pragma unroll
                    for (int j = 0; j < 4; ++j) { qeL[i * 129 + ds + hh * 8 + 2 * j] = bflo(a[j]); qeL[i * 129 + ds + hh * 8 + 2 * j + 1] = bfhi(a[j]);
                                                  keL[i * 129 + ds + hh * 8 + 2 * j] = bflo(c[j]); keL[i * 129 + ds + hh * 8 + 2 * j + 1] = bfhi(c[j]); } }
                if (tid < 256) { const int iv = tid >> 2, vs = (tid & 3) * 8;
                    const u32x4 a = *(const u32x4*)(v + (tok0 + iv) * GV + h * GDV + js * 32 + vs);
#pragma unroll
                    for (int j = 0; j < 4; ++j) { vL[iv * 33 + vs + 2 * j] = bflo(a[j]); vL[iv * 33 + vs + 2 * j + 1] = bfhi(a[j]); } }
                if (tid < 128) dL[tid] = decay[((((size_t)b * GH + h) * 2 + dir) * NCH + n) * GDK + tid];
            }
            __syncthreads();
            {
                const int i = tid >> 3, jg = tid & 7;
                float a[8];
#pragma unroll
                for (int e = 0; e < 8; ++e) a[e] = 0.f;
                for (int d = 0; d < GDK; ++d) { const float qv = qeL[i * 129 + d];
#pragma unroll
                    for (int e = 0; e < 8; ++e) a[e] += qv * keL[(jg + 8 * e) * 129 + d]; }
#pragma unroll
                for (int e = 0; e < 8; ++e) { const int j = jg + 8 * e; const bool keep = dir == 0 ? (j <= i) : (j >= i); AL[i * 65 + j] = keep ? a[e] : 0.f; }
            }
            __syncthreads();
            {
                const int i = tid >> 3, vg = (tid & 7) * 4;
                float o[4] = {0.f, 0.f, 0.f, 0.f};
                for (int j = 0; j < CH; ++j) { const float a = AL[i * 65 + j];
#pragma unroll
                    for (int e = 0; e < 4; ++e) o[e] += a * vL[j * 33 + vg + e]; }
                for (int d = 0; d < GDK; ++d) { const float qv = qeL[i * 129 + d];
#pragma unroll
                    for (int e = 0; e < 4; ++e) o[e] += qv * SL[d * 33 + vg + e]; }
                u32x2 w; w.x = pk2(o[0], o[1]); w.y = pk2(o[2], o[3]);
                *(u32x2*)(od + (tok0 + i) * GV + h * GDV + js * 32 + vg) = w;
            }
            __syncthreads();
            {
                const int d = tid >> 2, vg = (tid & 3) * 8;
                float s[8];
#pragma unroll
                for (int e = 0; e < 8; ++e) s[e] = SL[d * 33 + vg + e];
                for (int j = 0; j < CH; ++j) { const float kv = keL[j * 129 + d];
#pragma unroll
                    for (int e = 0; e < 8; ++e) s[e] += kv * vL[j * 33 + vg + e]; }
                const float dc = dL[d];
#pragma unroll
                for (int e = 0; e < 8; ++e) SL[d * 33 + vg + e] = dc * s[e];
            }
            __syncthreads();
        }
    }
}

__device__ __forceinline__ void gla_combine(bf16_t* of, const bf16_t* ob, const bf16_t* r, const float* og, int gw, int ngw, int lane) {
    for (int row = gw; row < M; row += ngw) {
        const size_t off = (size_t)row * GV + lane * 16;
        const u32x4 a0 = *(const u32x4*)(of + off), a1 = *(const u32x4*)(of + off + 8);
        const u32x4 b0 = *(const u32x4*)(ob + off), b1 = *(const u32x4*)(ob + off + 8);
        const u32x4 r0 = *(const u32x4*)(r + off), r1 = *(const u32x4*)(r + off + 8);
        float o[16], rr[16];
#pragma unroll
        for (int j = 0; j < 4; ++j) { o[2 * j] = bflo(a0[j]) + bflo(b0[j]); o[2 * j + 1] = bfhi(a0[j]) + bfhi(b0[j]); o[8 + 2 * j] = bflo(a1[j]) + bflo(b1[j]); o[8 + 2 * j + 1] = bfhi(a1[j]) + bfhi(b1[j]);
            rr[2 * j] = bflo(r0[j]); rr[2 * j + 1] = bfhi(r0[j]); rr[8 + 2 * j] = bflo(r1[j]); rr[8 + 2 * j + 1] = bfhi(r1[j]); }
        float ss = 0.f;
#pragma unroll
        for (int j = 0; j < 16; ++j) ss += o[j] * o[j];
        ss += __shfl_xor(ss, 1); ss += __shfl_xor(ss, 2); ss += __shfl_xor(ss, 4); ss += __shfl_xor(ss, 8);
        const float rs = 1.0f / sqrtf(ss * (1.0f / GDV) + EPS);
        const int dv0 = (lane & 15) * 16;
        float g[16];
#pragma unroll
        for (int j = 0; j < 16; ++j) { const float y = o[j] * rs * og[dv0 + j]; const float x = rr[j]; g[j] = y * x / (1.0f + __expf(-x)); }
        u32x4 w0, w1;
#pragma unroll
        for (int j = 0; j < 4; ++j) { w0[j] = pk2(g[2 * j], g[2 * j + 1]); w1[j] = pk2(g[8 + 2 * j], g[8 + 2 * j + 1]); }
        *(u32x4*)(of + off) = w0; *(u32x4*)(of + off + 8) = w1;
    }
}

struct Args { const float* in[15]; float* out; unsigned char* ws; int ph_lo, ph_hi; };
static_assert(sizeof(Args) == 15 * 8 + 8 + 8 + 8, "Args has no padding");

__global__ void __launch_bounds__(NTHREADS, 2) fwd_kernel(Args args) {
    extern __shared__ __attribute__((aligned(16))) unsigned char lds_raw[];
    LAS unsigned char* lds = (LAS unsigned char*)lds_raw;
    const int tid0 = threadIdx.x;
#define KARG_BASE() const __attribute__((address_space(4))) unsigned char* ka_ = (const __attribute__((address_space(4))) unsigned char*)__builtin_amdgcn_kernarg_segment_ptr(); asm volatile("" : "+s"(ka_))
#define IN_PTR(i) (*(const float* const __attribute__((address_space(4)))*)(ka_ + 8 * (i)))
#define OUT_PTR() (*(float* const __attribute__((address_space(4)))*)(ka_ + 8 * 15))
#define WS_PTR() (*(unsigned char* const __attribute__((address_space(4)))*)(ka_ + 8 * 16))
#define WSP(T, off) ((T*)(ws + (off)))
    for (int u = tid0; u < (LDS_BYTES - LDSCTL_OFF) / 4; u += NTHREADS) ((LAS unsigned*)(lds + LDSCTL_OFF))[u] = 0u;
    __syncthreads();
    volatile LAS unsigned* MISC = (volatile LAS unsigned*)(lds + MISC_OFF);
    const int lo = args.ph_lo, hi = args.ph_hi;
    const bool multi = (hi - lo) > 1;
    XcdBarrier bar; bar.bar = (unsigned*)(args.ws + WS_CTL) + 4096; bar.x = 0; bar.st = nullptr;
    if (multi) bar = xcd_barrier_post((unsigned*)(args.ws + WS_CTL) + 4096, MISC + 8);
#ifndef FAST_GEMM
#define FAST_GEMM 15
#endif
    for (int ph = lo; ph < hi; ++ph) {
        int tid = threadIdx.x; asm volatile("" : "+v"(tid));
        int wg = blockIdx.x, G = gridDim.x; asm volatile("" : "+s"(wg), "+s"(G));
        const int lane = tid & 63, wave = __builtin_amdgcn_readfirstlane(tid >> 6);
        const int gw = wg * NWAVES + wave, ngw = G * NWAVES;
        switch (ph) {
        case 0: {
            KARG_BASE(); unsigned char* ws = WS_PTR();
            const float* x = IN_PTR(0); const float* norm_mix = IN_PTR(1); const float* norm_mlp = IN_PTR(2); const float* attn_w_qkv = IN_PTR(3); const float* attn_w_o = IN_PTR(6);
            const float* gla_w_in = IN_PTR(7); const float* gla_w_o = IN_PTR(11); const float* mlp_w_in = IN_PTR(12); const float* mlp_w_out = IN_PTR(13);
            bf16_t* Wqkv = WSP(bf16_t, W_QKV); bf16_t* Wo0 = WSP(bf16_t, W_O0); bf16_t* W1a = WSP(bf16_t, W_1A); bf16_t* W2a = WSP(bf16_t, W_2A);
            bf16_t* Wgin = WSP(bf16_t, W_GIN); bf16_t* Wo1 = WSP(bf16_t, W_O1); bf16_t* W1b = WSP(bf16_t, W_1B); bf16_t* W2b = WSP(bf16_t, W_2B);
            bf16_t* XB = WSP(bf16_t, WS_XB); float* SSQ0 = WSP(float, WS_SSQ); f32x2* ROPE = WSP(f32x2, WS_ROPE);
            LAS float* scr = (LAS float*)(lds + wave * 16384);
            constexpr int I_QKV = 16 * 48, I_O = 16 * 32, I_1 = 16 * 128, I_2 = 64 * 32, I_GIN = 16 * 97;
            constexpr int NITEMS = I_QKV + I_O + I_1 + I_2 + I_GIN + I_O + I_1 + I_2;
            for (int it = gw; it < NITEMS; it += ngw) {
                int r = it;
                if (r < I_QKV) { transpose_item(attn_w_qkv, norm_mix, D, QKV_N, Wqkv, scr, r, lane); continue; } r -= I_QKV;
                if (r < I_O) { transpose_item(attn_w_o, nullptr, D, D, Wo0, scr, r, lane); continue; } r -= I_O;
                if (r < I_1) { transpose_item(mlp_w_in, norm_mlp, D, FF, W1a, scr, r, lane); continue; } r -= I_1;
                if (r < I_2) { transpose_item(mlp_w_out, nullptr, FF, D, W2a, scr, r, lane); continue; } r -= I_2;
                if (r < I_GIN) { transpose_item(gla_w_in, norm_mix + D, D, GIN, Wgin, scr, r, lane); continue; } r -= I_GIN;
                if (r < I_O) { transpose_item(gla_w_o, nullptr, D, D, Wo1, scr, r, lane); continue; } r -= I_O;
                if (r < I_1) { transpose_item(mlp_w_in + (size_t)D * FF, norm_mlp + D, D, FF, W1b, scr, r, lane); continue; } r -= I_1;
                transpose_item(mlp_w_out + (size_t)FF * D, nullptr, FF, D, W2b, scr, r, lane);
            }
            for (int e = gw * 64 + lane; e < 32 * D / 8; e += ngw * 64) *(u32x4*)(Wgin + (size_t)GIN * D + (size_t)e * 8) = (u32x4){0u, 0u, 0u, 0u};
            for (int m = gw; m < M; m += ngw) {
                const f32x4* xr = (const f32x4*)(x + (size_t)m * D) + lane;
                f32x4 v[4]; float s = 0.f;
#pragma unroll
                for (int j = 0; j < 4; ++j) { v[j] = xr[64 * j]; s += (v[j].x * v[j].x + v[j].y * v[j].y) + (v[j].z * v[j].z + v[j].w * v[j].w); }
                s = wave_sum(s);
                u32x2* o8 = (u32x2*)(XB + (size_t)m * D) + lane;
#pragma unroll
                for (int j = 0; j < 4; ++j) { u32x2 w; w.x = pk2(v[j].x, v[j].y); w.y = pk2(v[j].z, v[j].w); o8[64 * j] = w; }
                if (lane < 16) SSQ0[(size_t)m * 16 + lane] = lane == 0 ? s : 0.f;
            }
            if (wg == 0) {
                for (int e = tid; e < 64 * 16; e += NTHREADS) {
                    const int pos = e >> 4, i = e & 15;
                    double invd = (i & 3) == 0 ? 1.0 : (i & 3) == 1 ? 0.56234132519034908 : (i & 3) == 2 ? 0.31622776601683794 : 0.17782794100389228;
                    invd *= (i >> 2) == 0 ? 1.0 : (i >> 2) == 1 ? 0.1 : (i >> 2) == 2 ? 0.01 : 0.001;
                    const float invf = (float)invd; const float ang = (float)pos * invf;
                    double s, c; sincos_d((double)ang, s, c);
                    ROPE[e] = (f32x2){(float)c, (float)s};
                }
            }
        } break;
        case 1: {
            KARG_BASE(); unsigned char* ws = WS_PTR(); const float* attn_qn = IN_PTR(4); const float* attn_kn = IN_PTR(5);
            const bf16_t* XB = WSP(bf16_t, WS_XB); const bf16_t* Wqkv = WSP(bf16_t, W_QKV); const float* SSQ0 = WSP(float, WS_SSQ); const f32x2* ROPE = WSP(f32x2, WS_ROPE);
            bf16_t* Qb = WSP(bf16_t, WS_BIG); bf16_t* Kb = WSP(bf16_t, WS_BIG + 32 * MiB); bf16_t* Vb = WSP(bf16_t, WS_BIG + 40 * MiB);
            if (FAST_GEMM & 1) { pg8::Gemm g{XB, Wqkv, M, QKV_N, D}; pg8::StaticOrder S; S.init(M, QKV_N, G, wg);
                pg8::EpiQKV8 E{SSQ0, attn_qn, attn_kn, ROPE, Qb, Kb, Vb};
                pg8::gemm_phase<pg8::EpiQKV8, pg8::StaticOrder, true, true>(lds, g, S, E, tid); }
            else { EpiQKV E{SSQ0, attn_qn, attn_kn, ROPE, Qb, Kb, Vb}; gemm_simple(XB, Wqkv, M, QKV_N, D, E, gw, ngw, lane); }
        } break;
        case 2: {
            KARG_BASE(); unsigned char* ws = WS_PTR();
            bf16_t* Qb = WSP(bf16_t, WS_BIG); bf16_t* Kb = WSP(bf16_t, WS_BIG + 32 * MiB); bf16_t* Vb = WSP(bf16_t, WS_BIG + 40 * MiB);
            attn_simple(Qb, Kb, Vb, Qb, gw, ngw, lane);
        } break;
        case 3: case 5: case 10: case 12: {
            KARG_BASE(); unsigned char* ws = WS_PTR(); float* out = OUT_PTR();
            const bf16_t* A = WSP(bf16_t, ph == 10 ? WS_QK : WS_BIG);
            const bf16_t* Bt = WSP(bf16_t, ph == 3 ? W_O0 : ph == 5 ? W_2A : ph == 10 ? W_O1 : W_2B);
            const int K = (ph == 3 || ph == 10) ? D : FF;
            const float* base = ph == 3 ? IN_PTR(0) : out;
            bf16_t* xb = ph == 12 ? nullptr : WSP(bf16_t, WS_XB);
            float* ssq = ph == 12 ? nullptr : WSP(float, WS_SSQ + (ph == 3 ? 1 : ph == 5 ? 2 : 3) * (size_t)M * 64);
            if (FAST_GEMM & 2) { pg8::Gemm g{A, Bt, M, D, K}; pg8::StaticOrder S; S.init(M, D, G, wg);
                pg8::EpiRes8 E{base, out, xb, ssq};
                pg8::gemm_phase<pg8::EpiRes8, pg8::StaticOrder, true, true>(lds, g, S, E, tid); }
            else { EpiRes E{base, out, xb, ssq}; gemm_simple(A, Bt, M, D, K, E, gw, ngw, lane); }
        } break;
        case 4: case 11: {
            KARG_BASE(); unsigned char* ws = WS_PTR();
            const bf16_t* XB = WSP(bf16_t, WS_XB); bf16_t* HB = WSP(bf16_t, WS_BIG);
            const bf16_t* Bt = WSP(bf16_t, ph == 4 ? W_1A : W_1B); const float* ssq = WSP(float, WS_SSQ + (ph == 4 ? 1 : 3) * (size_t)M * 64);
            if (FAST_GEMM & 4) { pg8::Gemm g{XB, Bt, M, FF, D}; pg8::StaticOrder S; S.init(M, FF, G, wg);
                pg8::EpiUp8 E{ssq, HB};
                pg8::gemm_phase<pg8::EpiUp8, pg8::StaticOrder, true, true>(lds, g, S, E, tid); }
            else { EpiUp E{ssq, HB}; gemm_simple(XB, Bt, M, FF, D, E, gw, ngw, lane); }
        } break;
        case 6: {
            KARG_BASE(); unsigned char* ws = WS_PTR();
            const bf16_t* XB = WSP(bf16_t, WS_XB); const bf16_t* Wgin = WSP(bf16_t, W_GIN); const float* SSQ2 = WSP(float, WS_SSQ + 2 * (size_t)M * 64); float* Zb = WSP(float, WS_Z);
            bf16_t* Gv = WSP(bf16_t, WS_BIG); bf16_t* Gr = WSP(bf16_t, WS_BIG + 32 * MiB); bf16_t* Gq = WSP(bf16_t, WS_QK); bf16_t* Gk = WSP(bf16_t, WS_QK + 16 * MiB);
            if (FAST_GEMM & 8) { pg8::Gemm g{XB, Wgin, M, 3072, D}; pg8::StaticOrder S; S.init(M, 3072, G, wg);
                pg8::EpiGin8 E{SSQ2, Gq, Gk, Gv, Gr};
                pg8::gemm_phase<pg8::EpiGin8, pg8::StaticOrder, true, true>(lds, g, S, E, tid); }
            else { EpiGin E{SSQ2, Gq, Gk, Gv, Gr}; gemm_simple(XB, Wgin, M, 3072, D, E, gw, ngw, lane); }
            EpiZ Ez{SSQ2, Zb}; gemm_simple(XB, Wgin + (size_t)3072 * D, M, 64, D, Ez, gw, ngw, lane);
        } break;
        case 7: {
            KARG_BASE(); unsigned char* ws = WS_PTR();
            gla_pre(WSP(bf16_t, WS_QK), WSP(bf16_t, WS_QK + 16 * MiB), WSP(float, WS_Z), IN_PTR(8), IN_PTR(9), WSP(bf16_t, WS_BIG + 64 * MiB), WSP(bf16_t, WS_BIG + 96 * MiB), WSP(float, WS_DECAY), wg, G, tid);
        } break;
        case 8: {
            KARG_BASE(); unsigned char* ws = WS_PTR();
            gla_scan_simple(WSP(bf16_t, WS_BIG + 64 * MiB), WSP(bf16_t, WS_BIG + 96 * MiB), WSP(bf16_t, WS_BIG), WSP(float, WS_DECAY), WSP(bf16_t, WS_QK), WSP(bf16_t, WS_XB), lds, wg, G, tid);
        } break;
        case 9: {
            KARG_BASE(); unsigned char* ws = WS_PTR();
            gla_combine(WSP(bf16_t, WS_QK), WSP(bf16_t, WS_XB), WSP(bf16_t, WS_BIG + 32 * MiB), IN_PTR(10), gw, ngw, lane);
        } break;
        default: {
            KARG_BASE(); float* out = OUT_PTR(); const float* final_norm = IN_PTR(14);
            for (int m = gw; m < M; m += ngw) {
                f32x4* xr = (f32x4*)(out + (size_t)m * D) + lane;
                f32x4 v[4]; float s = 0.f;
#pragma unroll
                for (int j = 0; j < 4; ++j) { v[j] = xr[64 * j]; s += (v[j].x * v[j].x + v[j].y * v[j].y) + (v[j].z * v[j].z + v[j].w * v[j].w); }
                s = wave_sum(s);
                const float rs = 1.0f / sqrtf(s * (1.0f / D) + EPS);
#pragma unroll
                for (int j = 0; j < 4; ++j) { const f32x4 g = *((const f32x4*)final_norm + lane + 64 * j); xr[64 * j] = v[j] * rs * g; }
            }
        } break;
        }
        if (ph + 1 < hi) xcd_barrier(bar);
    }
}

#ifndef MK_SINGLE
#define MK_SINGLE 1
#endif
extern "C" void kernel_launch(void* const* d_in, const int* in_sizes, int n_in, void* d_out, int out_size, void* d_ws, size_t ws_size, hipStream_t stream) {
    static int grid = 0;
    if (grid == 0) {
        if (n_in != 15 || in_sizes[0] != M * D || out_size != M * D || ws_size < WS_END) { fprintf(stderr, "kernel_launch: unexpected shapes (n_in %d, in0 %d, out %d, ws %zu)\n", n_in, n_in > 0 ? in_sizes[0] : -1, out_size, ws_size); grid = -1; return; }
        int dev = 0, cus = 0, per_cu = 0;
        if (hipGetDevice(&dev) != hipSuccess || hipDeviceGetAttribute(&cus, hipDeviceAttributeMultiprocessorCount, dev) != hipSuccess) { grid = -1; return; }
        if (hipFuncSetAttribute((const void*)fwd_kernel, hipFuncAttributeMaxDynamicSharedMemorySize, LDS_BYTES) != hipSuccess) { fprintf(stderr, "kernel_launch: hipFuncSetAttribute failed\n"); grid = -1; return; }
        if (hipOccupancyMaxActiveBlocksPerMultiprocessor(&per_cu, (const void*)fwd_kernel, NTHREADS, LDS_BYTES) != hipSuccess || per_cu < 1) { fprintf(stderr, "kernel_launch: occupancy query says %d\n", per_cu); }
        (void)hipGetLastError();
        grid = cus;
    }
    if (grid < 0) return;
    (void)hipMemsetAsync((char*)d_ws + WS_CTL, 0, CTL_ZERO_BYTES, stream);
    Args a{};
    for (int i = 0; i < 15; ++i) a.in[i] = (const float*)d_in[i];
    a.out = (float*)d_out; a.ws = (unsigned char*)d_ws;
#if MK_SINGLE
    a.ph_lo = 0; a.ph_hi = NPHASES;
    hipLaunchKernelGGL(fwd_kernel, dim3(grid), dim3(NTHREADS), LDS_BYTES, stream, a);
#else
    for (int p = 0; p < NPHASES; ++p) { a.ph_lo = p; a.ph_hi = p + 1; hipLaunchKernelGGL(fwd_kernel, dim3(grid), dim3(NTHREADS), LDS_BYTES, stream, a); }
#endif
}
```

```cpp
#include <hip/hip_runtime.h>
#include <cstdio>
#include <cstdint>
#include <hip/hip_bf16.h>
#include <cmath>

#define GAS __attribute__((address_space(1)))
#define LAS __attribute__((address_space(3)))
typedef unsigned short bf16_t;
typedef short bf16x8 __attribute__((ext_vector_type(8)));
typedef float f32x4 __attribute__((ext_vector_type(4)));
typedef float f32x2 __attribute__((ext_vector_type(2)));
typedef unsigned u32x4 __attribute__((ext_vector_type(4)));
typedef unsigned u32x2 __attribute__((ext_vector_type(2)));

constexpr int BATCH = 4, SEQ = 4096, D = 1024, M = BATCH * SEQ;
constexpr int NH = 16, NKV = 4, HD = 64, QKV_N = 1536, KVP = NKV * HD;
constexpr int GH = 4, GDK = 128, GDV = 256, GQK = 512, GV = 1024, RANK = 16, GIN = 3104, CH = 64, NCH = SEQ / CH;
constexpr int FF = 4096;
constexpr float EPS = 1e-6f;
constexpr float C2 = 0.125f * 1.4426950408889634f;
constexpr int NWAVES = 8, NTHREADS = 512;
constexpr int NPHASES = 14;

constexpr size_t MiB = 1u << 20;
constexpr size_t WS_CTL = 0, CTL_ZERO_BYTES = 1 * MiB;
constexpr size_t WS_ROPE = 1 * MiB;
constexpr size_t WS_SSQ = 2 * MiB;
constexpr size_t WS_Z = 7 * MiB;
constexpr size_t WS_DECAY = 11 * MiB;
constexpr size_t WS_W = 12 * MiB;
constexpr size_t W_QKV = WS_W, W_O0 = W_QKV + 3 * MiB, W_1A = W_O0 + 2 * MiB, W_2A = W_1A + 8 * MiB, W_GIN = W_2A + 8 * MiB,
                 W_O1 = W_GIN + 6 * MiB + 128 * 1024, W_1B = W_O1 + 2 * MiB, W_2B = W_1B + 8 * MiB, W_END = W_2B + 8 * MiB;
constexpr size_t WS_XB = 58 * MiB;
constexpr size_t WS_BIG = 90 * MiB;
constexpr size_t WS_QK = 218 * MiB;
constexpr size_t WS_END = 250 * MiB;
static_assert(W_END <= WS_XB, "weights fit");

__device__ __forceinline__ unsigned f2bf(float f) { unsigned u = __builtin_bit_cast(unsigned, f); return (u + 0x7fffu + ((u >> 16) & 1u)) >> 16; }
__device__ __forceinline__ unsigned pk2(float lo, float hi) { return f2bf(lo) | (f2bf(hi) << 16); }
__device__ __forceinline__ float bf2f(unsigned short u) { return __uint_as_float((unsigned)u << 16); }
__device__ __forceinline__ float bflo(unsigned w) { return __uint_as_float(w << 16); }
__device__ __forceinline__ float bfhi(unsigned w) { return __uint_as_float(w & 0xffff0000u); }
#define LDS_WAIT() asm volatile("s_waitcnt lgkmcnt(0)" ::: "memory")
#define VM_WAIT() asm volatile("s_waitcnt vmcnt(0)" ::: "memory")
__device__ __forceinline__ float wave_sum(float v) {
#pragma unroll
    for (int o = 1; o < 64; o <<= 1) v += __shfl_xor(v, o);
    return v;
}
__device__ __forceinline__ float rstd_from_slots(const float* ssq, int row) {
    const f32x4* p = (const f32x4*)(ssq + (size_t)row * 16);
    const f32x4 a = p[0], b = p[1], c = p[2], d = p[3];
    const float s = (((a.x + a.y) + (a.z + a.w)) + ((b.x + b.y) + (b.z + b.w))) + (((c.x + c.y) + (c.z + c.w)) + ((d.x + d.y) + (d.z + d.w)));
    return 1.0f / sqrtf(s * (1.0f / D) + EPS);
}

#define RLX_AGENT __ATOMIC_RELAXED, __HIP_MEMORY_SCOPE_AGENT
#define XB_TMO      128
#define XB_XCNT(j)  (256  + 64 * (j))
#define XB_XSUB(j)  (1280 + 64 * (j))
#define XB_XGEN(j)  (2304 + 64 * (j))
#define XB_TOP      3328
#define XB_TOPGEN   3392
#define XCD_BAR_WORDS 3456
#define XB_SPIN_CAP (1u << 22)
__device__ __forceinline__ unsigned xb_ld(unsigned* p)              { return __hip_atomic_load(p, __ATOMIC_RELAXED, __HIP_MEMORY_SCOPE_AGENT); }
__device__ __forceinline__ unsigned xb_add(unsigned* p, unsigned v) { return __hip_atomic_fetch_add(p, v, __ATOMIC_RELAXED, __HIP_MEMORY_SCOPE_AGENT); }
__device__ __forceinline__ unsigned xb_xcc_id() { return (unsigned)__builtin_amdgcn_s_getreg((3 << 11) | 20) & 0xFu; }
#define XB_SPIN(cond, bar) do { unsigned _sp = 0; while (cond) { __builtin_amdgcn_s_sleep(1); \
    if ((++_sp & 255u) == 0u) { if (xb_ld(&(bar)[XB_TMO])) break; if (_sp > XB_SPIN_CAP) { atomicAdd(&(bar)[XB_TMO], 1u); break; } } } } while (0)
struct XcdBarrier { unsigned* bar; unsigned x; volatile LAS unsigned* st; };
__device__ __forceinline__ XcdBarrier xcd_barrier_post(unsigned* bar, volatile LAS unsigned* st) {
    XcdBarrier b; b.bar = bar; b.x = xb_xcc_id(); b.st = st;
    if (threadIdx.x == 0) (void)xb_add(&bar[XB_XCNT(b.x)], 1u);
    return b;
}
__device__ __forceinline__ void xcd_barrier_complete(unsigned* bar, unsigned x, unsigned& nloc, unsigned& nx) {
    const unsigned G = gridDim.x * gridDim.y * gridDim.z;
    unsigned sum, cnt, mine, sp = 0u;
    for (;;) {
        sum = 0u; cnt = 0u; mine = 0u;
#pragma unroll
        for (unsigned j = 0; j < 16; ++j) { const unsigned c = xb_ld(&bar[XB_XCNT(j)]); sum += c; cnt += (c > 0u) ? 1u : 0u; mine = (j == x) ? c : mine; }
        if (sum == G) break;
        __builtin_amdgcn_s_sleep(1);
        if ((++sp & 255u) == 0u) { if (xb_ld(&bar[XB_TMO])) break; if (sp > XB_SPIN_CAP) { atomicAdd(&bar[XB_TMO], 1u); break; } }
    }
    nloc = mine > 0u ? mine : 1u; nx = cnt > 0u ? cnt : 1u;
}
__device__ __forceinline__ void xcd_barrier(const XcdBarrier& b) {
    asm volatile("s_waitcnt vmcnt(0)" ::: "memory");
    __syncthreads();
    if (threadIdx.x == 0) {
        unsigned* bar = b.bar;
        __builtin_amdgcn_s_waitcnt(0);
        unsigned nloc = b.st[0], nx = b.st[1];
        if (nloc == 0u) { xcd_barrier_complete(bar, b.x, nloc, nx); b.st[0] = nloc; b.st[1] = nx; }
        const unsigned old = xb_add(&bar[XB_XSUB(b.x)], 1u);
        const unsigned gen = old / nloc;
        if (old + 1u == (gen + 1u) * nloc) {
            __builtin_amdgcn_fence(__ATOMIC_RELEASE, "agent");
            asm volatile("s_waitcnt vmcnt(0)" ::: "memory");
            const unsigned og = xb_add(&bar[XB_TOP], 1u);
            const unsigned tg = og / nx;
            if (og + 1u == (tg + 1u) * nx) xb_add(&bar[XB_TOPGEN], 1u);
            else XB_SPIN(xb_ld(&bar[XB_TOPGEN]) == tg, bar);
            __builtin_amdgcn_fence(__ATOMIC_ACQUIRE, "agent");
            xb_add(&bar[XB_XGEN(b.x)], 1u);
            asm volatile("s_waitcnt vmcnt(0)" ::: "memory");
        } else {
            XB_SPIN(xb_ld(&bar[XB_XGEN(b.x)]) == gen, bar);
            __builtin_amdgcn_fence(__ATOMIC_ACQUIRE, "agent");
            asm volatile("s_waitcnt vmcnt(0)" ::: "memory");
        }
    }
    __syncthreads();
}

constexpr int RING_BYTES = 131072;
constexpr int LDSCTL_OFF = RING_BYTES, MISC_OFF = LDSCTL_OFF + 320;
constexpr int LDS_BYTES = 147456;

namespace pg8 {
#define PG8_LAS __attribute__((address_space(3)))
typedef unsigned short bf16_t;
typedef short bf16x8 __attribute__((ext_vector_type(8)));
typedef float f32x4 __attribute__((ext_vector_type(4)));
typedef unsigned u32x4 __attribute__((ext_vector_type(4)));
constexpr int BM = 256, BK = 64, HALF = 128, HTB = HALF * BK * 2  , STAGE_BYTES = 8 * HTB, NXCD = 8, WGM = 8;

__host__ __device__ __forceinline__ int lds_byte(int r, int c) { const int st = (r >> 4) * 2 + (c >> 5), rr = r & 15, cc = c & 31, ob = rr * 64 + cc * 2; return st * 1024 + (ob ^ (((ob >> 9) & 1) << 5)); }
__host__ __device__ __forceinline__ void stage_rc(int b, int& R, int& C) { const int st = b / 1024, sb = b % 1024, swz = sb ^ (((sb >> 9) & 1) << 5); R = (st >> 1) * 16 + swz / 64; C = (st & 1) * 32 + (swz % 64) / 2; }
__host__ __device__ __forceinline__ int perm32(int rho) { const int n = rho >> 4, i = rho & 15; return 8 * (i >> 2) + 4 * n + (i & 3); }

struct Unit { int pm, pn; };
struct Gemm { const bf16_t* A; const bf16_t* Bt; int M, N, K; };

struct StaticOrder {
    int nM, nN, nwg, G, c;
    __host__ __device__ void init(int M, int N, int G_, int c_) { nM = M / BM; nN = N / BM; nwg = nM * nN; G = G_; c = c_; }
    __host__ __device__ bool next(int i, Unit& u) const {
        const long L = (long)i * G + c; if (L >= nwg) return false;
        int wgid = (int)L; { const int q = nwg / NXCD, r = nwg % NXCD, xcd = wgid % NXCD, off = wgid / NXCD; wgid = (xcd < r ? xcd * (q + 1) : r * (q + 1) + (xcd - r) * q) + off; }
        const int nig = WGM * nN, gid = wgid / nig, fm = gid * WGM, gsz = (nM - fm) < WGM ? (nM - fm) : WGM;
        u.pm = fm + ((wgid % nig) % gsz); u.pn = (wgid % nig) / gsz; return true;
    }
    __device__ __forceinline__ void a_ready(const Unit&) const {}
    __device__ __forceinline__ void done(const Unit&) const {}
};
__device__ __forceinline__ unsigned cvt_pk_bf16(float lo, float hi) { unsigned r; asm volatile("v_cvt_pk_bf16_f32 %0, %1, %2" : "=v"(r) : "v"(lo), "v"(hi)); return r; }
typedef float f32x2 __attribute__((ext_vector_type(2)));
template <class Epi, class Sched, bool ALIGN_EPI = false, bool SP2 = false>
__device__ __forceinline__ void gemm_phase(PG8_LAS unsigned char* lds, const Gemm g, const Sched& S, const Epi& E, const int tid) {
    const int wid = __builtin_amdgcn_readfirstlane(tid >> 6), lane = tid & 63, wr = wid >> 2, wc = wid & 3, fr = lane & 15, fq = lane >> 4;
    const int K = g.K, nt = K / BK;
    unsigned voffA[2], voffB[2];
#pragma unroll
    for (int i = 0; i < 2; ++i) { int R, C; stage_rc(tid * 16 + i * 8192, R, C); const int Rb = Epi::BMODE == 1 ? ((R & ~31) + perm32(R & 31)) : Epi::BMODE == 2 ? (64 * (R >> 5) + (R & 31)) : R;
        voffA[i] = (unsigned)(R * K + C) * 2u; voffB[i] = (unsigned)(Rb * K + C) * 2u; }
    const size_t kstep = (size_t)(BK * 2);
    const size_t hstep = (size_t)HALF * K * 2;
    const size_t tstep = 2 * hstep;
    const size_t bhstep = Epi::BMODE == 2 ? (size_t)32 * K * 2 : hstep;
    const unsigned ldsw = (unsigned)wid * 1024u;
    const int aoff = lds_byte(wr * 64 + fr, fq * 8), boff = lds_byte(wc * 32 + fr, fq * 8);
#define PG8_SA(b, h) (((b) * 2 + (h)) * HTB)
#define PG8_SB(b, h) ((4 + (b) * 2 + (h)) * HTB)
#define PG8_STAGE(bufoff, gbase, voff) do { _Pragma("unroll") for (int _i = 0; _i < 2; ++_i) \
        __builtin_amdgcn_global_load_lds((const unsigned*)((const char*)(gbase) + (voff)[_i]), (PG8_LAS unsigned*)(lds + (bufoff) + ldsw + _i * 8192), 16, 0, 0); } while (0)
#define PG8_LDA(dst, b, h) do { _Pragma("unroll") for (int m = 0; m < 4; ++m) _Pragma("unroll") for (int k = 0; k < 2; ++k) dst[m][k] = *(const PG8_LAS bf16x8*)(lds + PG8_SA(b, h) + aoff + m * 2048 + k * 1024); } while (0)
#define PG8_LDB(dst, b, h) do { _Pragma("unroll") for (int n = 0; n < 2; ++n) _Pragma("unroll") for (int k = 0; k < 2; ++k) dst[n][k] = *(const PG8_LAS bf16x8*)(lds + PG8_SB(b, h) + boff + n * 2048 + k * 1024); } while (0)
#define PG8_MMA(ai, bj, At, Bt) do { __builtin_amdgcn_s_setprio(1); _Pragma("unroll") for (int m = 0; m < 4; ++m) _Pragma("unroll") for (int n = 0; n < 2; ++n) _Pragma("unroll") for (int k = 0; k < 2; ++k) \
        acc[ai][bj][m][n] = __builtin_amdgcn_mfma_f32_16x16x32_bf16(Bt[n][k], At[m][k], acc[ai][bj][m][n], 0, 0, 0); __builtin_amdgcn_s_setprio(0); } while (0)
#define PG8_WAIT_V(n) asm volatile("s_waitcnt vmcnt(" #n ")" ::: "memory")
#define PG8_WAIT_L(n) asm volatile("s_waitcnt lgkmcnt(" #n ")" ::: "memory")
#define PG8_BAR __builtin_amdgcn_s_barrier()
#define PG8_SCHED __builtin_amdgcn_sched_barrier(0)
    Unit cur, nxt; int ui = 0;
    if (!S.next(0, cur)) return;
    f32x4 acc[2][2][4][2];
#pragma unroll
    for (int a = 0; a < 2; ++a)
#pragma unroll
        for (int b = 0; b < 2; ++b)
#pragma unroll
            for (int m = 0; m < 4; ++m)
#pragma unroll
                for (int n = 0; n < 2; ++n) acc[a][b][m][n] = (f32x4){0.f, 0.f, 0.f, 0.f};
    bf16x8 At[4][2], B0[2][2], B1[2][2];
    const char* cA = (const char*)g.A + (size_t)cur.pm * tstep; const char* cB = (const char*)g.Bt + (size_t)cur.pn * tstep;
    S.a_ready(cur);
    if constexpr (SP2) {
        PG8_STAGE(PG8_SB(0, 0), cB, voffB); PG8_STAGE(PG8_SB(0, 1), cB + bhstep, voffB); PG8_STAGE(PG8_SA(0, 0), cA, voffA); PG8_STAGE(PG8_SA(0, 1), cA + hstep, voffA);
        if (wr == 1) PG8_BAR;
        PG8_WAIT_V(2); PG8_BAR;
        PG8_STAGE(PG8_SB(1, 0), cB + kstep, voffB); PG8_STAGE(PG8_SA(1, 0), cA + kstep, voffA); PG8_STAGE(PG8_SB(1, 1), cB + bhstep + kstep, voffB);
        PG8_WAIT_V(6); PG8_BAR;
    } else {
        PG8_STAGE(PG8_SB(0, 0), cB, voffB); PG8_STAGE(PG8_SA(0, 0), cA, voffA); PG8_STAGE(PG8_SB(0, 1), cB + bhstep, voffB); PG8_STAGE(PG8_SA(0, 1), cA + hstep, voffA);
        if (wr == 1) PG8_BAR;
        PG8_WAIT_V(4); PG8_BAR;
        PG8_STAGE(PG8_SB(1, 0), cB + kstep, voffB); PG8_STAGE(PG8_SA(1, 0), cA + kstep, voffA); PG8_STAGE(PG8_SB(1, 1), cB + bhstep + kstep, voffB);
        PG8_WAIT_V(6); PG8_BAR;
    }
    for (;;) {
        const bool has_next = S.next(ui + 1, nxt);
        const char* nA = has_next ? (const char*)g.A + (size_t)nxt.pm * tstep : cA; const char* nB = has_next ? (const char*)g.Bt + (size_t)nxt.pn * tstep : cB;
        for (int t = 0; t < nt; t += 2) {
            const bool last = (t == nt - 2);
            const char* a1 = cA + (size_t)(t + 1) * kstep;
            const char* a2 = last ? nA : cA + (size_t)(t + 2) * kstep; const char* b2 = last ? nB : cB + (size_t)(t + 2) * kstep;
            const char* a3 = a2 + kstep; const char* b3 = b2 + kstep;
            if (last && has_next) S.a_ready(nxt);
            if constexpr (SP2) {
            PG8_LDB(B0, 0, 0); PG8_LDB(B1, 0, 1); PG8_SCHED; PG8_LDA(At, 0, 0); PG8_STAGE(PG8_SA(1, 1), a1 + hstep, voffA);
            PG8_WAIT_V(8); PG8_WAIT_L(0); PG8_BAR; PG8_MMA(0, 0, At, B0); PG8_MMA(0, 1, At, B1); PG8_BAR; PG8_SCHED;
            PG8_LDA(At, 0, 1); PG8_STAGE(PG8_SB(0, 0), b2, voffB); PG8_STAGE(PG8_SB(0, 1), b2 + bhstep, voffB); PG8_STAGE(PG8_SA(0, 0), a2, voffA);
            PG8_WAIT_V(8); PG8_WAIT_L(0); PG8_BAR; PG8_MMA(1, 0, At, B0); PG8_MMA(1, 1, At, B1); PG8_BAR; PG8_SCHED;
            PG8_LDB(B0, 1, 0); PG8_LDB(B1, 1, 1); PG8_SCHED; PG8_LDA(At, 1, 0); PG8_STAGE(PG8_SA(0, 1), a2 + hstep, voffA);
            PG8_WAIT_V(8); PG8_WAIT_L(0); PG8_BAR; PG8_MMA(0, 0, At, B0); PG8_MMA(0, 1, At, B1); PG8_BAR; PG8_SCHED;
            PG8_LDA(At, 1, 1); PG8_STAGE(PG8_SB(1, 0), b3, voffB); PG8_STAGE(PG8_SB(1, 1), b3 + bhstep, voffB); PG8_STAGE(PG8_SA(1, 0), a3, voffA);
            PG8_WAIT_V(8); PG8_WAIT_L(0); PG8_BAR; PG8_MMA(1, 0, At, B0); PG8_MMA(1, 1, At, B1); PG8_BAR; PG8_SCHED;
            } else {
            PG8_LDB(B0, 0, 0); PG8_SCHED; PG8_LDA(At, 0, 0); PG8_STAGE(PG8_SA(1, 1), a1 + hstep, voffA);
            PG8_WAIT_L(8); PG8_BAR; PG8_WAIT_L(0); PG8_MMA(0, 0, At, B0); PG8_BAR; PG8_SCHED;
            PG8_LDB(B1, 0, 1); PG8_STAGE(PG8_SB(0, 0), b2, voffB);
            PG8_BAR; PG8_WAIT_L(0); PG8_MMA(0, 1, At, B1); PG8_BAR;
            PG8_LDA(At, 0, 1); PG8_STAGE(PG8_SA(0, 0), a2, voffA);
            PG8_BAR; PG8_WAIT_L(0); PG8_MMA(1, 0, At, B0); PG8_BAR; PG8_SCHED;
            PG8_STAGE(PG8_SB(0, 1), b2 + bhstep, voffB);
            PG8_WAIT_V(6); PG8_BAR; PG8_MMA(1, 1, At, B1); PG8_BAR;
            PG8_LDB(B0, 1, 0); PG8_SCHED; PG8_LDA(At, 1, 0); PG8_STAGE(PG8_SA(0, 1), a2 + hstep, voffA);
            PG8_WAIT_L(8); PG8_BAR; PG8_WAIT_L(0); PG8_MMA(0, 0, At, B0); PG8_BAR; PG8_SCHED;
            PG8_LDB(B1, 1, 1); PG8_STAGE(PG8_SB(1, 0), b3, voffB);
            PG8_BAR; PG8_WAIT_L(0); PG8_MMA(0, 1, At, B1); PG8_BAR;
            PG8_LDA(At, 1, 1); PG8_STAGE(PG8_SA(1, 0), a3, voffA);
            PG8_BAR; PG8_WAIT_L(0); PG8_MMA(1, 0, At, B0); PG8_BAR; PG8_SCHED;
            PG8_STAGE(PG8_SB(1, 1), b3 + bhstep, voffB);
            PG8_WAIT_V(6); PG8_BAR; PG8_MMA(1, 1, At, B1); PG8_BAR;
            }
        }
        if constexpr (ALIGN_EPI) { if (wr == 0) PG8_BAR; }
        if constexpr (!Epi::AFTER_DRAIN) { E(acc, cur, wr, wc, fr, fq); S.done(cur); }
        if (!has_next) break;
#pragma unroll
        for (int a = 0; a < 2; ++a)
#pragma unroll
            for (int b = 0; b < 2; ++b)
#pragma unroll
                for (int m = 0; m < 4; ++m)
#pragma unroll
                    for (int n = 0; n < 2; ++n) acc[a][b][m][n] = (f32x4){0.f, 0.f, 0.f, 0.f};
        cur = nxt; cA = nA; cB = nB; ++ui;
        if constexpr (ALIGN_EPI) { if (wr == 1) PG8_BAR; }
    }
    PG8_WAIT_V(0);
    if constexpr (!ALIGN_EPI) { if (wr == 0) PG8_BAR; }
    PG8_BAR;
    if constexpr (Epi::AFTER_DRAIN) { E.fused(acc, cur, wr, wc, fr, fq, lds, wid, lane); S.done(cur); }
#undef PG8_SA
#undef PG8_SB
#undef PG8_STAGE
#undef PG8_LDA
#undef PG8_LDB
#undef PG8_MMA
#undef PG8_WAIT_V
#undef PG8_WAIT_L
#undef PG8_BAR
#undef PG8_SCHED
}
}

namespace pg8 {
typedef unsigned u32x2 __attribute__((ext_vector_type(2)));
struct EpiQKV8 {
    static constexpr int BMODE = 2; static constexpr bool PERM = false, AFTER_DRAIN = false;
    const float* ssq; const float* qg; const float* kg; const ::f32x2* rope; bf16_t* Q; bf16_t* Kb; bf16_t* Vb;
    __device__ __forceinline__ void operator()(const f32x4 (&acc)[2][2][4][2], const Unit& u, int wr, int wc, int fr, int fq) const {
        const int pn = u.pn;
#pragma unroll
        for (int ai = 0; ai < 2; ++ai)
#pragma unroll
            for (int m = 0; m < 4; ++m) {
                const int row = u.pm * BM + ai * HALF + wr * 64 + m * 16 + fr; const float rs = rstd_from_slots(ssq, row);
                f32x4 v[2][2];
#pragma unroll
                for (int bj = 0; bj < 2; ++bj)
#pragma unroll
                    for (int n = 0; n < 2; ++n) v[bj][n] = acc[ai][bj][m][n] * rs;
                if (pn < 5) {
                    const bool isq = pn < 4; const float* g = isq ? qg : kg;
                    float ss = 0.f;
#pragma unroll
                    for (int bj = 0; bj < 2; ++bj)
#pragma unroll
                        for (int n = 0; n < 2; ++n) ss += (v[bj][n].x * v[bj][n].x + v[bj][n].y * v[bj][n].y) + (v[bj][n].z * v[bj][n].z + v[bj][n].w * v[bj][n].w);
                    ss += __shfl_xor(ss, 16); ss += __shfl_xor(ss, 32);
                    const float r = 1.0f / sqrtf(ss * (1.0f / 64.0f) + EPS);
#pragma unroll
                    for (int bj = 0; bj < 2; ++bj)
#pragma unroll
                        for (int n = 0; n < 2; ++n) { const f32x4 gv = *(const f32x4*)(g + 32 * bj + 16 * n + 4 * fq); v[bj][n] = v[bj][n] * r * gv; }
                    const int t = row % SEQ, prow = t >> 6, pcol = t & 63;
                    const float sc = isq ? C2 : 1.0f;
#pragma unroll
                    for (int bj = 0; bj < 2; ++bj) {
                        const int pos = bj == 0 ? prow : pcol;
                        const f32x4 cs01 = *(const f32x4*)(rope + pos * 16 + 4 * fq), cs23 = *(const f32x4*)(rope + pos * 16 + 4 * fq + 2);
                        const float cc[4] = {cs01.x, cs01.z, cs23.x, cs23.z}, sn[4] = {cs01.y, cs01.w, cs23.y, cs23.w};
                        const f32x4 x1 = v[bj][0], x2 = v[bj][1]; f32x4 o1, o2;
#pragma unroll
                        for (int j = 0; j < 4; ++j) { o1[j] = (x1[j] * cc[j] - x2[j] * sn[j]) * sc; o2[j] = (x2[j] * cc[j] + x1[j] * sn[j]) * sc; }
                        v[bj][0] = o1; v[bj][1] = o2;
                    }
                }
                bf16_t* dst = pn < 4 ? Q + (size_t)row * D + pn * 256 + wc * 64 : pn == 4 ? Kb + (size_t)row * KVP + wc * 64 : Vb + (size_t)row * KVP + wc * 64;
#pragma unroll
                for (int bj = 0; bj < 2; ++bj)
#pragma unroll
                    for (int n = 0; n < 2; ++n) { u32x2 w; w.x = cvt_pk_bf16(v[bj][n].x, v[bj][n].y); w.y = cvt_pk_bf16(v[bj][n].z, v[bj][n].w); *(u32x2*)(dst + 32 * bj + 16 * n + 4 * fq) = w; }
            }
    }
};
struct EpiRes8 {
    static constexpr int BMODE = 0; static constexpr bool PERM = false, AFTER_DRAIN = false;
    const float* base; float* out; bf16_t* xb; float* ssq;
    __device__ __forceinline__ void operator()(const f32x4 (&acc)[2][2][4][2], const Unit& u, int wr, int wc, int fr, int fq) const {
        const int col0 = u.pn * BM + wc * 32 + 4 * fq;
#pragma unroll
        for (int ai = 0; ai < 2; ++ai)
#pragma unroll
            for (int m = 0; m < 4; ++m) {
                const int row = u.pm * BM + ai * HALF + wr * 64 + m * 16 + fr; float ss = 0.f;
#pragma unroll
                for (int bj = 0; bj < 2; ++bj)
#pragma unroll
                    for (int n = 0; n < 2; ++n) { const size_t off = (size_t)row * D + col0 + bj * HALF + n * 16;
                        const f32x4 h = *(const f32x4*)(base + off) + acc[ai][bj][m][n]; *(f32x4*)(out + off) = h;
                        ss += (h.x * h.x + h.y * h.y) + (h.z * h.z + h.w * h.w);
                        if (xb) { u32x2 w; w.x = cvt_pk_bf16(h.x, h.y); w.y = cvt_pk_bf16(h.z, h.w); *(u32x2*)(xb + off) = w; } }
                ss += __shfl_xor(ss, 16); ss += __shfl_xor(ss, 32);
                if (ssq && fq == 0) ssq[(size_t)row * 16 + u.pn * 4 + wc] = ss;
                asm volatile("" ::: "memory");
            }
    }
};
struct EpiUp8 {
    static constexpr int BMODE = 1; static constexpr bool PERM = true, AFTER_DRAIN = false;
    const float* ssq; bf16_t* HB;
    __device__ __forceinline__ void operator()(const f32x4 (&acc)[2][2][4][2], const Unit& u, int wr, int wc, int fr, int fq) const {
        const int col0 = u.pn * BM + wc * 32 + 8 * fq;
#pragma unroll
        for (int ai = 0; ai < 2; ++ai)
#pragma unroll
            for (int m = 0; m < 4; ++m) {
                const int row = u.pm * BM + ai * HALF + wr * 64 + m * 16 + fr; const float rs = rstd_from_slots(ssq, row);
                bf16_t* rowp = HB + (size_t)row * FF + col0;
#pragma unroll
                for (int bj = 0; bj < 2; ++bj) { f32x4 v0 = acc[ai][bj][m][0] * rs, v1 = acc[ai][bj][m][1] * rs;
#pragma unroll
                    for (int j = 0; j < 4; ++j) { const float a = fmaxf(v0[j], 0.f), b = fmaxf(v1[j], 0.f); v0[j] = a * a; v1[j] = b * b; }
                    u32x4 w; w.x = cvt_pk_bf16(v0[0], v0[1]); w.y = cvt_pk_bf16(v0[2], v0[3]); w.z = cvt_pk_bf16(v1[0], v1[1]); w.w = cvt_pk_bf16(v1[2], v1[3]);
                    *(u32x4*)(rowp + bj * HALF) = w; }
            }
    }
};
struct EpiGin8 {
    static constexpr int BMODE = 1; static constexpr bool PERM = true, AFTER_DRAIN = false;
    const float* ssq; bf16_t* q; bf16_t* k; bf16_t* v; bf16_t* r;
    __device__ __forceinline__ void operator()(const f32x4 (&acc)[2][2][4][2], const Unit& u, int wr, int wc, int fr, int fq) const {
        const int pn = u.pn;
        bf16_t* basep; int ld, ct; float sc = 1.0f;
        if (pn < 2) { basep = q; ld = GQK; ct = pn; sc = 0.08838834764831845f; } else if (pn < 4) { basep = k; ld = GQK; ct = pn - 2; } else if (pn < 8) { basep = v; ld = GV; ct = pn - 4; } else { basep = r; ld = GV; ct = pn - 8; }
        const int col0 = ct * BM + wc * 32 + 8 * fq;
#pragma unroll
        for (int ai = 0; ai < 2; ++ai)
#pragma unroll
            for (int m = 0; m < 4; ++m) {
                const int row = u.pm * BM + ai * HALF + wr * 64 + m * 16 + fr; const float rs = rstd_from_slots(ssq, row) * sc;
                bf16_t* rowp = basep + (size_t)row * ld + col0;
#pragma unroll
                for (int bj = 0; bj < 2; ++bj) { const f32x4 v0 = acc[ai][bj][m][0] * rs, v1 = acc[ai][bj][m][1] * rs;
                    u32x4 w; w.x = cvt_pk_bf16(v0[0], v0[1]); w.y = cvt_pk_bf16(v0[2], v0[3]); w.z = cvt_pk_bf16(v1[0], v1[1]); w.w = cvt_pk_bf16(v1[2], v1[3]);
                    *(u32x4*)(rowp + bj * HALF) = w; }
            }
    }
};
}

namespace attn_body {
using bf16=__hip_bfloat16;
using bf16x8=__attribute__((ext_vector_type(8)))short;
using s16x4=__attribute__((ext_vector_type(4)))short;
using f32x16=__attribute__((ext_vector_type(16)))float;
using u32x4=__attribute__((ext_vector_type(4)))unsigned;
constexpr int BATCH=4,NHEAD=16,SEQ=4096,D=64,DM=NHEAD*D,KVP=256;
constexpr int NW=8,QBLK=32,QB=QBLK*NW,KVBLK=64,NQB=SEQ/QB;
constexpr int ATTN_PITCH=DM, ATTN_UNIT_ROWS=QB;
__device__ __forceinline__ int crow(int r,int hi){return (r&3)+8*(r>>2)+4*hi;}
#define SBAR() __builtin_amdgcn_sched_barrier(0)
__device__ __forceinline__ void cmask(f32x16&p0,f32x16&p1,int jb,int qrel,int hi){
  const float NEG=-INFINITY; int kb=64*jb+4*hi;
  #pragma unroll
  for(int r=0;r<16;++r){int kv=kb+(r&3)+8*(r>>2); if(kv>qrel)p0[r]=NEG; if(kv+32>qrel)p1[r]=NEG;}
}

constexpr int NSLOT=3, SLOTB=8192;
constexpr int LDS_K=0, LDS_V=NSLOT*SLOTB, LDS_WS=2*NSLOT*SLOTB, LDS_OST=LDS_WS+NW*64*4, LDS_BYTES=LDS_OST+NW*4096;
constexpr float C2=0.125f*1.4426950408889634f;
__device__ __forceinline__ void glds16(const void*gsrc,unsigned lds_dst){unsigned keep;
  asm volatile("s_mov_b32 %0, m0\n\ts_mov_b32 m0, %2\n\ts_nop 0\n\tglobal_load_lds_dwordx4 %1, off\n\ts_mov_b32 m0, %0":"=&s"(keep):"v"(gsrc),"s"(lds_dst):"memory");}
__device__ __forceinline__ float max3f(float a,float b,float c){float r;asm("v_max3_f32 %0, %1, %2, %3":"=v"(r):"v"(a),"v"(b),"v"(c));return r;}
__device__ __forceinline__ float max2f(float a,float b){float r;asm("v_max_f32_e32 %0, %1, %2":"=v"(r):"v"(a),"v"(b));return r;}
__device__ __forceinline__ float fadd_s(float a,float b){float r;asm("v_add_f32_e32 %0, %1, %2":"=v"(r):"v"(a),"v"(b));return r;}
__device__ __forceinline__ float fsub_s(float a,float b){float r;asm("v_sub_f32_e32 %0, %1, %2":"=v"(r):"v"(a),"v"(b));return r;}
typedef float f32x2_t __attribute__((ext_vector_type(2))); typedef __bf16 bf16x2_t __attribute__((ext_vector_type(2)));
__device__ __forceinline__ unsigned cvtpk_s(float lo,float hi){f32x2_t v={lo,hi};bf16x2_t b=__builtin_convertvector(v,bf16x2_t);return __builtin_bit_cast(unsigned,b);}
#define WAIT_BAR(N) asm volatile("s_waitcnt vmcnt(" #N ") lgkmcnt(0)\n\ts_barrier":::"memory")

__device__ __forceinline__ void qkt(f32x16&p0,f32x16&p1,const char*Kslot,const bf16x8*qr,const f32x16&negm,int r32,int hi){
  const char*kb=Kslot+hi*1024+r32*16;
  #pragma unroll
  for(int d0=0;d0<4;++d0){
    const bf16x8 b0=*reinterpret_cast<const bf16x8*>(kb+d0*2048);
    const bf16x8 b1=*reinterpret_cast<const bf16x8*>(kb+d0*2048+512);
    if(d0==0){p0=__builtin_amdgcn_mfma_f32_32x32x16_bf16(b0,qr[0],negm,0,0,0);p1=__builtin_amdgcn_mfma_f32_32x32x16_bf16(b1,qr[0],negm,0,0,0);}
    else{p0=__builtin_amdgcn_mfma_f32_32x32x16_bf16(b0,qr[d0],p0,0,0,0);p1=__builtin_amdgcn_mfma_f32_32x32x16_bf16(b1,qr[d0],p1,0,0,0);}}
}
typedef __attribute__((address_space(3))) const char* lds_cptr;
typedef short v4i16_t __attribute__((ext_vector_type(4)));
__device__ __forceinline__ void kload8(bf16x8*kf,lds_cptr kp){
  kf[0]=*(const __attribute__((address_space(3))) bf16x8*)(kp);      kf[1]=*(const __attribute__((address_space(3))) bf16x8*)(kp+512);
  kf[2]=*(const __attribute__((address_space(3))) bf16x8*)(kp+2048); kf[3]=*(const __attribute__((address_space(3))) bf16x8*)(kp+2560);
  kf[4]=*(const __attribute__((address_space(3))) bf16x8*)(kp+4096); kf[5]=*(const __attribute__((address_space(3))) bf16x8*)(kp+4608);
  kf[6]=*(const __attribute__((address_space(3))) bf16x8*)(kp+6144); kf[7]=*(const __attribute__((address_space(3))) bf16x8*)(kp+6656);
}
__device__ __forceinline__ void kload2(bf16x8*kf,lds_cptr kp,int j){ kf[2*j]=*(const __attribute__((address_space(3))) bf16x8*)(kp+j*2048); kf[2*j+1]=*(const __attribute__((address_space(3))) bf16x8*)(kp+j*2048+512); }
__device__ __forceinline__ s16x4 vtr(lds_cptr p){ return __builtin_bit_cast(s16x4,__builtin_amdgcn_ds_read_tr16_b64_v4i16((__attribute__((address_space(3))) v4i16_t*)p)); }
__device__ __forceinline__ float rowmax(const f32x16&p0,const f32x16&p1){
  float a=max3f(p0[0],p0[1],p1[0]),b=max3f(p0[2],p0[3],p1[1]);a=max3f(a,p1[2],p1[3]);
  #pragma unroll
  for(int r=4;r<16;r+=4){a=max3f(a,p0[r],p0[r+1]);b=max3f(b,p0[r+2],p0[r+3]);a=max3f(a,p1[r],p1[r+1]);b=max3f(b,p1[r+2],p1[r+3]);}
  const float m=max2f(a,b);
  auto rr=__builtin_amdgcn_permlane32_swap(__float_as_uint(m),__float_as_uint(m),false,false);
  return max2f(__uint_as_float(rr[0]),__uint_as_float(rr[1]));
}
__device__ __forceinline__ void pv(f32x16*o,int vb,bf16x8 pa0,bf16x8 pa1,bf16x8 pa2,bf16x8 pa3){
  #pragma unroll
  for(int d0=0;d0<2;++d0){s16x4 lo[4],hi[4];
    #pragma unroll
    for(int ks=0;ks<4;++ks){
      asm volatile("ds_read_b64_tr_b16 %0,%1 offset:%c2":"=&v"(lo[ks]):"v"(vb),"i"(d0*4096+ks*1024):"memory");
      asm volatile("ds_read_b64_tr_b16 %0,%1 offset:%c2":"=&v"(hi[ks]):"v"(vb),"i"(d0*4096+ks*1024+512):"memory");}
    asm volatile("s_waitcnt lgkmcnt(0)":::"memory");SBAR();
    #define PK(k) (bf16x8){lo[k][0],lo[k][1],lo[k][2],lo[k][3],hi[k][0],hi[k][1],hi[k][2],hi[k][3]}
    o[d0]=__builtin_amdgcn_mfma_f32_32x32x16_bf16(pa0,PK(0),o[d0],0,0,0);
    o[d0]=__builtin_amdgcn_mfma_f32_32x32x16_bf16(pa1,PK(1),o[d0],0,0,0);
    o[d0]=__builtin_amdgcn_mfma_f32_32x32x16_bf16(pa2,PK(2),o[d0],0,0,0);
    o[d0]=__builtin_amdgcn_mfma_f32_32x32x16_bf16(pa3,PK(3),o[d0],0,0,0);
    #undef PK
  }
}

#ifndef ATTN_STORE16
#define ATTN_STORE16(p,v) (*(u32x4*)(p)=(v))
#endif
template<int THRL> __device__ __forceinline__ void attn_unit(int b,int h,int qb,const bf16*Q,const bf16*__restrict__ K,const bf16*__restrict__ V,bf16*O,char*shm,const int tid){
  const int lane=tid&63,r32=lane&31,hi=lane>>5; const int wid=__builtin_amdgcn_readfirstlane(tid>>6);
  const long rowbase=(long)b*SEQ; const int q0=qb*QB;
  const bf16*Qw=Q+(rowbase+q0+wid*QBLK)*DM+h*D;
  const bf16*Kh=K+rowbase*KVP+(h>>2)*D,*Vh=V+rowbase*KVP+(h>>2)*D;
  const unsigned lds0=(unsigned)(uintptr_t)shm;
  float*wsf=(float*)(shm+LDS_WS)+wid*64;
  const bf16*ksrc=Kh+(long)lane*KVP+wid*8;
  const bf16*vsrc=Vh+(long)(16*(wid&3)+(lane>>2))*KVP+(wid>>2)*32+(lane&3)*8;
  const unsigned kdst=lds0+LDS_K+wid*1024, vdst=lds0+LDS_V+wid*1024;
  #define DMA_K(t,slot) glds16(ksrc+(long)(t)*KVBLK*KVP,(unsigned)__builtin_amdgcn_readfirstlane(kdst+(slot)))
  #define DMA_V(t,slot) glds16(vsrc+(long)(t)*KVBLK*KVP,(unsigned)__builtin_amdgcn_readfirstlane(vdst+(slot)))
  const int vb0=(int)(lds0+LDS_V)+((lane>>4)&1)*32+(lane&3)*8+(4*hi+((lane&15)>>2))*64;
  const char*Kbase=shm+LDS_K; bf16x8 kf[8];
  const lds_cptr shm3=(lds_cptr)shm; const lds_cptr kp0=shm3+LDS_K+hi*1024+r32*16; const lds_cptr vp0=shm3+LDS_V+((lane>>4)&1)*32+(lane&3)*8+(4*hi+((lane&15)>>2))*64;
  const int NT=SEQ/KVBLK;
  DMA_K(0,0);DMA_V(0,0);DMA_K(1,SLOTB);
  bf16x8 qr[4];
  #pragma unroll
  for(int d0=0;d0<4;++d0)qr[d0]=*reinterpret_cast<const bf16x8*>(&Qw[(long)r32*DM+d0*16+hi*8]);
  float mhat=0.f,l_reg=0.f;f32x16 o[2];o[0]=f32x16{};o[1]=f32x16{};f32x16 negm=f32x16{};asm volatile("":"+v"(negm));
  const int qrel=wid*QBLK+r32;
  #define CMASK(P0,P1,t) do{}while(0)
  bool resc=false;
  #define START(P0,P1) do{ const float rm=rowmax(P0,P1); resc=false; \
    { const float dl=rm; mhat=fadd_s(mhat,dl); \
      _Pragma("unroll") for(int r=0;r<16;++r){P0[r]=fsub_s(P0[r],dl);P1[r]=fsub_s(P1[r],dl);} \
      _Pragma("unroll") for(int r=0;r<16;++r)negm[r]=-mhat; asm volatile("":"+v"(negm)); } \
    _Pragma("unroll") for(int r=0;r<16;++r)P0[r]=__builtin_amdgcn_exp2f(P0[r]); }while(0)
  #define RESC() do{ if(resc){ asm volatile("s_waitcnt lgkmcnt(0)":::"memory"); \
      _Pragma("unroll") for(int d_=0;d_<2;++d_) _Pragma("unroll") for(int r=0;r<16;++r)o[d_][r]*=wsf[crow(r,hi)]; } }while(0)
  f32x16 pA0,pA1,pB0,pB1;
  int sl_prev=0,sl_cur=0,sl_next=SLOTB;
  #define ROT() do{sl_prev=sl_cur;sl_cur=sl_next;sl_next=(sl_next==(NSLOT-1)*SLOTB)?0:sl_next+SLOTB;}while(0)
  DMA_K(2,2*SLOTB);
  WAIT_BAR(3);
  qkt(pA0,pA1,Kbase,qr,negm,r32,hi);asm volatile("s_nop 15\n\ts_nop 7":"+v"(pA0),"+v"(pA1));CMASK(pA0,pA1,0);
  START(pA0,pA1);
  _Pragma("unroll") for(int r=0;r<16;++r)pA1[r]=__builtin_amdgcn_exp2f(pA1[r]);
  WAIT_BAR(0);
  DMA_K(3,0);DMA_V(1,SLOTB);
  ROT();
  kload8(kf,kp0+sl_cur);
  WAIT_BAR(2);
  s16x4 vlo[8],vhi[8]; u32x4 pw0,pw1,pw2,pw3;
  #define PKW(P,B) cvtpk_s(P[B],P[B+1])
  #define PAF(k) __builtin_bit_cast(bf16x8,pw##k)
  #define VFR(i) (bf16x8){vlo[i][0],vlo[i][1],vlo[i][2],vlo[i][3],vhi[i][0],vhi[i][1],vhi[i][2],vhi[i][3]}
  #define PIN(x) asm volatile("":"+v"(x))
  #define MX3(a,b,c) __builtin_fmaxf(__builtin_fmaxf((a),(b)),(c))
  #define GAPA(MF,A0,A1,A2,A3,W0,W1,PW) do{ MF; sacc+=A0; sacc+=A1; sacc+=A2; sacc+=A3; PIN(sacc); W0; W1; PIN(PW); SBAR(); }while(0)
  #define EX(v) __builtin_amdgcn_exp2f(v)
  #define GAPB(MF,X,B) do{ MF; X[B]=EX(X[B]); X[B+1]=EX(X[B+1]); X[B+2]=EX(X[B+2]); X[B+3]=EX(X[B+3]); PIN(X); SBAR(); }while(0)
  #define VRD(i) do{ vlo[i]=vtr(vp_+(((i)>>2)*4096+((i)&3)*1024)); vhi[i]=vtr(vp_+(((i)>>2)*4096+((i)&3)*1024+512)); }while(0)
  #define KRD(G,j) do{ if(G){ kload2(kf,kp0+sl_next,j); SBAR(); } }while(0)
  #define STEP(C0,C1,P0,P1,t,GK,GV,GL) do{ SBAR(); \
    const lds_cptr vp_=vp0+sl_prev; \
    VRD(0); SBAR(); float sacc=(P0[0]+P0[1]); \
    GAPA(C0=__builtin_amdgcn_mfma_f32_32x32x16_bf16(kf[0],qr[0],negm,0,0,0), P0[2],P0[3],P0[4],P0[5],     pw0[0]=PKW(P0,0), pw0[1]=PKW(P0,2), pw0); \
    VRD(4); SBAR(); GAPA(C1=__builtin_amdgcn_mfma_f32_32x32x16_bf16(kf[1],qr[0],negm,0,0,0), P0[6],P0[7],P0[8],P0[9],     pw0[2]=PKW(P0,4), pw0[3]=PKW(P0,6), pw0); \
    VRD(1); SBAR(); GAPA(C0=__builtin_amdgcn_mfma_f32_32x32x16_bf16(kf[2],qr[1],C0,0,0,0),   P0[10],P0[11],P0[12],P0[13], pw1[0]=PKW(P0,8), pw1[1]=PKW(P0,10), pw1); \
    VRD(5); SBAR(); GAPA(C1=__builtin_amdgcn_mfma_f32_32x32x16_bf16(kf[3],qr[1],C1,0,0,0),   P0[14],P0[15],P1[0],P1[1],   pw1[2]=PKW(P0,12),pw1[3]=PKW(P0,14), pw1); \
    VRD(2); SBAR(); GAPA(C0=__builtin_amdgcn_mfma_f32_32x32x16_bf16(kf[4],qr[2],C0,0,0,0),   P1[2],P1[3],P1[4],P1[5],     pw2[0]=PKW(P1,0), pw2[1]=PKW(P1,2), pw2); \
    VRD(6); SBAR(); GAPA(C1=__builtin_amdgcn_mfma_f32_32x32x16_bf16(kf[5],qr[2],C1,0,0,0),   P1[6],P1[7],P1[8],P1[9],     pw2[2]=PKW(P1,4), pw2[3]=PKW(P1,6), pw2); \
    VRD(3); SBAR(); GAPA(C0=__builtin_amdgcn_mfma_f32_32x32x16_bf16(kf[6],qr[3],C0,0,0,0),   P1[10],P1[11],P1[12],P1[13], pw3[0]=PKW(P1,8), pw3[1]=PKW(P1,10), pw3); \
    VRD(7); SBAR(); GAPA(C1=__builtin_amdgcn_mfma_f32_32x32x16_bf16(kf[7],qr[3],C1,0,0,0),   P1[14],P1[15],0.f,0.f,       pw3[2]=PKW(P1,12),pw3[3]=PKW(P1,14), pw3); \
    l_reg+=sacc; \
    if(GK){DMA_K((t)+3,sl_cur);} if(GV){DMA_V((t)+1,sl_next);} \
    CMASK(C0,C1,t); \
    { float a=MX3(C0[0],C0[1],C1[0]),b=MX3(C0[2],C0[3],C1[1]); a=MX3(a,C1[2],C1[3]); \
      _Pragma("unroll") for(int r=4;r<16;r+=4){a=MX3(a,C0[r],C0[r+1]);b=MX3(b,C0[r+2],C0[r+3]);a=MX3(a,C1[r],C1[r+1]);b=MX3(b,C1[r+2],C1[r+3]);} \
      float rm=__builtin_fmaxf(a,b); { auto rr=__builtin_amdgcn_permlane32_swap(__float_as_uint(rm),__float_as_uint(rm),false,false); rm=__builtin_fmaxf(__uint_as_float(rr[0]),__uint_as_float(rr[1])); } \
      resc=false; \
      if(__builtin_expect(__any(rm>(float)THRL),0)){ const float dl=__builtin_fmaxf(rm,0.f); mhat+=dl; \
        _Pragma("unroll") for(int r=0;r<16;++r){C0[r]-=dl;C1[r]-=dl;} \
        _Pragma("unroll") for(int r=0;r<16;++r)negm[r]=-mhat; asm volatile("":"+v"(negm)); \
        const float f=__builtin_amdgcn_exp2f(-dl); l_reg*=f; if(hi==0)wsf[r32]=f; resc=true; } } \
    SBAR(); \
    GAPB(o[0]=__builtin_amdgcn_mfma_f32_32x32x16_bf16(PAF(0),VFR(0),o[0],0,0,0), C0,0); \
    GAPB(o[1]=__builtin_amdgcn_mfma_f32_32x32x16_bf16(PAF(0),VFR(4),o[1],0,0,0), C0,4); \
    KRD(GL,0); GAPB(o[0]=__builtin_amdgcn_mfma_f32_32x32x16_bf16(PAF(1),VFR(1),o[0],0,0,0), C0,8); \
    KRD(GL,1); GAPB(o[1]=__builtin_amdgcn_mfma_f32_32x32x16_bf16(PAF(1),VFR(5),o[1],0,0,0), C0,12); \
    KRD(GL,2); GAPB(o[0]=__builtin_amdgcn_mfma_f32_32x32x16_bf16(PAF(2),VFR(2),o[0],0,0,0), C1,0); \
    KRD(GL,3); GAPB(o[1]=__builtin_amdgcn_mfma_f32_32x32x16_bf16(PAF(2),VFR(6),o[1],0,0,0), C1,4); \
    GAPB(o[0]=__builtin_amdgcn_mfma_f32_32x32x16_bf16(PAF(3),VFR(3),o[0],0,0,0), C1,8); \
    GAPB(o[1]=__builtin_amdgcn_mfma_f32_32x32x16_bf16(PAF(3),VFR(7),o[1],0,0,0), C1,12); \
    }while(0)
  int t=1;
  #undef CMASK
  #define CMASK(P0,P1,t) do{}while(0)
  for(;t+5<NT;t+=2){
    STEP(pB0,pB1,pA0,pA1,t,true,true,true);     WAIT_BAR(2); RESC(); ROT();
    STEP(pA0,pA1,pB0,pB1,t+1,true,true,true);   WAIT_BAR(2); RESC(); ROT();
  }
  #undef CMASK
  #define CMASK(P0,P1,t) do{}while(0)
  #define ENDW(tt) do{ if((tt)+3<NT){WAIT_BAR(2);} else if((tt)+2<NT){WAIT_BAR(1);} else {WAIT_BAR(0);} }while(0)
  for(;t+1<NT;t+=2){
    STEP(pB0,pB1,pA0,pA1,t,(t+3<NT),(t+1<NT),(t+1<NT));       ENDW(t);   RESC(); ROT();
    STEP(pA0,pA1,pB0,pB1,t+1,(t+4<NT),(t+2<NT),(t+2<NT));     ENDW(t+1); RESC(); ROT();
  }
  STEP(pB0,pB1,pA0,pA1,NT-1,false,false,false); RESC();
  { float sacc=pB0[0]+pB0[1]; _Pragma("unroll") for(int r=2;r<16;++r)sacc+=pB0[r]; _Pragma("unroll") for(int r=0;r<16;++r)sacc+=pB1[r]; l_reg+=sacc;
    pw0=(u32x4){PKW(pB0,0),PKW(pB0,2),PKW(pB0,4),PKW(pB0,6)};pw1=(u32x4){PKW(pB0,8),PKW(pB0,10),PKW(pB0,12),PKW(pB0,14)};pw2=(u32x4){PKW(pB1,0),PKW(pB1,2),PKW(pB1,4),PKW(pB1,6)};pw3=(u32x4){PKW(pB1,8),PKW(pB1,10),PKW(pB1,12),PKW(pB1,14)};
    SBAR(); pv(o,vb0+sl_cur,PAF(0),PAF(1),PAF(2),PAF(3)); }
  #undef PKW
  #undef PAF
  #undef VFR
  #undef PIN
  #undef MX3
  #undef GAPA
  #undef GAPB
  #undef EX
  #undef VRD
  #undef KRD
  #undef STEP
  #undef ENDW
  {auto rr=__builtin_amdgcn_permlane32_swap(__float_as_uint(l_reg),__float_as_uint(l_reg),false,false);l_reg=__uint_as_float(rr[0])+__uint_as_float(rr[1]);}
  if(hi==0)wsf[32+r32]=l_reg;asm volatile("s_waitcnt lgkmcnt(0)":::"memory");
  float rli[16];
  #pragma unroll
  for(int r=0;r<16;++r)rli[r]=__builtin_amdgcn_rcpf(wsf[32+crow(r,hi)]);
  bf16*Ow=O+(rowbase+q0+wid*QBLK)*DM+h*D;
  { bf16*stg=(bf16*)(shm+LDS_OST)+wid*2048;
    #pragma unroll
    for(int r=0;r<16;++r){const int orow=crow(r,hi);
      #pragma unroll
      for(int d0=0;d0<2;++d0)stg[orow*64+d0*32+r32]=__float2bfloat16(o[d0][r]*rli[r]);}
    asm volatile("s_waitcnt lgkmcnt(0)":::"memory");
    #pragma unroll
    for(int i=0;i<4;++i){const int row=i*8+(lane>>3),ch=lane&7; const u32x4 v=*(const u32x4*)(stg+row*64+ch*8); ATTN_STORE16(Ow+(long)row*DM+ch*8,v);} }
  asm volatile("s_waitcnt lgkmcnt(0)\n\ts_barrier":::"memory");
  #undef DMA_K
  #undef DMA_V
  #undef CMASK
  #undef START
  #undef RESC
  #undef ROT
}
constexpr int ATTN_LDS_BYTES=LDS_BYTES;
struct AttnTensors { const bf16* Q; const bf16* K; const bf16* V; bf16* O; };
struct AttnUnit { int bh; int qb; };
struct StaticOrder {
  int vcu,per;
  __device__ __forceinline__ explicit StaticOrder(int grid,int block):vcu((grid%8==0)?(block%8)*(grid/8)+block/8:block),per((BATCH*NHEAD*NQB+grid-1)/grid){}
  __device__ __forceinline__ bool next(int i,AttnUnit&u)const{ const int L=vcu*per+i; if(i>=per||L>=BATCH*NHEAD*NQB)return false; const int grp=L>>6,idx=L&63; u.bh=(grp>>2)*NHEAD+(grp&3)*4+(idx&3); u.qb=idx>>2; return true; }
  __device__ __forceinline__ void a_ready(const AttnUnit&)const{}
  __device__ __forceinline__ void done(const AttnUnit&)const{}
};
template<class Sched,int THRL=8> __device__ __forceinline__ void attn_phase(char*lds,const AttnTensors&T,const Sched&S,const int tid){
  AttnUnit u;
  for(int i=0;S.next(i,u);++i){ S.a_ready(u); attn_unit<THRL>(u.bh/NHEAD,u.bh%NHEAD,u.qb,T.Q,T.K,T.V,T.O,lds,tid); S.done(u); }
}
#undef SBAR
#undef WAIT_BAR
}

__device__ __forceinline__ void transpose_item(const float* W, const float* g, int K, int N, bf16_t* WT, LAS float* scr, int item, int lane) {
    const int nblk = N / 32, kb = item / nblk, nb = item % nblk, k0 = 64 * kb, n0 = 32 * nb;
#pragma unroll 8
    for (int i = 0; i < 32; ++i) { const int kk = 2 * i + (lane >> 5); const float gv = g ? g[k0 + kk] : 1.0f;
        scr[kk * 33 + (lane & 31)] = W[(size_t)(k0 + kk) * N + n0 + (lane & 31)] * gv; }
    LDS_WAIT(); asm volatile("" ::: "memory");
    const int c = lane & 7;
#pragma unroll
    for (int j = 0; j < 4; ++j) { const int n = (lane >> 3) + 8 * j; const LAS float* s = scr + (8 * c) * 33 + n;
        u32x4 o; o.x = pk2(s[0 * 33], s[1 * 33]); o.y = pk2(s[2 * 33], s[3 * 33]); o.z = pk2(s[4 * 33], s[5 * 33]); o.w = pk2(s[6 * 33], s[7 * 33]);
        *(u32x4*)(WT + (size_t)(n0 + n) * K + k0 + 8 * c) = o; }
    LDS_WAIT(); asm volatile("" ::: "memory");
}
__device__ __forceinline__ void sincos_d(double x, double& s, double& c) {
    const double TWO_PI = 6.283185307179586476925286766559;
    const double n = __builtin_rint(x / TWO_PI);
    const double r = x - n * TWO_PI, r2 = r * r;
    double ts = 1.0, tc = 1.0;
#pragma unroll
    for (int k = 13; k >= 1; --k) { ts = 1.0 - ts * r2 / (double)((2 * k) * (2 * k + 1)); tc = 1.0 - tc * r2 / (double)((2 * k - 1) * (2 * k)); }
    s = r * ts; c = tc;
}

template <class Epi>
__device__ __forceinline__ void gemm_simple(const bf16_t* A, const bf16_t* Bt, int Mrows, int N, int K, const Epi& E, int gw, int ngw, int lane) {
    const int fr = lane & 15, fq = lane >> 4;
    const int ntn = N / 64, ntm = Mrows / 32, ntiles = ntn * ntm;
    for (int t = gw; t < ntiles; t += ngw) {
        const int tn = t % ntn, tm = t / ntn;
        f32x4 acc[2][4];
#pragma unroll
        for (int m = 0; m < 2; ++m)
#pragma unroll
            for (int n = 0; n < 4; ++n) acc[m][n] = (f32x4){0.f, 0.f, 0.f, 0.f};
        const bf16_t* Ap = A + (size_t)(tm * 32 + fr) * K + fq * 8;
        const bf16_t* Bp = Bt + (size_t)(tn * 64 + fr) * K + fq * 8;
        for (int k0 = 0; k0 < K; k0 += 32) {
            bf16x8 a[2], b[4];
            a[0] = *(const bf16x8*)(Ap + k0); a[1] = *(const bf16x8*)(Ap + (size_t)16 * K + k0);
#pragma unroll
            for (int n = 0; n < 4; ++n) b[n] = *(const bf16x8*)(Bp + (size_t)n * 16 * K + k0);
#pragma unroll
            for (int m = 0; m < 2; ++m)
#pragma unroll
                for (int n = 0; n < 4; ++n) acc[m][n] = __builtin_amdgcn_mfma_f32_16x16x32_bf16(b[n], a[m], acc[m][n], 0, 0, 0);
        }
        E(tm * 32, tn * 64, acc, fr, fq);
    }
}

struct EpiQKV {
    const float* ssq; const float* qg; const float* kg; const f32x2* rope; bf16_t* Q; bf16_t* Kb; bf16_t* Vb;
    __device__ __forceinline__ void operator()(int row0, int col0, f32x4 (&acc)[2][4], int fr, int fq) const {
#pragma unroll
        for (int m = 0; m < 2; ++m) {
            const int row = row0 + 16 * m + fr; const float rs = rstd_from_slots(ssq, row);
            f32x4 v[4];
#pragma unroll
            for (int n = 0; n < 4; ++n) v[n] = acc[m][n] * rs;
            if (col0 < 1280) {
                const bool isq = col0 < 1024; const float* g = isq ? qg : kg;
                float ss = 0.f;
#pragma unroll
                for (int n = 0; n < 4; ++n) ss += (v[n].x * v[n].x + v[n].y * v[n].y) + (v[n].z * v[n].z + v[n].w * v[n].w);
                ss += __shfl_xor(ss, 16); ss += __shfl_xor(ss, 32);
                const float r = 1.0f / sqrtf(ss * (1.0f / 64.0f) + EPS);
#pragma unroll
                for (int n = 0; n < 4; ++n) { const f32x4 gv = *(const f32x4*)(g + 16 * n + 4 * fq); v[n] = v[n] * r * gv; }
                const int t = row % SEQ, prow = t >> 6, pcol = t & 63;
                const float sc = isq ? C2 : 1.0f;
#pragma unroll
                for (int hh = 0; hh < 2; ++hh) {
                    const int pos = hh == 0 ? prow : pcol;
                    f32x4 x1 = v[2 * hh], x2 = v[2 * hh + 1], o1, o2;
#pragma unroll
                    for (int j = 0; j < 4; ++j) { const f32x2 cs = rope[pos * 16 + 4 * fq + j];
                        o1[j] = (x1[j] * cs.x - x2[j] * cs.y) * sc; o2[j] = (x2[j] * cs.x + x1[j] * cs.y) * sc; }
                    v[2 * hh] = o1; v[2 * hh + 1] = o2;
                }
            }
            bf16_t* dst;
            if (col0 < 1024) dst = Q + (size_t)row * D + col0;
            else if (col0 < 1280) dst = Kb + (size_t)row * KVP + (col0 - 1024);
            else dst = Vb + (size_t)row * KVP + (col0 - 1280);
#pragma unroll
            for (int n = 0; n < 4; ++n) { u32x2 w; w.x = pk2(v[n].x, v[n].y); w.y = pk2(v[n].z, v[n].w); *(u32x2*)(dst + 16 * n + 4 * fq) = w; }
        }
    }
};
struct EpiRes {
    const float* base; float* out; bf16_t* xb; float* ssq;
    __device__ __forceinline__ void operator()(int row0, int col0, f32x4 (&acc)[2][4], int fr, int fq) const {
#pragma unroll
        for (int m = 0; m < 2; ++m) {
            const int row = row0 + 16 * m + fr; float ss = 0.f;
#pragma unroll
            for (int n = 0; n < 4; ++n) { const size_t off = (size_t)row * D + col0 + 16 * n + 4 * fq;
                const f32x4 h = *(const f32x4*)(base + off) + acc[m][n]; *(f32x4*)(out + off) = h;
                ss += (h.x * h.x + h.y * h.y) + (h.z * h.z + h.w * h.w);
                if (xb) { u32x2 w; w.x = pk2(h.x, h.y); w.y = pk2(h.z, h.w); *(u32x2*)(xb + off) = w; } }
            ss += __shfl_xor(ss, 16); ss += __shfl_xor(ss, 32);
            if (ssq && fq == 0) ssq[(size_t)row * 16 + (col0 >> 6)] = ss;
        }
    }
};
struct EpiUp {
    const float* ssq; bf16_t* HB;
    __device__ __forceinline__ void operator()(int row0, int col0, f32x4 (&acc)[2][4], int fr, int fq) const {
#pragma unroll
        for (int m = 0; m < 2; ++m) {
            const int row = row0 + 16 * m + fr; const float rs = rstd_from_slots(ssq, row);
#pragma unroll
            for (int n = 0; n < 4; ++n) { f32x4 v = acc[m][n] * rs;
#pragma unroll
                for (int j = 0; j < 4; ++j) { const float t = fmaxf(v[j], 0.f); v[j] = t * t; }
                u32x2 w; w.x = pk2(v.x, v.y); w.y = pk2(v.z, v.w); *(u32x2*)(HB + (size_t)row * FF + col0 + 16 * n + 4 * fq) = w; }
        }
    }
};
struct EpiGin {
    const float* ssq; bf16_t* q; bf16_t* k; bf16_t* v; bf16_t* r;
    __device__ __forceinline__ void operator()(int row0, int col0, f32x4 (&acc)[2][4], int fr, int fq) const {
#pragma unroll
        for (int m = 0; m < 2; ++m) {
            const int row = row0 + 16 * m + fr; float rs = rstd_from_slots(ssq, row);
            bf16_t* dst;
            if (col0 < 512) { dst = q + (size_t)row * GQK + col0; rs *= 0.08838834764831845f; }
            else if (col0 < 1024) dst = k + (size_t)row * GQK + (col0 - 512);
            else if (col0 < 2048) dst = v + (size_t)row * GV + (col0 - 1024);
            else dst = r + (size_t)row * GV + (col0 - 2048);
#pragma unroll
            for (int n = 0; n < 4; ++n) { const f32x4 x = acc[m][n] * rs; u32x2 w; w.x = pk2(x.x, x.y); w.y = pk2(x.z, x.w); *(u32x2*)(dst + 16 * n + 4 * fq) = w; }
        }
    }
};
struct EpiZ {
    const float* ssq; float* Z;
    __device__ __forceinline__ void operator()(int row0, int col0, f32x4 (&acc)[2][4], int fr, int fq) const {
#pragma unroll
        for (int m = 0; m < 2; ++m) {
            const int row = row0 + 16 * m + fr; const float rs = rstd_from_slots(ssq, row);
#pragma unroll
            for (int n = 0; n < 4; ++n) *(f32x4*)(Z + (size_t)row * 64 + col0 + 16 * n + 4 * fq) = acc[m][n] * rs;
        }
    }
};

__device__ __forceinline__ void attn_simple(const bf16_t* Q, const bf16_t* Kb, const bf16_t* Vb, bf16_t* O, int gw, int ngw, int lane) {
    const int fr = lane & 15, fq = lane >> 4;
    for (int u = gw; u < BATCH * NH * (SEQ / 16); u += ngw) {
        const int qt = u & 255, h = (u >> 8) & 15, b = u >> 12, kvh = h >> 2;
        const size_t rowbase = (size_t)b * SEQ;
        const bf16_t* Qp = Q + (rowbase + qt * 16 + fr) * D + h * HD + fq * 8;
        bf16x8 qf[2]; qf[0] = *(const bf16x8*)Qp; qf[1] = *(const bf16x8*)(Qp + 32);
        const bf16_t* Kh = Kb + rowbase * KVP + kvh * HD;
        const bf16_t* Vh = Vb + rowbase * KVP + kvh * HD;
        float mrun = -1e30f, lrun = 0.f;
        f32x4 oacc[4];
#pragma unroll
        for (int dt = 0; dt < 4; ++dt) oacc[dt] = (f32x4){0.f, 0.f, 0.f, 0.f};
        for (int kt = 0; kt < SEQ / 64; ++kt) {
            const int key0 = kt * 64;
            f32x4 sT[4];
#pragma unroll
            for (int blk = 0; blk < 4; ++blk) {
                const int key = key0 + 32 * (blk >> 1) + 8 * (fr >> 2) + 4 * (blk & 1) + (fr & 3);
                const bf16_t* kp = Kh + (size_t)key * KVP + fq * 8;
                const bf16x8 k0 = *(const bf16x8*)kp, k1 = *(const bf16x8*)(kp + 32);
                f32x4 z = (f32x4){0.f, 0.f, 0.f, 0.f};
                z = __builtin_amdgcn_mfma_f32_16x16x32_bf16(k0, qf[0], z, 0, 0, 0);
                z = __builtin_amdgcn_mfma_f32_16x16x32_bf16(k1, qf[1], z, 0, 0, 0);
                sT[blk] = z;
            }
            float mx = sT[0][0];
#pragma unroll
            for (int blk = 0; blk < 4; ++blk)
#pragma unroll
                for (int r = 0; r < 4; ++r) mx = fmaxf(mx, sT[blk][r]);
            mx = fmaxf(mx, __shfl_xor(mx, 16)); mx = fmaxf(mx, __shfl_xor(mx, 32));
            const float mnew = fmaxf(mrun, mx), alpha = __builtin_amdgcn_exp2f(mrun - mnew); mrun = mnew;
            float ps = 0.f; bf16x8 pf[2];
#pragma unroll
            for (int ks = 0; ks < 2; ++ks) {
                float p[8];
#pragma unroll
                for (int j = 0; j < 8; ++j) { p[j] = __builtin_amdgcn_exp2f(sT[2 * ks + (j >> 2)][j & 3] - mnew); ps += p[j]; }
                u32x4 w; w.x = pk2(p[0], p[1]); w.y = pk2(p[2], p[3]); w.z = pk2(p[4], p[5]); w.w = pk2(p[6], p[7]);
                pf[ks] = __builtin_bit_cast(bf16x8, w);
            }
            lrun = lrun * alpha + ps;
#pragma unroll
            for (int dt = 0; dt < 4; ++dt) oacc[dt] = oacc[dt] * alpha;
#pragma unroll
            for (int ks = 0; ks < 2; ++ks)
#pragma unroll
                for (int dt = 0; dt < 4; ++dt) {
                    const bf16_t* vp = Vh + (size_t)(key0 + 32 * ks + 8 * fq) * KVP + dt * 16 + fr;
                    bf16x8 vf;
#pragma unroll
                    for (int e = 0; e < 8; ++e) vf[e] = (short)vp[(size_t)e * KVP];
                    oacc[dt] = __builtin_amdgcn_mfma_f32_16x16x32_bf16(vf, pf[ks], oacc[dt], 0, 0, 0);
                }
        }
        lrun += __shfl_xor(lrun, 16); lrun += __shfl_xor(lrun, 32);
        const float inv = 1.0f / lrun;
        bf16_t* Op = O + (rowbase + qt * 16 + fr) * D + h * HD + 4 * fq;
#pragma unroll
        for (int dt = 0; dt < 4; ++dt) { const f32x4 o = oacc[dt] * inv; u32x2 w; w.x = pk2(o.x, o.y); w.y = pk2(o.z, o.w); *(u32x2*)(Op + dt * 16) = w; }
    }
}

__device__ __forceinline__ void gla_pre(const bf16_t* q, const bf16_t* k, const float* Z, const float* wgu, const float* bgate, bf16_t* qe, bf16_t* ke, float* decay, int wg, int nwg, int tid) {
    const int c = tid, h = c >> 7, d = c & 127;
    for (int it = wg; it < BATCH * NCH * 2; it += nwg) {
        const int dir = it & 1, n = (it >> 1) & (NCH - 1), b = it >> 7;
        float w[RANK];
#pragma unroll
        for (int r = 0; r < RANK; ++r) w[r] = wgu[((size_t)dir * RANK + r) * GQK + c];
        const float bg = bgate[dir * GQK + c];
        float bsum = 0.f;
        bf16_t* qed = qe + (size_t)dir * M * GQK; bf16_t* ked = ke + (size_t)dir * M * GQK;
        for (int s = 0; s < CH; ++s) {
            const int i = dir == 0 ? s : (CH - 1 - s);
            const size_t tok = (size_t)b * SEQ + n * CH + i;
            const f32x4* zp = (const f32x4*)(Z + tok * 64 + dir * RANK);
            const f32x4 z0 = zp[0], z1 = zp[1], z2 = zp[2], z3 = zp[3];
            float logit = bg;
            logit += z0.x * w[0] + z0.y * w[1] + z0.z * w[2] + z0.w * w[3];
            logit += z1.x * w[4] + z1.y * w[5] + z1.z * w[6] + z1.w * w[7];
            logit += z2.x * w[8] + z2.y * w[9] + z2.z * w[10] + z2.w * w[11];
            logit += z3.x * w[12] + z3.y * w[13] + z3.z * w[14] + z3.w * w[15];
            const float lg = (fminf(logit, 0.f) - log1pf(expf(-fabsf(logit)))) * (1.0f / 16.0f);
            bsum += lg;
            const float eb = expf(bsum), enb = expf(-bsum);
            qed[tok * GQK + c] = (bf16_t)f2bf(bf2f(q[tok * GQK + c]) * eb);
            ked[tok * GQK + c] = (bf16_t)f2bf(bf2f(k[tok * GQK + c]) * enb);
        }
        decay[((((size_t)b * GH + h) * 2 + dir) * NCH + n) * GDK + d] = expf(bsum);
    }
}

__device__ __forceinline__ void gla_scan_simple(const bf16_t* qe, const bf16_t* ke, const bf16_t* v, const float* decay, bf16_t* of, bf16_t* ob, LAS unsigned char* lds, int wg, int nwg, int tid) {
    LAS float* qeL = (LAS float*)lds;
    LAS float* keL = qeL + 64 * 129;
    LAS float* vL = keL + 64 * 129;
    LAS float* AL = vL + 64 * 33;
    LAS float* SL = AL + 64 * 65;
    LAS float* dL = SL + 128 * 33;
    for (int it = wg; it < BATCH * GH * 2 * 8; it += nwg) {
        const int js = it & 7, dir = (it >> 3) & 1, h = (it >> 4) & 3, b = it >> 6;
        const bf16_t* qed = qe + (size_t)dir * M * GQK; const bf16_t* ked = ke + (size_t)dir * M * GQK;
        bf16_t* od = dir == 0 ? of : ob;
        for (int e = tid; e < 128 * 33; e += NTHREADS) SL[e] = 0.f;
        __syncthreads();
        for (int st = 0; st < NCH; ++st) {
            const int n = dir == 0 ? st : (NCH - 1 - st);
            const size_t tok0 = (size_t)b * SEQ + n * CH;
            {
                const int i = tid >> 3, ds = (tid & 7) * 16;
                const u32x4* qp = (const u32x4*)(qed + (tok0 + i) * GQK + h * GDK + ds);
                const u32x4* kp = (const u32x4*)(ked + (tok0 + i) * GQK + h * GDK + ds);
#pragma unroll
                for (int hh = 0; hh < 2; ++hh) { const u32x4 a = qp[hh], c = kp[hh];
#pragma unroll
                    for (int j = 0; j < 4; ++j) { qeL[i * 129 + ds + hh * 8 + 2 * j] = bflo(a[j]); qeL[i * 129 + ds + hh * 8 + 2 * j + 1] = bfhi(a[j]);
                                                  keL[i * 129 + ds + hh * 8 + 2 * j] = bflo(c[j]); keL[i * 129 + ds + hh * 8 + 2 * j + 1] = bfhi(c[j]); } }
                if (tid < 256) { const int iv = tid >> 2, vs = (tid & 3) * 8;
                    const u32x4 a = *(const u32x4*)(v + (tok0 + iv) * GV + h * GDV + js * 32 + vs);
#pragma unroll
                    for (int j = 0; j < 4; ++j) { vL[iv * 33 + vs + 2 * j] = bflo(a[j]); vL[iv * 33 + vs + 2 * j + 1] = bfhi(a[j]); } }
                if (tid < 128) dL[tid] = decay[((((size_t)b * GH + h) * 2 + dir) * NCH + n) * GDK + tid];
            }
            __syncthreads();
            {
                const int i = tid >> 3, jg = tid & 7;
                float a[8];
#pragma unroll
                for (int e = 0; e < 8; ++e) a[e] = 0.f;
                for (int d = 0; d < GDK; ++d) { const float qv = qeL[i * 129 + d];
#pragma unroll
                    for (int e = 0; e < 8; ++e) a[e] += qv * keL[(jg + 8 * e) * 129 + d]; }
#pragma unroll
                for (int e = 0; e < 8; ++e) { const int j = jg + 8 * e; const bool keep = dir == 0 ? (j <= i) : (j >= i); AL[i * 65 + j] = keep ? a[e] : 0.f; }
            }
            __syncthreads();
            {
                const int i = tid >> 3, vg = (tid & 7) * 4;
                float o[4] = {0.f, 0.f, 0.f, 0.f};
                for (int j = 0; j < CH; ++j) { const float a = AL[i * 65 + j];
#pragma unroll
                    for (int e = 0; e < 4; ++e) o[e] += a * vL[j * 33 + vg + e]; }
                for (int d = 0; d < GDK; ++d) { const float qv = qeL[i * 129 + d];
#pragma unroll
                    for (int e = 0; e < 4; ++e) o[e] += qv * SL[d * 33 + vg + e]; }
                u32x2 w; w.x = pk2(o[0], o[1]); w.y = pk2(o[2], o[3]);
                *(u32x2*)(od + (tok0 + i) * GV + h * GDV + js * 32 + vg) = w;
            }
            __syncthreads();
            {
                const int d = tid >> 2, vg = (tid & 3) * 8;
                float s[8];
#pragma unroll
                for (int e = 0; e < 8; ++e) s[e] = SL[d * 33 + vg + e];
                for (int j = 0; j < CH; ++j) { const float kv = keL[j * 129 + d];
#pragma unroll
                    for (int e = 0; e < 8; ++e) s[e] += kv * vL[j * 33 + vg + e]; }
                const float dc = dL[d];
#pragma unroll
                for (int e = 0; e < 8; ++e) SL[d * 33 + vg + e] = dc * s[e];
            }
            __syncthreads();
        }
    }
}

__device__ __forceinline__ void gla_combine(bf16_t* of, const bf16_t* ob, const bf16_t* r, const float* og, int gw, int ngw, int lane) {
    for (int row = gw; row < M; row += ngw) {
        const size_t off = (size_t)row * GV + lane * 16;
        const u32x4 a0 = *(const u32x4*)(of + off), a1 = *(const u32x4*)(of + off + 8);
        const u32x4 b0 = *(const u32x4*)(ob + off), b1 = *(const u32x4*)(ob + off + 8);
        const u32x4 r0 = *(const u32x4*)(r + off), r1 = *(const u32x4*)(r + off + 8);
        float o[16], rr[16];
#pragma unroll
        for (int j = 0; j < 4; ++j) { o[2 * j] = bflo(a0[j]) + bflo(b0[j]); o[2 * j + 1] = bfhi(a0[j]) + bfhi(b0[j]); o[8 + 2 * j] = bflo(a1[j]) + bflo(b1[j]); o[8 + 2 * j + 1] = bfhi(a1[j]) + bfhi(b1[j]);
            rr[2 * j] = bflo(r0[j]); rr[2 * j + 1] = bfhi(r0[j]); rr[8 + 2 * j] = bflo(r1[j]); rr[8 + 2 * j + 1] = bfhi(r1[j]); }
        float ss = 0.f;
#pragma unroll
        for (int j = 0; j < 16; ++j) ss += o[j] * o[j];
        ss += __shfl_xor(ss, 1); ss += __shfl_xor(ss, 2); ss += __shfl_xor(ss, 4); ss += __shfl_xor(ss, 8);
        const float rs = 1.0f / sqrtf(ss * (1.0f / GDV) + EPS);
        const int dv0 = (lane & 15) * 16;
        float g[16];
#pragma unroll
        for (int j = 0; j < 16; ++j) { const float y = o[j] * rs * og[dv0 + j]; const float x = rr[j]; g[j] = y * x / (1.0f + __expf(-x)); }
        u32x4 w0, w1;
#pragma unroll
        for (int j = 0; j < 4; ++j) { w0[j] = pk2(g[2 * j], g[2 * j + 1]); w1[j] = pk2(g[8 + 2 * j], g[8 + 2 * j + 1]); }
        *(u32x4*)(of + off) = w0; *(u32x4*)(of + off + 8) = w1;
    }
}

struct Args { const float* in[15]; float* out; unsigned char* ws; int ph_lo, ph_hi; };
static_assert(sizeof(Args) == 15 * 8 + 8 + 8 + 8, "Args has no padding");

__global__ void __launch_bounds__(NTHREADS, 2) fwd_kernel(Args args) {
    extern __shared__ __attribute__((aligned(16))) unsigned char lds_raw[];
    LAS unsigned char* lds = (LAS unsigned char*)lds_raw;
    const int tid0 = threadIdx.x;
#define KARG_BASE() const __attribute__((address_space(4))) unsigned char* ka_ = (const __attribute__((address_space(4))) unsigned char*)__builtin_amdgcn_kernarg_segment_ptr(); asm volatile("" : "+s"(ka_))
#define IN_PTR(i) (*(const float* const __attribute__((address_space(4)))*)(ka_ + 8 * (i)))
#define OUT_PTR() (*(float* const __attribute__((address_space(4)))*)(ka_ + 8 * 15))
#define WS_PTR() (*(unsigned char* const __attribute__((address_space(4)))*)(ka_ + 8 * 16))
#define WSP(T, off) ((T*)(ws + (off)))
    for (int u = tid0; u < (LDS_BYTES - LDSCTL_OFF) / 4; u += NTHREADS) ((LAS unsigned*)(lds + LDSCTL_OFF))[u] = 0u;
    __syncthreads();
    volatile LAS unsigned* MISC = (volatile LAS unsigned*)(lds + MISC_OFF);
    const int lo = args.ph_lo, hi = args.ph_hi;
    const bool multi = (hi - lo) > 1;
    XcdBarrier bar; bar.bar = (unsigned*)(args.ws + WS_CTL) + 4096; bar.x = 0; bar.st = nullptr;
    if (multi) bar = xcd_barrier_post((unsigned*)(args.ws + WS_CTL) + 4096, MISC + 8);
#ifndef FAST_GEMM
#define FAST_GEMM 15
#endif
    for (int ph = lo; ph < hi; ++ph) {
        int tid = threadIdx.x; asm volatile("" : "+v"(tid));
        int wg = blockIdx.x, G = gridDim.x; asm volatile("" : "+s"(wg), "+s"(G));
        const int lane = tid & 63, wave = __builtin_amdgcn_readfirstlane(tid >> 6);
        const int gw = wg * NWAVES + wave, ngw = G * NWAVES;
        switch (ph) {
        case 0: {
            KARG_BASE(); unsigned char* ws = WS_PTR();
            const float* x = IN_PTR(0); const float* norm_mix = IN_PTR(1); const float* norm_mlp = IN_PTR(2); const float* attn_w_qkv = IN_PTR(3); const float* attn_w_o = IN_PTR(6);
            const float* gla_w_in = IN_PTR(7); const float* gla_w_o = IN_PTR(11); const float* mlp_w_in = IN_PTR(12); const float* mlp_w_out = IN_PTR(13);
            bf16_t* Wqkv = WSP(bf16_t, W_QKV); bf16_t* Wo0 = WSP(bf16_t, W_O0); bf16_t* W1a = WSP(bf16_t, W_1A); bf16_t* W2a = WSP(bf16_t, W_2A);
            bf16_t* Wgin = WSP(bf16_t, W_GIN); bf16_t* Wo1 = WSP(bf16_t, W_O1); bf16_t* W1b = WSP(bf16_t, W_1B); bf16_t* W2b = WSP(bf16_t, W_2B);
            bf16_t* XB = WSP(bf16_t, WS_XB); float* SSQ0 = WSP(float, WS_SSQ); f32x2* ROPE = WSP(f32x2, WS_ROPE);
            LAS float* scr = (LAS float*)(lds + wave * 16384);
            constexpr int I_QKV = 16 * 48, I_O = 16 * 32, I_1 = 16 * 128, I_2 = 64 * 32, I_GIN = 16 * 97;
            constexpr int NITEMS = I_QKV + I_O + I_1 + I_2 + I_GIN + I_O + I_1 + I_2;
            for (int it = gw; it < NITEMS; it += ngw) {
                int r = it;
                if (r < I_QKV) { transpose_item(attn_w_qkv, norm_mix, D, QKV_N, Wqkv, scr, r, lane); continue; } r -= I_QKV;
                if (r < I_O) { transpose_item(attn_w_o, nullptr, D, D, Wo0, scr, r, lane); continue; } r -= I_O;
                if (r < I_1) { transpose_item(mlp_w_in, norm_mlp, D, FF, W1a, scr, r, lane); continue; } r -= I_1;
                if (r < I_2) { transpose_item(mlp_w_out, nullptr, FF, D, W2a, scr, r, lane); continue; } r -= I_2;
                if (r < I_GIN) { transpose_item(gla_w_in, norm_mix + D, D, GIN, Wgin, scr, r, lane); continue; } r -= I_GIN;
                if (r < I_O) { transpose_item(gla_w_o, nullptr, D, D, Wo1, scr, r, lane); continue; } r -= I_O;
                if (r < I_1) { transpose_item(mlp_w_in + (size_t)D * FF, norm_mlp + D, D, FF, W1b, scr, r, lane); continue; } r -= I_1;
                transpose_item(mlp_w_out + (size_t)FF * D, nullptr, FF, D, W2b, scr, r, lane);
            }
            for (int e = gw * 64 + lane; e < 32 * D / 8; e += ngw * 64) *(u32x4*)(Wgin + (size_t)GIN * D + (size_t)e * 8) = (u32x4){0u, 0u, 0u, 0u};
            for (int m = gw; m < M; m += ngw) {
                const f32x4* xr = (const f32x4*)(x + (size_t)m * D) + lane;
                f32x4 v[4]; float s = 0.f;
#pragma unroll
                for (int j = 0; j < 4; ++j) { v[j] = xr[64 * j]; s += (v[j].x * v[j].x + v[j].y * v[j].y) + (v[j].z * v[j].z + v[j].w * v[j].w); }
                s = wave_sum(s);
                u32x2* o8 = (u32x2*)(XB + (size_t)m * D) + lane;
#pragma unroll
                for (int j = 0; j < 4; ++j) { u32x2 w; w.x = pk2(v[j].x, v[j].y); w.y = pk2(v[j].z, v[j].w); o8[64 * j] = w; }
                if (lane < 16) SSQ0[(size_t)m * 16 + lane] = lane == 0 ? s : 0.f;
            }
            if (wg == 0) {
                for (int e = tid; e < 64 * 16; e += NTHREADS) {
                    const int pos = e >> 4, i = e & 15;
                    double invd = (i & 3) == 0 ? 1.0 : (i & 3) == 1 ? 0.56234132519034908 : (i & 3) == 2 ? 0.31622776601683794 : 0.17782794100389228;
                    invd *= (i >> 2) == 0 ? 1.0 : (i >> 2) == 1 ? 0.1 : (i >> 2) == 2 ? 0.01 : 0.001;
                    const float invf = (float)invd; const float ang = (float)pos * invf;
                    double s, c; sincos_d((double)ang, s, c);
                    ROPE[e] = (f32x2){(float)c, (float)s};
                }
            }
        } break;
        case 1: {
            KARG_BASE(); unsigned char* ws = WS_PTR(); const float* attn_qn = IN_PTR(4); const float* attn_kn = IN_PTR(5);
            const bf16_t* XB = WSP(bf16_t, WS_XB); const bf16_t* Wqkv = WSP(bf16_t, W_QKV); const float* SSQ0 = WSP(float, WS_SSQ); const f32x2* ROPE = WSP(f32x2, WS_ROPE);
            bf16_t* Qb = WSP(bf16_t, WS_BIG); bf16_t* Kb = WSP(bf16_t, WS_BIG + 32 * MiB); bf16_t* Vb = WSP(bf16_t, WS_BIG + 40 * MiB);
            if (FAST_GEMM & 1) { pg8::Gemm g{XB, Wqkv, M, QKV_N, D}; pg8::StaticOrder S; S.init(M, QKV_N, G, wg);
                pg8::EpiQKV8 E{SSQ0, attn_qn, attn_kn, ROPE, Qb, Kb, Vb};
                pg8::gemm_phase<pg8::EpiQKV8, pg8::StaticOrder, true, true>(lds, g, S, E, tid); }
            else { EpiQKV E{SSQ0, attn_qn, attn_kn, ROPE, Qb, Kb, Vb}; gemm_simple(XB, Wqkv, M, QKV_N, D, E, gw, ngw, lane); }
        } break;
        case 2: {
            KARG_BASE(); unsigned char* ws = WS_PTR();
            bf16_t* Qb = WSP(bf16_t, WS_BIG); bf16_t* Kb = WSP(bf16_t, WS_BIG + 32 * MiB); bf16_t* Vb = WSP(bf16_t, WS_BIG + 40 * MiB);
#ifndef FAST_ATTN
#define FAST_ATTN 1
#endif
            if (FAST_ATTN) {
                const attn_body::AttnTensors AT{(const attn_body::bf16*)Qb, (const attn_body::bf16*)Kb, (const attn_body::bf16*)Vb, (attn_body::bf16*)Qb};
                const attn_body::StaticOrder S(G, wg);
                attn_body::attn_phase<attn_body::StaticOrder>((char*)lds_raw, AT, S, tid);
            } else attn_simple(Qb, Kb, Vb, Qb, gw, ngw, lane);
        } break;
        case 3: case 5: case 10: case 12: {
            KARG_BASE(); unsigned char* ws = WS_PTR(); float* out = OUT_PTR();
            const bf16_t* A = WSP(bf16_t, ph == 10 ? WS_QK : WS_BIG);
            const bf16_t* Bt = WSP(bf16_t, ph == 3 ? W_O0 : ph == 5 ? W_2A : ph == 10 ? W_O1 : W_2B);
            const int K = (ph == 3 || ph == 10) ? D : FF;
            const float* base = ph == 3 ? IN_PTR(0) : out;
            bf16_t* xb = ph == 12 ? nullptr : WSP(bf16_t, WS_XB);
            float* ssq = ph == 12 ? nullptr : WSP(float, WS_SSQ + (ph == 3 ? 1 : ph == 5 ? 2 : 3) * (size_t)M * 64);
            if (FAST_GEMM & 2) { pg8::Gemm g{A, Bt, M, D, K}; pg8::StaticOrder S; S.init(M, D, G, wg);
                pg8::EpiRes8 E{base, out, xb, ssq};
                pg8::gemm_phase<pg8::EpiRes8, pg8::StaticOrder, true, true>(lds, g, S, E, tid); }
            else { EpiRes E{base, out, xb, ssq}; gemm_simple(A, Bt, M, D, K, E, gw, ngw, lane); }
        } break;
        case 4: case 11: {
            KARG_BASE(); unsigned char* ws = WS_PTR();
            const bf16_t* XB = WSP(bf16_t, WS_XB); bf16_t* HB = WSP(bf16_t, WS_BIG);
            const bf16_t* Bt = WSP(bf16_t, ph == 4 ? W_1A : W_1B); const float* ssq = WSP(float, WS_SSQ + (ph == 4 ? 1 : 3) * (size_t)M * 64);
            if (FAST_GEMM & 4) { pg8::Gemm g{XB, Bt, M, FF, D}; pg8::StaticOrder S; S.init(M, FF, G, wg);
                pg8::EpiUp8 E{ssq, HB};
                pg8::gemm_phase<pg8::EpiUp8, pg8::StaticOrder, true, true>(lds, g, S, E, tid); }
            else { EpiUp E{ssq, HB}; gemm_simple(XB, Bt, M, FF, D, E, gw, ngw, lane); }
        } break;
        case 6: {
            KARG_BASE(); unsigned char* ws = WS_PTR();
            const bf16_t* XB = WSP(bf16_t, WS_XB); const bf16_t* Wgin = WSP(bf16_t, W_GIN); const float* SSQ2 = WSP(float, WS_SSQ + 2 * (size_t)M * 64); float* Zb = WSP(float, WS_Z);
            bf16_t* Gv = WSP(bf16_t, WS_BIG); bf16_t* Gr = WSP(bf16_t, WS_BIG + 32 * MiB); bf16_t* Gq = WSP(bf16_t, WS_QK); bf16_t* Gk = WSP(bf16_t, WS_QK + 16 * MiB);
            if (FAST_GEMM & 8) { pg8::Gemm g{XB, Wgin, M, 3072, D}; pg8::StaticOrder S; S.init(M, 3072, G, wg);
                pg8::EpiGin8 E{SSQ2, Gq, Gk, Gv, Gr};
                pg8::gemm_phase<pg8::EpiGin8, pg8::StaticOrder, true, true>(lds, g, S, E, tid); }
            else { EpiGin E{SSQ2, Gq, Gk, Gv, Gr}; gemm_simple(XB, Wgin, M, 3072, D, E, gw, ngw, lane); }
            EpiZ Ez{SSQ2, Zb}; gemm_simple(XB, Wgin + (size_t)3072 * D, M, 64, D, Ez, gw, ngw, lane);
        } break;
        case 7: {
            KARG_BASE(); unsigned char* ws = WS_PTR();
            gla_pre(WSP(bf16_t, WS_QK), WSP(bf16_t, WS_QK + 16 * MiB), WSP(float, WS_Z), IN_PTR(8), IN_PTR(9), WSP(bf16_t, WS_BIG + 64 * MiB), WSP(bf16_t, WS_BIG + 96 * MiB), WSP(float, WS_DECAY), wg, G, tid);
        } break;
        case 8: {
            KARG_BASE(); unsigned char* ws = WS_PTR();
            gla_scan_simple(WSP(bf16_t, WS_BIG + 64 * MiB), WSP(bf16_t, WS_BIG + 96 * MiB), WSP(bf16_t, WS_BIG), WSP(float, WS_DECAY), WSP(bf16_t, WS_QK), WSP(bf16_t, WS_XB), lds, wg, G, tid);
        } break;
        case 9: {
            KARG_BASE(); unsigned char* ws = WS_PTR();
            gla_combine(WSP(bf16_t, WS_QK), WSP(bf16_t, WS_XB), WSP(bf16_t, WS_BIG + 32 * MiB), IN_PTR(10), gw, ngw, lane);
        } break;
        default: {
            KARG_BASE(); float* out = OUT_PTR(); const float* final_norm = IN_PTR(14);
            for (int m = gw; m < M; m += ngw) {
                f32x4* xr = (f32x4*)(out + (size_t)m * D) + lane;
                f32x4 v[4]; float s = 0.f;
#pragma unroll
                for (int j = 0; j < 4; ++j) { v[j] = xr[64 * j]; s += (v[j].x * v[j].x + v[j].y * v[j].y) + (v[j].z * v[j].z + v[j].w * v[j].w); }
                s = wave_sum(s);
                const float rs = 1.0f / sqrtf(s * (1.0f / D) + EPS);
#pragma unroll
                for (int j = 0; j < 4; ++j) { const f32x4 g = *((const f32x4*)final_norm + lane + 64 * j); xr[64 * j] = v[j] * rs * g; }
            }
        } break;
        }
        if (ph + 1 < hi) xcd_barrier(bar);
    }
}

#ifndef MK_SINGLE
#define MK_SINGLE 1
#endif
extern "C" void kernel_launch(void* const* d_in, const int* in_sizes, int n_in, void* d_out, int out_size, void* d_ws, size_t ws_size, hipStream_t stream) {
    static int grid = 0;
    if (grid == 0) {
        if (n_in != 15 || in_sizes[0] != M * D || out_size != M * D || ws_size < WS_END) { fprintf(stderr, "kernel_launch: unexpected shapes (n_in %d, in0 %d, out %d, ws %zu)\n", n_in, n_in > 0 ? in_sizes[0] : -1, out_size, ws_size); grid = -1; return; }
        int dev = 0, cus = 0, per_cu = 0;
        if (hipGetDevice(&dev) != hipSuccess || hipDeviceGetAttribute(&cus, hipDeviceAttributeMultiprocessorCount, dev) != hipSuccess) { grid = -1; return; }
        if (hipFuncSetAttribute((const void*)fwd_kernel, hipFuncAttributeMaxDynamicSharedMemorySize, LDS_BYTES) != hipSuccess) { fprintf(stderr, "kernel_launch: hipFuncSetAttribute failed\n"); grid = -1; return; }
        if (hipOccupancyMaxActiveBlocksPerMultiprocessor(&per_cu, (const void*)fwd_kernel, NTHREADS, LDS_BYTES) != hipSuccess || per_cu < 1) { fprintf(stderr, "kernel_launch: occupancy query says %d\n", per_cu); }
        (void)hipGetLastError();
        grid = cus;
    }
    if (grid < 0) return;
    (void)hipMemsetAsync((char*)d_ws + WS_CTL, 0, CTL_ZERO_BYTES, stream);
    Args a{};
    for (int i = 0; i < 15; ++i) a.in[i] = (const float*)d_in[i];
    a.out = (float*)d_out; a.ws = (unsigned char*)d_ws;
#if MK_SINGLE
    a.ph_lo = 0; a.ph_hi = NPHASES;
    hipLaunchKernelGGL(fwd_kernel, dim3(grid), dim3(NTHREADS), LDS_BYTES, stream, a);
#else
    for (int p = 0; p < NPHASES; ++p) { a.ph_lo = p; a.ph_hi = p + 1; hipLaunchKernelGGL(fwd_kernel, dim3(grid), dim3(NTHREADS), LDS_BYTES, stream, a); }
#endif
}
```

```cpp
#include <hip/hip_runtime.h>
#include <cstdio>
#include <cstdint>
#include <hip/hip_bf16.h>
#include <cmath>

#define GAS __attribute__((address_space(1)))
#define LAS __attribute__((address_space(3)))
typedef unsigned short bf16_t;
typedef short bf16x8 __attribute__((ext_vector_type(8)));
typedef float f32x4 __attribute__((ext_vector_type(4)));
typedef float f32x2 __attribute__((ext_vector_type(2)));
typedef unsigned u32x4 __attribute__((ext_vector_type(4)));
typedef unsigned u32x2 __attribute__((ext_vector_type(2)));

constexpr int BATCH = 4, SEQ = 4096, D = 1024, M = BATCH * SEQ;
constexpr int NH = 16, NKV = 4, HD = 64, QKV_N = 1536, KVP = NKV * HD;
constexpr int GH = 4, GDK = 128, GDV = 256, GQK = 512, GV = 1024, RANK = 16, GIN = 3104, CH = 64, NCH = SEQ / CH;
constexpr int FF = 4096;
constexpr float EPS = 1e-6f;
constexpr float C2 = 0.125f * 1.4426950408889634f;
constexpr int NWAVES = 8, NTHREADS = 512;
constexpr int NPHASES = 14;

constexpr size_t MiB = 1u << 20;
constexpr size_t WS_CTL = 0, CTL_ZERO_BYTES = 1 * MiB;
constexpr size_t WS_ROPE = 1 * MiB;
constexpr size_t WS_SSQ = 2 * MiB;
constexpr size_t WS_Z = 7 * MiB;
constexpr size_t WS_DECAY = 11 * MiB;
constexpr size_t WS_W = 12 * MiB;
constexpr size_t W_QKV = WS_W, W_O0 = W_QKV + 3 * MiB, W_1A = W_O0 + 2 * MiB, W_2A = W_1A + 8 * MiB, W_GIN = W_2A + 8 * MiB,
                 W_O1 = W_GIN + 6 * MiB + 128 * 1024, W_1B = W_O1 + 2 * MiB, W_2B = W_1B + 8 * MiB, W_END = W_2B + 8 * MiB;
constexpr size_t WS_XB = 58 * MiB;
constexpr size_t WS_BIG = 90 * MiB;
constexpr size_t WS_QK = 218 * MiB;
constexpr size_t WS_END = 250 * MiB;
static_assert(W_END <= WS_XB, "weights fit");

__device__ __forceinline__ unsigned f2bf(float f) { unsigned u = __builtin_bit_cast(unsigned, f); return (u + 0x7fffu + ((u >> 16) & 1u)) >> 16; }
__device__ __forceinline__ unsigned pk2(float lo, float hi) { return f2bf(lo) | (f2bf(hi) << 16); }
__device__ __forceinline__ float bf2f(unsigned short u) { return __uint_as_float((unsigned)u << 16); }
__device__ __forceinline__ float bflo(unsigned w) { return __uint_as_float(w << 16); }
__device__ __forceinline__ float bfhi(unsigned w) { return __uint_as_float(w & 0xffff0000u); }
#define LDS_WAIT() asm volatile("s_waitcnt lgkmcnt(0)" ::: "memory")
#define VM_WAIT() asm volatile("s_waitcnt vmcnt(0)" ::: "memory")
__device__ __forceinline__ float wave_sum(float v) {
#pragma unroll
    for (int o = 1; o < 64; o <<= 1) v += __shfl_xor(v, o);
    return v;
}
__device__ __forceinline__ float rstd_from_slots(const float* ssq, int row) {
    const f32x4* p = (const f32x4*)(ssq + (size_t)row * 16);
    const f32x4 a = p[0], b = p[1], c = p[2], d = p[3];
    const float s = (((a.x + a.y) + (a.z + a.w)) + ((b.x + b.y) + (b.z + b.w))) + (((c.x + c.y) + (c.z + c.w)) + ((d.x + d.y) + (d.z + d.w)));
    return 1.0f / sqrtf(s * (1.0f / D) + EPS);
}

#define RLX_AGENT __ATOMIC_RELAXED, __HIP_MEMORY_SCOPE_AGENT
#define XB_TMO      128
#define XB_XCNT(j)  (256  + 64 * (j))
#define XB_XSUB(j)  (1280 + 64 * (j))
#define XB_XGEN(j)  (2304 + 64 * (j))
#define XB_TOP      3328
#define XB_TOPGEN   3392
#define XCD_BAR_WORDS 3456
#define XB_SPIN_CAP (1u << 22)
__device__ __forceinline__ unsigned xb_ld(unsigned* p)              { return __hip_atomic_load(p, __ATOMIC_RELAXED, __HIP_MEMORY_SCOPE_AGENT); }
__device__ __forceinline__ unsigned xb_add(unsigned* p, unsigned v) { return __hip_atomic_fetch_add(p, v, __ATOMIC_RELAXED, __HIP_MEMORY_SCOPE_AGENT); }
__device__ __forceinline__ unsigned xb_xcc_id() { return (unsigned)__builtin_amdgcn_s_getreg((3 << 11) | 20) & 0xFu; }
#define XB_SPIN(cond, bar) do { unsigned _sp = 0; while (cond) { __builtin_amdgcn_s_sleep(1); \
    if ((++_sp & 255u) == 0u) { if (xb_ld(&(bar)[XB_TMO])) break; if (_sp > XB_SPIN_CAP) { atomicAdd(&(bar)[XB_TMO], 1u); break; } } } } while (0)
struct XcdBarrier { unsigned* bar; unsigned x; volatile LAS unsigned* st; };
__device__ __forceinline__ XcdBarrier xcd_barrier_post(unsigned* bar, volatile LAS unsigned* st) {
    XcdBarrier b; b.bar = bar; b.x = xb_xcc_id(); b.st = st;
    if (threadIdx.x == 0) (void)xb_add(&bar[XB_XCNT(b.x)], 1u);
    return b;
}
__device__ __forceinline__ void xcd_barrier_complete(unsigned* bar, unsigned x, unsigned& nloc, unsigned& nx) {
    const unsigned G = gridDim.x * gridDim.y * gridDim.z;
    unsigned sum, cnt, mine, sp = 0u;
    for (;;) {
        sum = 0u; cnt = 0u; mine = 0u;
#pragma unroll
        for (unsigned j = 0; j < 16; ++j) { const unsigned c = xb_ld(&bar[XB_XCNT(j)]); sum += c; cnt += (c > 0u) ? 1u : 0u; mine = (j == x) ? c : mine; }
        if (sum == G) break;
        __builtin_amdgcn_s_sleep(1);
        if ((++sp & 255u) == 0u) { if (xb_ld(&bar[XB_TMO])) break; if (sp > XB_SPIN_CAP) { atomicAdd(&bar[XB_TMO], 1u); break; } }
    }
    nloc = mine > 0u ? mine : 1u; nx = cnt > 0u ? cnt : 1u;
}
__device__ __forceinline__ void xcd_barrier(const XcdBarrier& b) {
    asm volatile("s_waitcnt vmcnt(0)" ::: "memory");
    __syncthreads();
    if (threadIdx.x == 0) {
        unsigned* bar = b.bar;
        __builtin_amdgcn_s_waitcnt(0);
        unsigned nloc = b.st[0], nx = b.st[1];
        if (nloc == 0u) { xcd_barrier_complete(bar, b.x, nloc, nx); b.st[0] = nloc; b.st[1] = nx; }
        const unsigned old = xb_add(&bar[XB_XSUB(b.x)], 1u);
        const unsigned gen = old / nloc;
        if (old + 1u == (gen + 1u) * nloc) {
            __builtin_amdgcn_fence(__ATOMIC_RELEASE, "agent");
            asm volatile("s_waitcnt vmcnt(0)" ::: "memory");
            const unsigned og = xb_add(&bar[XB_TOP], 1u);
            const unsigned tg = og / nx;
            if (og + 1u == (tg + 1u) * nx) xb_add(&bar[XB_TOPGEN], 1u);
            else XB_SPIN(xb_ld(&bar[XB_TOPGEN]) == tg, bar);
            __builtin_amdgcn_fence(__ATOMIC_ACQUIRE, "agent");
            xb_add(&bar[XB_XGEN(b.x)], 1u);
            asm volatile("s_waitcnt vmcnt(0)" ::: "memory");
        } else {
            XB_SPIN(xb_ld(&bar[XB_XGEN(b.x)]) == gen, bar);
            __builtin_amdgcn_fence(__ATOMIC_ACQUIRE, "agent");
            asm volatile("s_waitcnt vmcnt(0)" ::: "memory");
        }
    }
    __syncthreads();
}

constexpr int RING_BYTES = 131072;
constexpr int LDSCTL_OFF = RING_BYTES, MISC_OFF = LDSCTL_OFF + 320;
constexpr int LDS_BYTES = 147456;

namespace pg8 {
#define PG8_LAS __attribute__((address_space(3)))
typedef unsigned short bf16_t;
typedef short bf16x8 __attribute__((ext_vector_type(8)));
typedef float f32x4 __attribute__((ext_vector_type(4)));
typedef unsigned u32x4 __attribute__((ext_vector_type(4)));
constexpr int BM = 256, BK = 64, HALF = 128, HTB = HALF * BK * 2  , STAGE_BYTES = 8 * HTB, NXCD = 8, WGM = 8;

__host__ __device__ __forceinline__ int lds_byte(int r, int c) { const int st = (r >> 4) * 2 + (c >> 5), rr = r & 15, cc = c & 31, ob = rr * 64 + cc * 2; return st * 1024 + (ob ^ (((ob >> 9) & 1) << 5)); }
__host__ __device__ __forceinline__ void stage_rc(int b, int& R, int& C) { const int st = b / 1024, sb = b % 1024, swz = sb ^ (((sb >> 9) & 1) << 5); R = (st >> 1) * 16 + swz / 64; C = (st & 1) * 32 + (swz % 64) / 2; }
__host__ __device__ __forceinline__ int perm32(int rho) { const int n = rho >> 4, i = rho & 15; return 8 * (i >> 2) + 4 * n + (i & 3); }

struct Unit { int pm, pn; };
struct Gemm { const bf16_t* A; const bf16_t* Bt; int M, N, K; };

struct StaticOrder {
    int nM, nN, nwg, G, c;
    __host__ __device__ void init(int M, int N, int G_, int c_) { nM = M / BM; nN = N / BM; nwg = nM * nN; G = G_; c = c_; }
    __host__ __device__ bool next(int i, Unit& u) const {
        const long L = (long)i * G + c; if (L >= nwg) return false;
        int wgid = (int)L; { const int q = nwg / NXCD, r = nwg % NXCD, xcd = wgid % NXCD, off = wgid / NXCD; wgid = (xcd < r ? xcd * (q + 1) : r * (q + 1) + (xcd - r) * q) + off; }
        const int nig = WGM * nN, gid = wgid / nig, fm = gid * WGM, gsz = (nM - fm) < WGM ? (nM - fm) : WGM;
        u.pm = fm + ((wgid % nig) % gsz); u.pn = (wgid % nig) / gsz; return true;
    }
    __device__ __forceinline__ void a_ready(const Unit&) const {}
    __device__ __forceinline__ void done(const Unit&) const {}
};
__device__ __forceinline__ unsigned cvt_pk_bf16(float lo, float hi) { unsigned r; asm volatile("v_cvt_pk_bf16_f32 %0, %1, %2" : "=v"(r) : "v"(lo), "v"(hi)); return r; }
typedef float f32x2 __attribute__((ext_vector_type(2)));
template <class Epi, class Sched, bool ALIGN_EPI = false, bool SP2 = false>
__device__ __forceinline__ void gemm_phase(PG8_LAS unsigned char* lds, const Gemm g, const Sched& S, const Epi& E, const int tid) {
    const int wid = __builtin_amdgcn_readfirstlane(tid >> 6), lane = tid & 63, wr = wid >> 2, wc = wid & 3, fr = lane & 15, fq = lane >> 4;
    const int K = g.K, nt = K / BK;
    unsigned voffA[2], voffB[2];
#pragma unroll
    for (int i = 0; i < 2; ++i) { int R, C; stage_rc(tid * 16 + i * 8192, R, C); const int Rb = Epi::BMODE == 1 ? ((R & ~31) + perm32(R & 31)) : Epi::BMODE == 2 ? (64 * (R >> 5) + (R & 31)) : R;
        voffA[i] = (unsigned)(R * K + C) * 2u; voffB[i] = (unsigned)(Rb * K + C) * 2u; }
    const size_t kstep = (size_t)(BK * 2);
    const size_t hstep = (size_t)HALF * K * 2;
    const size_t tstep = 2 * hstep;
    const size_t bhstep = Epi::BMODE == 2 ? (size_t)32 * K * 2 : hstep;
    const unsigned ldsw = (unsigned)wid * 1024u;
    const int aoff = lds_byte(wr * 64 + fr, fq * 8), boff = lds_byte(wc * 32 + fr, fq * 8);
#define PG8_SA(b, h) (((b) * 2 + (h)) * HTB)
#define PG8_SB(b, h) ((4 + (b) * 2 + (h)) * HTB)
#define PG8_STAGE(bufoff, gbase, voff) do { _Pragma("unroll") for (int _i = 0; _i < 2; ++_i) \
        __builtin_amdgcn_global_load_lds((const unsigned*)((const char*)(gbase) + (voff)[_i]), (PG8_LAS unsigned*)(lds + (bufoff) + ldsw + _i * 8192), 16, 0, 0); } while (0)
#define PG8_LDA(dst, b, h) do { _Pragma("unroll") for (int m = 0; m < 4; ++m) _Pragma("unroll") for (int k = 0; k < 2; ++k) dst[m][k] = *(const PG8_LAS bf16x8*)(lds + PG8_SA(b, h) + aoff + m * 2048 + k * 1024); } while (0)
#define PG8_LDB(dst, b, h) do { _Pragma("unroll") for (int n = 0; n < 2; ++n) _Pragma("unroll") for (int k = 0; k < 2; ++k) dst[n][k] = *(const PG8_LAS bf16x8*)(lds + PG8_SB(b, h) + boff + n * 2048 + k * 1024); } while (0)
#define PG8_MMA(ai, bj, At, Bt) do { __builtin_amdgcn_s_setprio(1); _Pragma("unroll") for (int m = 0; m < 4; ++m) _Pragma("unroll") for (int n = 0; n < 2; ++n) _Pragma("unroll") for (int k = 0; k < 2; ++k) \
        acc[ai][bj][m][n] = __builtin_amdgcn_mfma_f32_16x16x32_bf16(Bt[n][k], At[m][k], acc[ai][bj][m][n], 0, 0, 0); __builtin_amdgcn_s_setprio(0); } while (0)
#define PG8_WAIT_V(n) asm volatile("s_waitcnt vmcnt(" #n ")" ::: "memory")
#define PG8_WAIT_L(n) asm volatile("s_waitcnt lgkmcnt(" #n ")" ::: "memory")
#define PG8_BAR __builtin_amdgcn_s_barrier()
#define PG8_SCHED __builtin_amdgcn_sched_barrier(0)
    Unit cur, nxt; int ui = 0;
    if (!S.next(0, cur)) return;
    f32x4 acc[2][2][4][2];
#pragma unroll
    for (int a = 0; a < 2; ++a)
#pragma unroll
        for (int b = 0; b < 2; ++b)
#pragma unroll
            for (int m = 0; m < 4; ++m)
#pragma unroll
                for (int n = 0; n < 2; ++n) acc[a][b][m][n] = (f32x4){0.f, 0.f, 0.f, 0.f};
    bf16x8 At[4][2], B0[2][2], B1[2][2];
    const char* cA = (const char*)g.A + (size_t)cur.pm * tstep; const char* cB = (const char*)g.Bt + (size_t)cur.pn * tstep;
    S.a_ready(cur);
    if constexpr (SP2) {
        PG8_STAGE(PG8_SB(0, 0), cB, voffB); PG8_STAGE(PG8_SB(0, 1), cB + bhstep, voffB); PG8_STAGE(PG8_SA(0, 0), cA, voffA); PG8_STAGE(PG8_SA(0, 1), cA + hstep, voffA);
        if (wr == 1) PG8_BAR;
        PG8_WAIT_V(2); PG8_BAR;
        PG8_STAGE(PG8_SB(1, 0), cB + kstep, voffB); PG8_STAGE(PG8_SA(1, 0), cA + kstep, voffA); PG8_STAGE(PG8_SB(1, 1), cB + bhstep + kstep, voffB);
        PG8_WAIT_V(6); PG8_BAR;
    } else {
        PG8_STAGE(PG8_SB(0, 0), cB, voffB); PG8_STAGE(PG8_SA(0, 0), cA, voffA); PG8_STAGE(PG8_SB(0, 1), cB + bhstep, voffB); PG8_STAGE(PG8_SA(0, 1), cA + hstep, voffA);
        if (wr == 1) PG8_BAR;
        PG8_WAIT_V(4); PG8_BAR;
        PG8_STAGE(PG8_SB(1, 0), cB + kstep, voffB); PG8_STAGE(PG8_SA(1, 0), cA + kstep, voffA); PG8_STAGE(PG8_SB(1, 1), cB + bhstep + kstep, voffB);
        PG8_WAIT_V(6); PG8_BAR;
    }
    for (;;) {
        const bool has_next = S.next(ui + 1, nxt);
        const char* nA = has_next ? (const char*)g.A + (size_t)nxt.pm * tstep : cA; const char* nB = has_next ? (const char*)g.Bt + (size_t)nxt.pn * tstep : cB;
        for (int t = 0; t < nt; t += 2) {
            const bool last = (t == nt - 2);
            const char* a1 = cA + (size_t)(t + 1) * kstep;
            const char* a2 = last ? nA : cA + (size_t)(t + 2) * kstep; const char* b2 = last ? nB : cB + (size_t)(t + 2) * kstep;
            const char* a3 = a2 + kstep; const char* b3 = b2 + kstep;
            if (last && has_next) S.a_ready(nxt);
            if constexpr (SP2) {
            PG8_LDB(B0, 0, 0); PG8_LDB(B1, 0, 1); PG8_SCHED; PG8_LDA(At, 0, 0); PG8_STAGE(PG8_SA(1, 1), a1 + hstep, voffA);
            PG8_WAIT_V(8); PG8_WAIT_L(0); PG8_BAR; PG8_MMA(0, 0, At, B0); PG8_MMA(0, 1, At, B1); PG8_BAR; PG8_SCHED;
            PG8_LDA(At, 0, 1); PG8_STAGE(PG8_SB(0, 0), b2, voffB); PG8_STAGE(PG8_SB(0, 1), b2 + bhstep, voffB); PG8_STAGE(PG8_SA(0, 0), a2, voffA);
            PG8_WAIT_V(8); PG8_WAIT_L(0); PG8_BAR; PG8_MMA(1, 0, At, B0); PG8_MMA(1, 1, At, B1); PG8_BAR; PG8_SCHED;
            PG8_LDB(B0, 1, 0); PG8_LDB(B1, 1, 1); PG8_SCHED; PG8_LDA(At, 1, 0); PG8_STAGE(PG8_SA(0, 1), a2 + hstep, voffA);
            PG8_WAIT_V(8); PG8_WAIT_L(0); PG8_BAR; PG8_MMA(0, 0, At, B0); PG8_MMA(0, 1, At, B1); PG8_BAR; PG8_SCHED;
            PG8_LDA(At, 1, 1); PG8_STAGE(PG8_SB(1, 0), b3, voffB); PG8_STAGE(PG8_SB(1, 1), b3 + bhstep, voffB); PG8_STAGE(PG8_SA(1, 0), a3, voffA);
            PG8_WAIT_V(8); PG8_WAIT_L(0); PG8_BAR; PG8_MMA(1, 0, At, B0); PG8_MMA(1, 1, At, B1); PG8_BAR; PG8_SCHED;
            } else {
            PG8_LDB(B0, 0, 0); PG8_SCHED; PG8_LDA(At, 0, 0); PG8_STAGE(PG8_SA(1, 1), a1 + hstep, voffA);
            PG8_WAIT_L(8); PG8_BAR; PG8_WAIT_L(0); PG8_MMA(0, 0, At, B0); PG8_BAR; PG8_SCHED;
            PG8_LDB(B1, 0, 1); PG8_STAGE(PG8_SB(0, 0), b2, voffB);
            PG8_BAR; PG8_WAIT_L(0); PG8_MMA(0, 1, At, B1); PG8_BAR;
            PG8_LDA(At, 0, 1); PG8_STAGE(PG8_SA(0, 0), a2, voffA);
            PG8_BAR; PG8_WAIT_L(0); PG8_MMA(1, 0, At, B0); PG8_BAR; PG8_SCHED;
            PG8_STAGE(PG8_SB(0, 1), b2 + bhstep, voffB);
            PG8_WAIT_V(6); PG8_BAR; PG8_MMA(1, 1, At, B1); PG8_BAR;
            PG8_LDB(B0, 1, 0); PG8_SCHED; PG8_LDA(At, 1, 0); PG8_STAGE(PG8_SA(0, 1), a2 + hstep, voffA);
            PG8_WAIT_L(8); PG8_BAR; PG8_WAIT_L(0); PG8_MMA(0, 0, At, B0); PG8_BAR; PG8_SCHED;
            PG8_LDB(B1, 1, 1); PG8_STAGE(PG8_SB(1, 0), b3, voffB);
            PG8_BAR; PG8_WAIT_L(0); PG8_MMA(0, 1, At, B1); PG8_BAR;
            PG8_LDA(At, 1, 1); PG8_STAGE(PG8_SA(1, 0), a3, voffA);
            PG8_BAR; PG8_WAIT_L(0); PG8_MMA(1, 0, At, B0); PG8_BAR; PG8_SCHED;
            PG8_STAGE(PG8_SB(1, 1), b3 + bhstep, voffB);
            PG8_WAIT_V(6); PG8_BAR; PG8_MMA(1, 1, At, B1); PG8_BAR;
            }
        }
        if constexpr (ALIGN_EPI) { if (wr == 0) PG8_BAR; }
        if constexpr (!Epi::AFTER_DRAIN) { E(acc, cur, wr, wc, fr, fq); S.done(cur); }
        if (!has_next) break;
#pragma unroll
        for (int a = 0; a < 2; ++a)
#pragma unroll
            for (int b = 0; b < 2; ++b)
#pragma unroll
                for (int m = 0; m < 4; ++m)
#pragma unroll
                    for (int n = 0; n < 2; ++n) acc[a][b][m][n] = (f32x4){0.f, 0.f, 0.f, 0.f};
        cur = nxt; cA = nA; cB = nB; ++ui;
        if constexpr (ALIGN_EPI) { if (wr == 1) PG8_BAR; }
    }
    PG8_WAIT_V(0);
    if constexpr (!ALIGN_EPI) { if (wr == 0) PG8_BAR; }
    PG8_BAR;
    if constexpr (Epi::AFTER_DRAIN) { E.fused(acc, cur, wr, wc, fr, fq, lds, wid, lane); S.done(cur); }
#undef PG8_SA
#undef PG8_SB
#undef PG8_STAGE
#undef PG8_LDA
#undef PG8_LDB
#undef PG8_MMA
#undef PG8_WAIT_V
#undef PG8_WAIT_L
#undef PG8_BAR
#undef PG8_SCHED
}
}

namespace pg8 {
typedef unsigned u32x2 __attribute__((ext_vector_type(2)));
struct EpiQKV8 {
    static constexpr int BMODE = 2; static constexpr bool PERM = false, AFTER_DRAIN = false;
    const float* ssq; const float* qg; const float* kg; const ::f32x2* rope; bf16_t* Q; bf16_t* Kb; bf16_t* Vb;
    __device__ __forceinline__ void operator()(const f32x4 (&acc)[2][2][4][2], const Unit& u, int wr, int wc, int fr, int fq) const {
        const int pn = u.pn;
#pragma unroll
        for (int ai = 0; ai < 2; ++ai)
#pragma unroll
            for (int m = 0; m < 4; ++m) {
                const int row = u.pm * BM + ai * HALF + wr * 64 + m * 16 + fr; const float rs = rstd_from_slots(ssq, row);
                f32x4 v[2][2];
#pragma unroll
                for (int bj = 0; bj < 2; ++bj)
#pragma unroll
                    for (int n = 0; n < 2; ++n) v[bj][n] = acc[ai][bj][m][n] * rs;
                if (pn < 5) {
                    const bool isq = pn < 4; const float* g = isq ? qg : kg;
                    float ss = 0.f;
#pragma unroll
                    for (int bj = 0; bj < 2; ++bj)
#pragma unroll
                        for (int n = 0; n < 2; ++n) ss += (v[bj][n].x * v[bj][n].x + v[bj][n].y * v[bj][n].y) + (v[bj][n].z * v[bj][n].z + v[bj][n].w * v[bj][n].w);
                    ss += __shfl_xor(ss, 16); ss += __shfl_xor(ss, 32);
                    const float r = 1.0f / sqrtf(ss * (1.0f / 64.0f) + EPS);
#pragma unroll
                    for (int bj = 0; bj < 2; ++bj)
#pragma unroll
                        for (int n = 0; n < 2; ++n) { const f32x4 gv = *(const f32x4*)(g + 32 * bj + 16 * n + 4 * fq); v[bj][n] = v[bj][n] * r * gv; }
                    const int t = row % SEQ, prow = t >> 6, pcol = t & 63;
                    const float sc = isq ? C2 : 1.0f;
#pragma unroll
                    for (int bj = 0; bj < 2; ++bj) {
                        const int pos = bj == 0 ? prow : pcol;
                        const f32x4 cs01 = *(const f32x4*)(rope + pos * 16 + 4 * fq), cs23 = *(const f32x4*)(rope + pos * 16 + 4 * fq + 2);
                        const float cc[4] = {cs01.x, cs01.z, cs23.x, cs23.z}, sn[4] = {cs01.y, cs01.w, cs23.y, cs23.w};
                        const f32x4 x1 = v[bj][0], x2 = v[bj][1]; f32x4 o1, o2;
#pragma unroll
                        for (int j = 0; j < 4; ++j) { o1[j] = (x1[j] * cc[j] - x2[j] * sn[j]) * sc; o2[j] = (x2[j] * cc[j] + x1[j] * sn[j]) * sc; }
                        v[bj][0] = o1; v[bj][1] = o2;
                    }
                }
                bf16_t* dst = pn < 4 ? Q + (size_t)row * D + pn * 256 + wc * 64 : pn == 4 ? Kb + (size_t)row * KVP + wc * 64 : Vb + (size_t)row * KVP + wc * 64;
#pragma unroll
                for (int bj = 0; bj < 2; ++bj)
#pragma unroll
                    for (int n = 0; n < 2; ++n) { u32x2 w; w.x = cvt_pk_bf16(v[bj][n].x, v[bj][n].y); w.y = cvt_pk_bf16(v[bj][n].z, v[bj][n].w); *(u32x2*)(dst + 32 * bj + 16 * n + 4 * fq) = w; }
            }
    }
};
struct EpiRes8 {
    static constexpr int BMODE = 0; static constexpr bool PERM = false, AFTER_DRAIN = false;
    const float* base; float* out; bf16_t* xb; float* ssq;
    __device__ __forceinline__ void operator()(const f32x4 (&acc)[2][2][4][2], const Unit& u, int wr, int wc, int fr, int fq) const {
        const int col0 = u.pn * BM + wc * 32 + 4 * fq;
#pragma unroll
        for (int ai = 0; ai < 2; ++ai)
#pragma unroll
            for (int m = 0; m < 4; ++m) {
                const int row = u.pm * BM + ai * HALF + wr * 64 + m * 16 + fr; float ss = 0.f;
#pragma unroll
                for (int bj = 0; bj < 2; ++bj)
#pragma unroll
                    for (int n = 0; n < 2; ++n) { const size_t off = (size_t)row * D + col0 + bj * HALF + n * 16;
                        const f32x4 h = *(const f32x4*)(base + off) + acc[ai][bj][m][n]; *(f32x4*)(out + off) = h;
                        ss += (h.x * h.x + h.y * h.y) + (h.z * h.z + h.w * h.w);
                        if (xb) { u32x2 w; w.x = cvt_pk_bf16(h.x, h.y); w.y = cvt_pk_bf16(h.z, h.w); *(u32x2*)(xb + off) = w; } }
                ss += __shfl_xor(ss, 16); ss += __shfl_xor(ss, 32);
                if (ssq && fq == 0) ssq[(size_t)row * 16 + u.pn * 4 + wc] = ss;
                asm volatile("" ::: "memory");
            }
    }
};
struct EpiUp8 {
    static constexpr int BMODE = 1; static constexpr bool PERM = true, AFTER_DRAIN = false;
    const float* ssq; bf16_t* HB;
    __device__ __forceinline__ void operator()(const f32x4 (&acc)[2][2][4][2], const Unit& u, int wr, int wc, int fr, int fq) const {
        const int col0 = u.pn * BM + wc * 32 + 8 * fq;
#pragma unroll
        for (int ai = 0; ai < 2; ++ai)
#pragma unroll
            for (int m = 0; m < 4; ++m) {
                const int row = u.pm * BM + ai * HALF + wr * 64 + m * 16 + fr; const float rs = rstd_from_slots(ssq, row);
                bf16_t* rowp = HB + (size_t)row * FF + col0;
#pragma unroll
                for (int bj = 0; bj < 2; ++bj) { f32x4 v0 = acc[ai][bj][m][0] * rs, v1 = acc[ai][bj][m][1] * rs;
#pragma unroll
                    for (int j = 0; j < 4; ++j) { const float a = fmaxf(v0[j], 0.f), b = fmaxf(v1[j], 0.f); v0[j] = a * a; v1[j] = b * b; }
                    u32x4 w; w.x = cvt_pk_bf16(v0[0], v0[1]); w.y = cvt_pk_bf16(v0[2], v0[3]); w.z = cvt_pk_bf16(v1[0], v1[1]); w.w = cvt_pk_bf16(v1[2], v1[3]);
                    *(u32x4*)(rowp + bj * HALF) = w; }
            }
    }
};
struct EpiGin8 {
    static constexpr int BMODE = 1; static constexpr bool PERM = true, AFTER_DRAIN = false;
    const float* ssq; bf16_t* q; bf16_t* k; bf16_t* v; bf16_t* r;
    __device__ __forceinline__ void operator()(const f32x4 (&acc)[2][2][4][2], const Unit& u, int wr, int wc, int fr, int fq) const {
        const int pn = u.pn;
        bf16_t* basep; int ld, ct; float sc = 1.0f;
        if (pn < 2) { basep = q; ld = GQK; ct = pn; sc = 0.08838834764831845f; } else if (pn < 4) { basep = k; ld = GQK; ct = pn - 2; } else if (pn < 8) { basep = v; ld = GV; ct = pn - 4; } else { basep = r; ld = GV; ct = pn - 8; }
        const int col0 = ct * BM + wc * 32 + 8 * fq;
#pragma unroll
        for (int ai = 0; ai < 2; ++ai)
#pragma unroll
            for (int m = 0; m < 4; ++m) {
                const int row = u.pm * BM + ai * HALF + wr * 64 + m * 16 + fr; const float rs = rstd_from_slots(ssq, row) * sc;
                bf16_t* rowp = basep + (size_t)row * ld + col0;
#pragma unroll
                for (int bj = 0; bj < 2; ++bj) { const f32x4 v0 = acc[ai][bj][m][0] * rs, v1 = acc[ai][bj][m][1] * rs;
                    u32x4 w; w.x = cvt_pk_bf16(v0[0], v0[1]); w.y = cvt_pk_bf16(v0[2], v0[3]); w.z = cvt_pk_bf16(v1[0], v1[1]); w.w = cvt_pk_bf16(v1[2], v1[3]);
                    *(u32x4*)(rowp + bj * HALF) = w; }
            }
    }
};
}

namespace attn_body {
using bf16=__hip_bfloat16;
using bf16x8=__attribute__((ext_vector_type(8)))short;
using s16x4=__attribute__((ext_vector_type(4)))short;
using f32x16=__attribute__((ext_vector_type(16)))float;
using u32x4=__attribute__((ext_vector_type(4)))unsigned;
constexpr int BATCH=4,NHEAD=16,SEQ=4096,D=64,DM=NHEAD*D,KVP=256;
constexpr int NW=8,QBLK=32,QB=QBLK*NW,KVBLK=64,NQB=SEQ/QB;
constexpr int ATTN_PITCH=DM, ATTN_UNIT_ROWS=QB;
__device__ __forceinline__ int crow(int r,int hi){return (r&3)+8*(r>>2)+4*hi;}
#define SBAR() __builtin_amdgcn_sched_barrier(0)
__device__ __forceinline__ void cmask(f32x16&p0,f32x16&p1,int jb,int qrel,int hi){
  const float NEG=-INFINITY; int kb=64*jb+4*hi;
  #pragma unroll
  for(int r=0;r<16;++r){int kv=kb+(r&3)+8*(r>>2); if(kv>qrel)p0[r]=NEG; if(kv+32>qrel)p1[r]=NEG;}
}

constexpr int NSLOT=3, SLOTB=8192;
constexpr int LDS_K=0, LDS_V=NSLOT*SLOTB, LDS_WS=2*NSLOT*SLOTB, LDS_OST=LDS_WS+NW*64*4, LDS_BYTES=LDS_OST+NW*4096;
constexpr float C2=0.125f*1.4426950408889634f;
__device__ __forceinline__ void glds16(const void*gsrc,unsigned lds_dst){unsigned keep;
  asm volatile("s_mov_b32 %0, m0\n\ts_mov_b32 m0, %2\n\ts_nop 0\n\tglobal_load_lds_dwordx4 %1, off\n\ts_mov_b32 m0, %0":"=&s"(keep):"v"(gsrc),"s"(lds_dst):"memory");}
__device__ __forceinline__ float max3f(float a,float b,float c){float r;asm("v_max3_f32 %0, %1, %2, %3":"=v"(r):"v"(a),"v"(b),"v"(c));return r;}
__device__ __forceinline__ float max2f(float a,float b){float r;asm("v_max_f32_e32 %0, %1, %2":"=v"(r):"v"(a),"v"(b));return r;}
__device__ __forceinline__ float fadd_s(float a,float b){float r;asm("v_add_f32_e32 %0, %1, %2":"=v"(r):"v"(a),"v"(b));return r;}
__device__ __forceinline__ float fsub_s(float a,float b){float r;asm("v_sub_f32_e32 %0, %1, %2":"=v"(r):"v"(a),"v"(b));return r;}
typedef float f32x2_t __attribute__((ext_vector_type(2))); typedef __bf16 bf16x2_t __attribute__((ext_vector_type(2)));
__device__ __forceinline__ unsigned cvtpk_s(float lo,float hi){f32x2_t v={lo,hi};bf16x2_t b=__builtin_convertvector(v,bf16x2_t);return __builtin_bit_cast(unsigned,b);}
#define WAIT_BAR(N) asm volatile("s_waitcnt vmcnt(" #N ") lgkmcnt(0)\n\ts_barrier":::"memory")

__device__ __forceinline__ void qkt(f32x16&p0,f32x16&p1,const char*Kslot,const bf16x8*qr,const f32x16&negm,int r32,int hi){
  const char*kb=Kslot+hi*1024+r32*16;
  #pragma unroll
  for(int d0=0;d0<4;++d0){
    const bf16x8 b0=*reinterpret_cast<const bf16x8*>(kb+d0*2048);
    const bf16x8 b1=*reinterpret_cast<const bf16x8*>(kb+d0*2048+512);
    if(d0==0){p0=__builtin_amdgcn_mfma_f32_32x32x16_bf16(b0,qr[0],negm,0,0,0);p1=__builtin_amdgcn_mfma_f32_32x32x16_bf16(b1,qr[0],negm,0,0,0);}
    else{p0=__builtin_amdgcn_mfma_f32_32x32x16_bf16(b0,qr[d0],p0,0,0,0);p1=__builtin_amdgcn_mfma_f32_32x32x16_bf16(b1,qr[d0],p1,0,0,0);}}
}
typedef __attribute__((address_space(3))) const char* lds_cptr;
typedef short v4i16_t __attribute__((ext_vector_type(4)));
__device__ __forceinline__ void kload8(bf16x8*kf,lds_cptr kp){
  kf[0]=*(const __attribute__((address_space(3))) bf16x8*)(kp);      kf[1]=*(const __attribute__((address_space(3))) bf16x8*)(kp+512);
  kf[2]=*(const __attribute__((address_space(3))) bf16x8*)(kp+2048); kf[3]=*(const __attribute__((address_space(3))) bf16x8*)(kp+2560);
  kf[4]=*(const __attribute__((address_space(3))) bf16x8*)(kp+4096); kf[5]=*(const __attribute__((address_space(3))) bf16x8*)(kp+4608);
  kf[6]=*(const __attribute__((address_space(3))) bf16x8*)(kp+6144); kf[7]=*(const __attribute__((address_space(3))) bf16x8*)(kp+6656);
}
__device__ __forceinline__ void kload2(bf16x8*kf,lds_cptr kp,int j){ kf[2*j]=*(const __attribute__((address_space(3))) bf16x8*)(kp+j*2048); kf[2*j+1]=*(const __attribute__((address_space(3))) bf16x8*)(kp+j*2048+512); }
__device__ __forceinline__ s16x4 vtr(lds_cptr p){ return __builtin_bit_cast(s16x4,__builtin_amdgcn_ds_read_tr16_b64_v4i16((__attribute__((address_space(3))) v4i16_t*)p)); }
__device__ __forceinline__ float rowmax(const f32x16&p0,const f32x16&p1){
  float a=max3f(p0[0],p0[1],p1[0]),b=max3f(p0[2],p0[3],p1[1]);a=max3f(a,p1[2],p1[3]);
  #pragma unroll
  for(int r=4;r<16;r+=4){a=max3f(a,p0[r],p0[r+1]);b=max3f(b,p0[r+2],p0[r+3]);a=max3f(a,p1[r],p1[r+1]);b=max3f(b,p1[r+2],p1[r+3]);}
  const float m=max2f(a,b);
  auto rr=__builtin_amdgcn_permlane32_swap(__float_as_uint(m),__float_as_uint(m),false,false);
  return max2f(__uint_as_float(rr[0]),__uint_as_float(rr[1]));
}
__device__ __forceinline__ void pv(f32x16*o,int vb,bf16x8 pa0,bf16x8 pa1,bf16x8 pa2,bf16x8 pa3){
  #pragma unroll
  for(int d0=0;d0<2;++d0){s16x4 lo[4],hi[4];
    #pragma unroll
    for(int ks=0;ks<4;++ks){
      asm volatile("ds_read_b64_tr_b16 %0,%1 offset:%c2":"=&v"(lo[ks]):"v"(vb),"i"(d0*4096+ks*1024):"memory");
      asm volatile("ds_read_b64_tr_b16 %0,%1 offset:%c2":"=&v"(hi[ks]):"v"(vb),"i"(d0*4096+ks*1024+512):"memory");}
    asm volatile("s_waitcnt lgkmcnt(0)":::"memory");SBAR();
    #define PK(k) (bf16x8){lo[k][0],lo[k][1],lo[k][2],lo[k][3],hi[k][0],hi[k][1],hi[k][2],hi[k][3]}
    o[d0]=__builtin_amdgcn_mfma_f32_32x32x16_bf16(pa0,PK(0),o[d0],0,0,0);
    o[d0]=__builtin_amdgcn_mfma_f32_32x32x16_bf16(pa1,PK(1),o[d0],0,0,0);
    o[d0]=__builtin_amdgcn_mfma_f32_32x32x16_bf16(pa2,PK(2),o[d0],0,0,0);
    o[d0]=__builtin_amdgcn_mfma_f32_32x32x16_bf16(pa3,PK(3),o[d0],0,0,0);
    #undef PK
  }
}

#ifndef ATTN_STORE16
#define ATTN_STORE16(p,v) (*(u32x4*)(p)=(v))
#endif
template<int THRL> __device__ __forceinline__ void attn_unit(int b,int h,int qb,const bf16*Q,const bf16*__restrict__ K,const bf16*__restrict__ V,bf16*O,char*shm,const int tid){
  const int lane=tid&63,r32=lane&31,hi=lane>>5; const int wid=__builtin_amdgcn_readfirstlane(tid>>6);
  const long rowbase=(long)b*SEQ; const int q0=qb*QB;
  const bf16*Qw=Q+(rowbase+q0+wid*QBLK)*DM+h*D;
  const bf16*Kh=K+rowbase*KVP+(h>>2)*D,*Vh=V+rowbase*KVP+(h>>2)*D;
  const unsigned lds0=(unsigned)(uintptr_t)shm;
  float*wsf=(float*)(shm+LDS_WS)+wid*64;
  const bf16*ksrc=Kh+(long)lane*KVP+wid*8;
  const bf16*vsrc=Vh+(long)(16*(wid&3)+(lane>>2))*KVP+(wid>>2)*32+(lane&3)*8;
  const unsigned kdst=lds0+LDS_K+wid*1024, vdst=lds0+LDS_V+wid*1024;
  #define DMA_K(t,slot) glds16(ksrc+(long)(t)*KVBLK*KVP,(unsigned)__builtin_amdgcn_readfirstlane(kdst+(slot)))
  #define DMA_V(t,slot) glds16(vsrc+(long)(t)*KVBLK*KVP,(unsigned)__builtin_amdgcn_readfirstlane(vdst+(slot)))
  const int vb0=(int)(lds0+LDS_V)+((lane>>4)&1)*32+(lane&3)*8+(4*hi+((lane&15)>>2))*64;
  const char*Kbase=shm+LDS_K; bf16x8 kf[8];
  const lds_cptr shm3=(lds_cptr)shm; const lds_cptr kp0=shm3+LDS_K+hi*1024+r32*16; const lds_cptr vp0=shm3+LDS_V+((lane>>4)&1)*32+(lane&3)*8+(4*hi+((lane&15)>>2))*64;
  const int NT=SEQ/KVBLK;
  DMA_K(0,0);DMA_V(0,0);DMA_K(1,SLOTB);
  bf16x8 qr[4];
  #pragma unroll
  for(int d0=0;d0<4;++d0)qr[d0]=*reinterpret_cast<const bf16x8*>(&Qw[(long)r32*DM+d0*16+hi*8]);
  float mhat=0.f,l_reg=0.f;f32x16 o[2];o[0]=f32x16{};o[1]=f32x16{};f32x16 negm=f32x16{};asm volatile("":"+v"(negm));
  const int qrel=wid*QBLK+r32;
  #define CMASK(P0,P1,t) do{}while(0)
  bool resc=false;
  #define START(P0,P1) do{ const float rm=rowmax(P0,P1); resc=false; \
    { const float dl=rm; mhat=fadd_s(mhat,dl); \
      _Pragma("unroll") for(int r=0;r<16;++r){P0[r]=fsub_s(P0[r],dl);P1[r]=fsub_s(P1[r],dl);} \
      _Pragma("unroll") for(int r=0;r<16;++r)negm[r]=-mhat; asm volatile("":"+v"(negm)); } \
    _Pragma("unroll") for(int r=0;r<16;++r)P0[r]=__builtin_amdgcn_exp2f(P0[r]); }while(0)
  #define RESC() do{ if(resc){ asm volatile("s_waitcnt lgkmcnt(0)":::"memory"); \
      _Pragma("unroll") for(int d_=0;d_<2;++d_) _Pragma("unroll") for(int r=0;r<16;++r)o[d_][r]*=wsf[crow(r,hi)]; } }while(0)
  f32x16 pA0,pA1,pB0,pB1;
  int sl_prev=0,sl_cur=0,sl_next=SLOTB;
  #define ROT() do{sl_prev=sl_cur;sl_cur=sl_next;sl_next=(sl_next==(NSLOT-1)*SLOTB)?0:sl_next+SLOTB;}while(0)
  DMA_K(2,2*SLOTB);
  WAIT_BAR(3);
  qkt(pA0,pA1,Kbase,qr,negm,r32,hi);asm volatile("s_nop 15\n\ts_nop 7":"+v"(pA0),"+v"(pA1));CMASK(pA0,pA1,0);
  START(pA0,pA1);
  _Pragma("unroll") for(int r=0;r<16;++r)pA1[r]=__builtin_amdgcn_exp2f(pA1[r]);
  WAIT_BAR(0);
  DMA_K(3,0);DMA_V(1,SLOTB);
  ROT();
  kload8(kf,kp0+sl_cur);
  WAIT_BAR(2);
  s16x4 vlo[8],vhi[8]; u32x4 pw0,pw1,pw2,pw3;
  #define PKW(P,B) cvtpk_s(P[B],P[B+1])
  #define PAF(k) __builtin_bit_cast(bf16x8,pw##k)
  #define VFR(i) (bf16x8){vlo[i][0],vlo[i][1],vlo[i][2],vlo[i][3],vhi[i][0],vhi[i][1],vhi[i][2],vhi[i][3]}
  #define PIN(x) asm volatile("":"+v"(x))
  #define MX3(a,b,c) __builtin_fmaxf(__builtin_fmaxf((a),(b)),(c))
  #define GAPA(MF,A0,A1,A2,A3,W0,W1,PW) do{ MF; sacc+=A0; sacc+=A1; sacc+=A2; sacc+=A3; PIN(sacc); W0; W1; PIN(PW); SBAR(); }while(0)
  #define EX(v) __builtin_amdgcn_exp2f(v)
  #define GAPB(MF,X,B) do{ MF; X[B]=EX(X[B]); X[B+1]=EX(X[B+1]); X[B+2]=EX(X[B+2]); X[B+3]=EX(X[B+3]); PIN(X); SBAR(); }while(0)
  #define VRD(i) do{ vlo[i]=vtr(vp_+(((i)>>2)*4096+((i)&3)*1024)); vhi[i]=vtr(vp_+(((i)>>2)*4096+((i)&3)*1024+512)); }while(0)
  #define KRD(G,j) do{ if(G){ kload2(kf,kp0+sl_next,j); SBAR(); } }while(0)
  #define STEP(C0,C1,P0,P1,t,GK,GV,GL) do{ SBAR(); \
    const lds_cptr vp_=vp0+sl_prev; \
    VRD(0); SBAR(); float sacc=(P0[0]+P0[1]); \
    GAPA(C0=__builtin_amdgcn_mfma_f32_32x32x16_bf16(kf[0],qr[0],negm,0,0,0), P0[2],P0[3],P0[4],P0[5],     pw0[0]=PKW(P0,0), pw0[1]=PKW(P0,2), pw0); \
    VRD(4); SBAR(); GAPA(C1=__builtin_amdgcn_mfma_f32_32x32x16_bf16(kf[1],qr[0],negm,0,0,0), P0[6],P0[7],P0[8],P0[9],     pw0[2]=PKW(P0,4), pw0[3]=PKW(P0,6), pw0); \
    VRD(1); SBAR(); GAPA(C0=__builtin_amdgcn_mfma_f32_32x32x16_bf16(kf[2],qr[1],C0,0,0,0),   P0[10],P0[11],P0[12],P0[13], pw1[0]=PKW(P0,8), pw1[1]=PKW(P0,10), pw1); \
    VRD(5); SBAR(); GAPA(C1=__builtin_amdgcn_mfma_f32_32x32x16_bf16(kf[3],qr[1],C1,0,0,0),   P0[14],P0[15],P1[0],P1[1],   pw1[2]=PKW(P0,12),pw1[3]=PKW(P0,14), pw1); \
    VRD(2); SBAR(); GAPA(C0=__builtin_amdgcn_mfma_f32_32x32x16_bf16(kf[4],qr[2],C0,0,0,0),   P1[2],P1[3],P1[4],P1[5],     pw2[0]=PKW(P1,0), pw2[1]=PKW(P1,2), pw2); \
    VRD(6); SBAR(); GAPA(C1=__builtin_amdgcn_mfma_f32_32x32x16_bf16(kf[5],qr[2],C1,0,0,0),   P1[6],P1[7],P1[8],P1[9],     pw2[2]=PKW(P1,4), pw2[3]=PKW(P1,6), pw2); \
    VRD(3); SBAR(); GAPA(C0=__builtin_amdgcn_mfma_f32_32x32x16_bf16(kf[6],qr[3],C0,0,0,0),   P1[10],P1[11],P1[12],P1[13], pw3[0]=PKW(P1,8), pw3[1]=PKW(P1,10), pw3); \
    VRD(7); SBAR(); GAPA(C1=__builtin_amdgcn_mfma_f32_32x32x16_bf16(kf[7],qr[3],C1,0,0,0),   P1[14],P1[15],0.f,0.f,       pw3[2]=PKW(P1,12),pw3[3]=PKW(P1,14), pw3); \
    l_reg+=sacc; \
    if(GK){DMA_K((t)+3,sl_cur);} if(GV){DMA_V((t)+1,sl_next);} \
    CMASK(C0,C1,t); \
    { float a=MX3(C0[0],C0[1],C1[0]),b=MX3(C0[2],C0[3],C1[1]); a=MX3(a,C1[2],C1[3]); \
      _Pragma("unroll") for(int r=4;r<16;r+=4){a=MX3(a,C0[r],C0[r+1]);b=MX3(b,C0[r+2],C0[r+3]);a=MX3(a,C1[r],C1[r+1]);b=MX3(b,C1[r+2],C1[r+3]);} \
      float rm=__builtin_fmaxf(a,b); { auto rr=__builtin_amdgcn_permlane32_swap(__float_as_uint(rm),__float_as_uint(rm),false,false); rm=__builtin_fmaxf(__uint_as_float(rr[0]),__uint_as_float(rr[1])); } \
      resc=false; \
      if(__builtin_expect(__any(rm>(float)THRL),0)){ const float dl=__builtin_fmaxf(rm,0.f); mhat+=dl; \
        _Pragma("unroll") for(int r=0;r<16;++r){C0[r]-=dl;C1[r]-=dl;} \
        _Pragma("unroll") for(int r=0;r<16;++r)negm[r]=-mhat; asm volatile("":"+v"(negm)); \
        const float f=__builtin_amdgcn_exp2f(-dl); l_reg*=f; if(hi==0)wsf[r32]=f; resc=true; } } \
    SBAR(); \
    GAPB(o[0]=__builtin_amdgcn_mfma_f32_32x32x16_bf16(PAF(0),VFR(0),o[0],0,0,0), C0,0); \
    GAPB(o[1]=__builtin_amdgcn_mfma_f32_32x32x16_bf16(PAF(0),VFR(4),o[1],0,0,0), C0,4); \
    KRD(GL,0); GAPB(o[0]=__builtin_amdgcn_mfma_f32_32x32x16_bf16(PAF(1),VFR(1),o[0],0,0,0), C0,8); \
    KRD(GL,1); GAPB(o[1]=__builtin_amdgcn_mfma_f32_32x32x16_bf16(PAF(1),VFR(5),o[1],0,0,0), C0,12); \
    KRD(GL,2); GAPB(o[0]=__builtin_amdgcn_mfma_f32_32x32x16_bf16(PAF(2),VFR(2),o[0],0,0,0), C1,0); \
    KRD(GL,3); GAPB(o[1]=__builtin_amdgcn_mfma_f32_32x32x16_bf16(PAF(2),VFR(6),o[1],0,0,0), C1,4); \
    GAPB(o[0]=__builtin_amdgcn_mfma_f32_32x32x16_bf16(PAF(3),VFR(3),o[0],0,0,0), C1,8); \
    GAPB(o[1]=__builtin_amdgcn_mfma_f32_32x32x16_bf16(PAF(3),VFR(7),o[1],0,0,0), C1,12); \
    }while(0)
  int t=1;
  #undef CMASK
  #define CMASK(P0,P1,t) do{}while(0)
  for(;t+5<NT;t+=2){
    STEP(pB0,pB1,pA0,pA1,t,true,true,true);     WAIT_BAR(2); RESC(); ROT();
    STEP(pA0,pA1,pB0,pB1,t+1,true,true,true);   WAIT_BAR(2); RESC(); ROT();
  }
  #undef CMASK
  #define CMASK(P0,P1,t) do{}while(0)
  #define ENDW(tt) do{ if((tt)+3<NT){WAIT_BAR(2);} else if((tt)+2<NT){WAIT_BAR(1);} else {WAIT_BAR(0);} }while(0)
  for(;t+1<NT;t+=2){
    STEP(pB0,pB1,pA0,pA1,t,(t+3<NT),(t+1<NT),(t+1<NT));       ENDW(t);   RESC(); ROT();
    STEP(pA0,pA1,pB0,pB1,t+1,(t+4<NT),(t+2<NT),(t+2<NT));     ENDW(t+1); RESC(); ROT();
  }
  STEP(pB0,pB1,pA0,pA1,NT-1,false,false,false); RESC();
  { float sacc=pB0[0]+pB0[1]; _Pragma("unroll") for(int r=2;r<16;++r)sacc+=pB0[r]; _Pragma("unroll") for(int r=0;r<16;++r)sacc+=pB1[r]; l_reg+=sacc;
    pw0=(u32x4){PKW(pB0,0),PKW(pB0,2),PKW(pB0,4),PKW(pB0,6)};pw1=(u32x4){PKW(pB0,8),PKW(pB0,10),PKW(pB0,12),PKW(pB0,14)};pw2=(u32x4){PKW(pB1,0),PKW(pB1,2),PKW(pB1,4),PKW(pB1,6)};pw3=(u32x4){PKW(pB1,8),PKW(pB1,10),PKW(pB1,12),PKW(pB1,14)};
    SBAR(); pv(o,vb0+sl_cur,PAF(0),PAF(1),PAF(2),PAF(3)); }
  #undef PKW
  #undef PAF
  #undef VFR
  #undef PIN
  #undef MX3
  #undef GAPA
  #undef GAPB
  #undef EX
  #undef VRD
  #undef KRD
  #undef STEP
  #undef ENDW
  {auto rr=__builtin_amdgcn_permlane32_swap(__float_as_uint(l_reg),__float_as_uint(l_reg),false,false);l_reg=__uint_as_float(rr[0])+__uint_as_float(rr[1]);}
  if(hi==0)wsf[32+r32]=l_reg;asm volatile("s_waitcnt lgkmcnt(0)":::"memory");
  float rli[16];
  #pragma unroll
  for(int r=0;r<16;++r)rli[r]=__builtin_amdgcn_rcpf(wsf[32+crow(r,hi)]);
  bf16*Ow=O+(rowbase+q0+wid*QBLK)*DM+h*D;
  { bf16*stg=(bf16*)(shm+LDS_OST)+wid*2048;
    #pragma unroll
    for(int r=0;r<16;++r){const int orow=crow(r,hi);
      #pragma unroll
      for(int d0=0;d0<2;++d0)stg[orow*64+d0*32+r32]=__float2bfloat16(o[d0][r]*rli[r]);}
    asm volatile("s_waitcnt lgkmcnt(0)":::"memory");
    #pragma unroll
    for(int i=0;i<4;++i){const int row=i*8+(lane>>3),ch=lane&7; const u32x4 v=*(const u32x4*)(stg+row*64+ch*8); ATTN_STORE16(Ow+(long)row*DM+ch*8,v);} }
  asm volatile("s_waitcnt lgkmcnt(0)\n\ts_barrier":::"memory");
  #undef DMA_K
  #undef DMA_V
  #undef CMASK
  #undef START
  #undef RESC
  #undef ROT
}
constexpr int ATTN_LDS_BYTES=LDS_BYTES;
struct AttnTensors { const bf16* Q; const bf16* K; const bf16* V; bf16* O; };
struct AttnUnit { int bh; int qb; };
struct StaticOrder {
  int vcu,per;
  __device__ __forceinline__ explicit StaticOrder(int grid,int block):vcu((grid%8==0)?(block%8)*(grid/8)+block/8:block),per((BATCH*NHEAD*NQB+grid-1)/grid){}
  __device__ __forceinline__ bool next(int i,AttnUnit&u)const{ const int L=vcu*per+i; if(i>=per||L>=BATCH*NHEAD*NQB)return false; const int grp=L>>6,idx=L&63; u.bh=(grp>>2)*NHEAD+(grp&3)*4+(idx&3); u.qb=idx>>2; return true; }
  __device__ __forceinline__ void a_ready(const AttnUnit&)const{}
  __device__ __forceinline__ void done(const AttnUnit&)const{}
};
template<class Sched,int THRL=8> __device__ __forceinline__ void attn_phase(char*lds,const AttnTensors&T,const Sched&S,const int tid){
  AttnUnit u;
  for(int i=0;S.next(i,u);++i){ S.a_ready(u); attn_unit<THRL>(u.bh/NHEAD,u.bh%NHEAD,u.qb,T.Q,T.K,T.V,T.O,lds,tid); S.done(u); }
}
#undef SBAR
#undef WAIT_BAR
}

__device__ __forceinline__ void transpose_item(const float* W, const float* g, int K, int N, bf16_t* WT, LAS float* scr, int item, int lane) {
    const int nblk = N / 32, kb = item / nblk, nb = item % nblk, k0 = 64 * kb, n0 = 32 * nb;
#pragma unroll 8
    for (int i = 0; i < 32; ++i) { const int kk = 2 * i + (lane >> 5); const float gv = g ? g[k0 + kk] : 1.0f;
        scr[kk * 33 + (lane & 31)] = W[(size_t)(k0 + kk) * N + n0 + (lane & 31)] * gv; }
    LDS_WAIT(); asm volatile("" ::: "memory");
    const int c = lane & 7;
#pragma unroll
    for (int j = 0; j < 4; ++j) { const int n = (lane >> 3) + 8 * j; const LAS float* s = scr + (8 * c) * 33 + n;
        u32x4 o; o.x = pk2(s[0 * 33], s[1 * 33]); o.y = pk2(s[2 * 33], s[3 * 33]); o.z = pk2(s[4 * 33], s[5 * 33]); o.w = pk2(s[6 * 33], s[7 * 33]);
        *(u32x4*)(WT + (size_t)(n0 + n) * K + k0 + 8 * c) = o; }
    LDS_WAIT(); asm volatile("" ::: "memory");
}
__device__ __forceinline__ void sincos_d(double x, double& s, double& c) {
    const double TWO_PI = 6.283185307179586476925286766559;
    const double n = __builtin_rint(x / TWO_PI);
    const double r = x - n * TWO_PI, r2 = r * r;
    double ts = 1.0, tc = 1.0;
#pragma unroll
    for (int k = 13; k >= 1; --k) { ts = 1.0 - ts * r2 / (double)((2 * k) * (2 * k + 1)); tc = 1.0 - tc * r2 / (double)((2 * k - 1) * (2 * k)); }
    s = r * ts; c = tc;
}

template <class Epi>
__device__ __forceinline__ void gemm_simple(const bf16_t* A, const bf16_t* Bt, int Mrows, int N, int K, const Epi& E, int gw, int ngw, int lane) {
    const int fr = lane & 15, fq = lane >> 4;
    const int ntn = N / 64, ntm = Mrows / 32, ntiles = ntn * ntm;
    for (int t = gw; t < ntiles; t += ngw) {
        const int tn = t % ntn, tm = t / ntn;
        f32x4 acc[2][4];
#pragma unroll
        for (int m = 0; m < 2; ++m)
#pragma unroll
            for (int n = 0; n < 4; ++n) acc[m][n] = (f32x4){0.f, 0.f, 0.f, 0.f};
        const bf16_t* Ap = A + (size_t)(tm * 32 + fr) * K + fq * 8;
        const bf16_t* Bp = Bt + (size_t)(tn * 64 + fr) * K + fq * 8;
        for (int k0 = 0; k0 < K; k0 += 32) {
            bf16x8 a[2], b[4];
            a[0] = *(const bf16x8*)(Ap + k0); a[1] = *(const bf16x8*)(Ap + (size_t)16 * K + k0);
#pragma unroll
            for (int n = 0; n < 4; ++n) b[n] = *(const bf16x8*)(Bp + (size_t)n * 16 * K + k0);
#pragma unroll
            for (int m = 0; m < 2; ++m)
#pragma unroll
                for (int n = 0; n < 4; ++n) acc[m][n] = __builtin_amdgcn_mfma_f32_16x16x32_bf16(b[n], a[m], acc[m][n], 0, 0, 0);
        }
        E(tm * 32, tn * 64, acc, fr, fq);
    }
}

struct EpiQKV {
    const float* ssq; const float* qg; const float* kg; const f32x2* rope; bf16_t* Q; bf16_t* Kb; bf16_t* Vb;
    __device__ __forceinline__ void operator()(int row0, int col0, f32x4 (&acc)[2][4], int fr, int fq) const {
#pragma unroll
        for (int m = 0; m < 2; ++m) {
            const int row = row0 + 16 * m + fr; const float rs = rstd_from_slots(ssq, row);
            f32x4 v[4];
#pragma unroll
            for (int n = 0; n < 4; ++n) v[n] = acc[m][n] * rs;
            if (col0 < 1280) {
                const bool isq = col0 < 1024; const float* g = isq ? qg : kg;
                float ss = 0.f;
#pragma unroll
                for (int n = 0; n < 4; ++n) ss += (v[n].x * v[n].x + v[n].y * v[n].y) + (v[n].z * v[n].z + v[n].w * v[n].w);
                ss += __shfl_xor(ss, 16); ss += __shfl_xor(ss, 32);
                const float r = 1.0f / sqrtf(ss * (1.0f / 64.0f) + EPS);
#pragma unroll
                for (int n = 0; n < 4; ++n) { const f32x4 gv = *(const f32x4*)(g + 16 * n + 4 * fq); v[n] = v[n] * r * gv; }
                const int t = row % SEQ, prow = t >> 6, pcol = t & 63;
                const float sc = isq ? C2 : 1.0f;
#pragma unroll
                for (int hh = 0; hh < 2; ++hh) {
                    const int pos = hh == 0 ? prow : pcol;
                    f32x4 x1 = v[2 * hh], x2 = v[2 * hh + 1], o1, o2;
#pragma unroll
                    for (int j = 0; j < 4; ++j) { const f32x2 cs = rope[pos * 16 + 4 * fq + j];
                        o1[j] = (x1[j] * cs.x - x2[j] * cs.y) * sc; o2[j] = (x2[j] * cs.x + x1[j] * cs.y) * sc; }
                    v[2 * hh] = o1; v[2 * hh + 1] = o2;
                }
            }
            bf16_t* dst;
            if (col0 < 1024) dst = Q + (size_t)row * D + col0;
            else if (col0 < 1280) dst = Kb + (size_t)row * KVP + (col0 - 1024);
            else dst = Vb + (size_t)row * KVP + (col0 - 1280);
#pragma unroll
            for (int n = 0; n < 4; ++n) { u32x2 w; w.x = pk2(v[n].x, v[n].y); w.y = pk2(v[n].z, v[n].w); *(u32x2*)(dst + 16 * n + 4 * fq) = w; }
        }
    }
};
struct EpiRes {
    const float* base; float* out; bf16_t* xb; float* ssq;
    __device__ __forceinline__ void operator()(int row0, int col0, f32x4 (&acc)[2][4], int fr, int fq) const {
#pragma unroll
        for (int m = 0; m < 2; ++m) {
            const int row = row0 + 16 * m + fr; float ss = 0.f;
#pragma unroll
            for (int n = 0; n < 4; ++n) { const size_t off = (size_t)row * D + col0 + 16 * n + 4 * fq;
                const f32x4 h = *(const f32x4*)(base + off) + acc[m][n]; *(f32x4*)(out + off) = h;
                ss += (h.x * h.x + h.y * h.y) + (h.z * h.z + h.w * h.w);
                if (xb) { u32x2 w; w.x = pk2(h.x, h.y); w.y = pk2(h.z, h.w); *(u32x2*)(xb + off) = w; } }
            ss += __shfl_xor(ss, 16); ss += __shfl_xor(ss, 32);
            if (ssq && fq == 0) ssq[(size_t)row * 16 + (col0 >> 6)] = ss;
        }
    }
};
struct EpiUp {
    const float* ssq; bf16_t* HB;
    __device__ __forceinline__ void operator()(int row0, int col0, f32x4 (&acc)[2][4], int fr, int fq) const {
#pragma unroll
        for (int m = 0; m < 2; ++m) {
            const int row = row0 + 16 * m + fr; const float rs = rstd_from_slots(ssq, row);
#pragma unroll
            for (int n = 0; n < 4; ++n) { f32x4 v = acc[m][n] * rs;
#pragma unroll
                for (int j = 0; j < 4; ++j) { const float t = fmaxf(v[j], 0.f); v[j] = t * t; }
                u32x2 w; w.x = pk2(v.x, v.y); w.y = pk2(v.z, v.w); *(u32x2*)(HB + (size_t)row * FF + col0 + 16 * n + 4 * fq) = w; }
        }
    }
};
struct EpiGin {
    const float* ssq; bf16_t* q; bf16_t* k; bf16_t* v; bf16_t* r;
    __device__ __forceinline__ void operator()(int row0, int col0, f32x4 (&acc)[2][4], int fr, int fq) const {
#pragma unroll
        for (int m = 0; m < 2; ++m) {
            const int row = row0 + 16 * m + fr; float rs = rstd_from_slots(ssq, row);
            bf16_t* dst;
            if (col0 < 512) { dst = q + (size_t)row * GQK + col0; rs *= 0.08838834764831845f; }
            else if (col0 < 1024) dst = k + (size_t)row * GQK + (col0 - 512);
            else if (col0 < 2048) dst = v + (size_t)row * GV + (col0 - 1024);
            else dst = r + (size_t)row * GV + (col0 - 2048);
#pragma unroll
            for (int n = 0; n < 4; ++n) { const f32x4 x = acc[m][n] * rs; u32x2 w; w.x = pk2(x.x, x.y); w.y = pk2(x.z, x.w); *(u32x2*)(dst + 16 * n + 4 * fq) = w; }
        }
    }
};
struct EpiZ {
    const float* ssq; float* Z;
    __device__ __forceinline__ void operator()(int row0, int col0, f32x4 (&acc)[2][4], int fr, int fq) const {
#pragma unroll
        for (int m = 0; m < 2; ++m) {
            const int row = row0 + 16 * m + fr; const float rs = rstd_from_slots(ssq, row);
#pragma unroll
            for (int n = 0; n < 4; ++n) *(f32x4*)(Z + (size_t)row * 64 + col0 + 16 * n + 4 * fq) = acc[m][n] * rs;
        }
    }
};

__device__ __forceinline__ void attn_simple(const bf16_t* Q, const bf16_t* Kb, const bf16_t* Vb, bf16_t* O, int gw, int ngw, int lane) {
    const int fr = lane & 15, fq = lane >> 4;
    for (int u = gw; u < BATCH * NH * (SEQ / 16); u += ngw) {
        const int qt = u & 255, h = (u >> 8) & 15, b = u >> 12, kvh = h >> 2;
        const size_t rowbase = (size_t)b * SEQ;
        const bf16_t* Qp = Q + (rowbase + qt * 16 + fr) * D + h * HD + fq * 8;
        bf16x8 qf[2]; qf[0] = *(const bf16x8*)Qp; qf[1] = *(const bf16x8*)(Qp + 32);
        const bf16_t* Kh = Kb + rowbase * KVP + kvh * HD;
        const bf16_t* Vh = Vb + rowbase * KVP + kvh * HD;
        float mrun = -1e30f, lrun = 0.f;
        f32x4 oacc[4];
#pragma unroll
        for (int dt = 0; dt < 4; ++dt) oacc[dt] = (f32x4){0.f, 0.f, 0.f, 0.f};
        for (int kt = 0; kt < SEQ / 64; ++kt) {
            const int key0 = kt * 64;
            f32x4 sT[4];
#pragma unroll
            for (int blk = 0; blk < 4; ++blk) {
                const int key = key0 + 32 * (blk >> 1) + 8 * (fr >> 2) + 4 * (blk & 1) + (fr & 3);
                const bf16_t* kp = Kh + (size_t)key * KVP + fq * 8;
                const bf16x8 k0 = *(const bf16x8*)kp, k1 = *(const bf16x8*)(kp + 32);
                f32x4 z = (f32x4){0.f, 0.f, 0.f, 0.f};
                z = __builtin_amdgcn_mfma_f32_16x16x32_bf16(k0, qf[0], z, 0, 0, 0);
                z = __builtin_amdgcn_mfma_f32_16x16x32_bf16(k1, qf[1], z, 0, 0, 0);
                sT[blk] = z;
            }
            float mx = sT[0][0];
#pragma unroll
            for (int blk = 0; blk < 4; ++blk)
#pragma unroll
                for (int r = 0; r < 4; ++r) mx = fmaxf(mx, sT[blk][r]);
            mx = fmaxf(mx, __shfl_xor(mx, 16)); mx = fmaxf(mx, __shfl_xor(mx, 32));
            const float mnew = fmaxf(mrun, mx), alpha = __builtin_amdgcn_exp2f(mrun - mnew); mrun = mnew;
            float ps = 0.f; bf16x8 pf[2];
#pragma unroll
            for (int ks = 0; ks < 2; ++ks) {
                float p[8];
#pragma unroll
                for (int j = 0; j < 8; ++j) { p[j] = __builtin_amdgcn_exp2f(sT[2 * ks + (j >> 2)][j & 3] - mnew); ps += p[j]; }
                u32x4 w; w.x = pk2(p[0], p[1]); w.y = pk2(p[2], p[3]); w.z = pk2(p[4], p[5]); w.w = pk2(p[6], p[7]);
                pf[ks] = __builtin_bit_cast(bf16x8, w);
            }
            lrun = lrun * alpha + ps;
#pragma unroll
            for (int dt = 0; dt < 4; ++dt) oacc[dt] = oacc[dt] * alpha;
#pragma unroll
            for (int ks = 0; ks < 2; ++ks)
#pragma unroll
                for (int dt = 0; dt < 4; ++dt) {
                    const bf16_t* vp = Vh + (size_t)(key0 + 32 * ks + 8 * fq) * KVP + dt * 16 + fr;
                    bf16x8 vf;
#pragma unroll
                    for (int e = 0; e < 8; ++e) vf[e] = (short)vp[(size_t)e * KVP];
                    oacc[dt] = __builtin_amdgcn_mfma_f32_16x16x32_bf16(vf, pf[ks], oacc[dt], 0, 0, 0);
                }
        }
        lrun += __shfl_xor(lrun, 16); lrun += __shfl_xor(lrun, 32);
        const float inv = 1.0f / lrun;
        bf16_t* Op = O + (rowbase + qt * 16 + fr) * D + h * HD + 4 * fq;
#pragma unroll
        for (int dt = 0; dt < 4; ++dt) { const f32x4 o = oacc[dt] * inv; u32x2 w; w.x = pk2(o.x, o.y); w.y = pk2(o.z, o.w); *(u32x2*)(Op + dt * 16) = w; }
    }
}

__device__ __forceinline__ void gla_pre(const bf16_t* q, const bf16_t* k, const float* Z, const float* wgu, const float* bgate, bf16_t* qe, bf16_t* ke, float* decay, int wg, int nwg, int tid) {
    const int c = tid, h = c >> 7, d = c & 127;
    for (int it = wg; it < BATCH * NCH * 2; it += nwg) {
        const int dir = it & 1, n = (it >> 1) & (NCH - 1), b = it >> 7;
        float w[RANK];
#pragma unroll
        for (int r = 0; r < RANK; ++r) w[r] = wgu[((size_t)dir * RANK + r) * GQK + c];
        const float bg = bgate[dir * GQK + c];
        float bsum = 0.f;
        bf16_t* qed = qe + (size_t)dir * M * GQK; bf16_t* ked = ke + (size_t)dir * M * GQK;
        for (int s = 0; s < CH; ++s) {
            const int i = dir == 0 ? s : (CH - 1 - s);
            const size_t tok = (size_t)b * SEQ + n * CH + i;
            const f32x4* zp = (const f32x4*)(Z + tok * 64 + dir * RANK);
            const f32x4 z0 = zp[0], z1 = zp[1], z2 = zp[2], z3 = zp[3];
            float logit = bg;
            logit += z0.x * w[0] + z0.y * w[1] + z0.z * w[2] + z0.w * w[3];
            logit += z1.x * w[4] + z1.y * w[5] + z1.z * w[6] + z1.w * w[7];
            logit += z2.x * w[8] + z2.y * w[9] + z2.z * w[10] + z2.w * w[11];
            logit += z3.x * w[12] + z3.y * w[13] + z3.z * w[14] + z3.w * w[15];
            const float lg = (fminf(logit, 0.f) - log1pf(expf(-fabsf(logit)))) * (1.0f / 16.0f);
            bsum += lg;
            const float eb = expf(bsum), enb = expf(-bsum);
            qed[tok * GQK + c] = (bf16_t)f2bf(bf2f(q[tok * GQK + c]) * eb);
            ked[tok * GQK + c] = (bf16_t)f2bf(bf2f(k[tok * GQK + c]) * enb);
        }
        decay[((((size_t)b * GH + h) * 2 + dir) * NCH + n) * GDK + d] = expf(bsum);
    }
}

__device__ __forceinline__ void gla_scan_simple(const bf16_t* qe, const bf16_t* ke, const bf16_t* v, const float* decay, bf16_t* of, bf16_t* ob, LAS unsigned char* lds, int wg, int nwg, int tid) {
    LAS float* qeL = (LAS float*)lds;
    LAS float* keL = qeL + 64 * 129;
    LAS float* vL = keL + 64 * 129;
    LAS float* AL = vL + 64 * 33;
    LAS float* SL = AL + 64 * 65;
    LAS float* dL = SL + 128 * 33;
    for (int it = wg; it < BATCH * GH * 2 * 8; it += nwg) {
        const int js = it & 7, dir = (it >> 3) & 1, h = (it >> 4) & 3, b = it >> 6;
        const bf16_t* qed = qe + (size_t)dir * M * GQK; const bf16_t* ked = ke + (size_t)dir * M * GQK;
        bf16_t* od = dir == 0 ? of : ob;
        for (int e = tid; e < 128 * 33; e += NTHREADS) SL[e] = 0.f;
        __syncthreads();
        for (int st = 0; st < NCH; ++st) {
            const int n = dir == 0 ? st : (NCH - 1 - st);
            const size_t tok0 = (size_t)b * SEQ + n * CH;
            {
                const int i = tid >> 3, ds = (tid & 7) * 16;
                const u32x4* qp = (const u32x4*)(qed + (tok0 + i) * GQK + h * GDK + ds);
                const u32x4* kp = (const u32x4*)(ked + (tok0 + i) * GQK + h * GDK + ds);
#pragma unroll
                for (int hh = 0; hh < 2; ++hh) { const u32x4 a = qp[hh], c = kp[hh];
#pragma unroll
                    for (int j = 0; j < 4; ++j) { qeL[i * 129 + ds + hh * 8 + 2 * j] = bflo(a[j]); qeL[i * 129 + ds + hh * 8 + 2 * j + 1] = bfhi(a[j]);
                                                  keL[i * 129 + ds + hh * 8 + 2 * j] = bflo(c[j]); keL[i * 129 + ds + hh * 8 + 2 * j + 1] = bfhi(c[j]); } }
                if (tid < 256) { const int iv = tid >> 2, vs = (tid & 3) * 8;
                    const u32x4 a = *(const u32x4*)(v + (tok0 + iv) * GV + h * GDV + js * 32 + vs);
#pragma unroll
                    for (int j = 0; j < 4; ++j) { vL[iv * 33 + vs + 2 * j] = bflo(a[j]); vL[iv * 33 + vs + 2 * j + 1] = bfhi(a[j]); } }
                if (tid < 128) dL[tid] = decay[((((size_t)b * GH + h) * 2 + dir) * NCH + n) * GDK + tid];
            }
            __syncthreads();
            {
                const int i = tid >> 3, jg = tid & 7;
                float a[8];
#pragma unroll
                for (int e = 0; e < 8; ++e) a[e] = 0.f;
                for (int d = 0; d < GDK; ++d) { const float qv = qeL[i * 129 + d];
#pragma unroll
                    for (int e = 0; e < 8; ++e) a[e] += qv * keL[(jg + 8 * e) * 129 + d]; }
#pragma unroll
                for (int e = 0; e < 8; ++e) { const int j = jg + 8 * e; const bool keep = dir == 0 ? (j <= i) : (j >= i); AL[i * 65 + j] = keep ? a[e] : 0.f; }
            }
            __syncthreads();
            {
                const int i = tid >> 3, vg = (tid & 7) * 4;
                float o[4] = {0.f, 0.f, 0.f, 0.f};
                for (int j = 0; j < CH; ++j) { const float a = AL[i * 65 + j];
#pragma unroll
                    for (int e = 0; e < 4; ++e) o[e] += a * vL[j * 33 + vg + e]; }
                for (int d = 0; d < GDK; ++d) { const float qv = qeL[i * 129 + d];
#pragma unroll
                    for (int e = 0; e < 4; ++e) o[e] += qv * SL[d * 33 + vg + e]; }
                u32x2 w; w.x = pk2(o[0], o[1]); w.y = pk2(o[2], o[3]);
                *(u32x2*)(od + (tok0 + i) * GV + h * GDV + js * 32 + vg) = w;
            }
            __syncthreads();
            {
                const int d = tid >> 2, vg = (tid & 3) * 8;
                float s[8];
#pragma unroll
                for (int e = 0; e < 8; ++e) s[e] = SL[d * 33 + vg + e];
                for (int j = 0; j < CH; ++j) { const float kv = keL[j * 129 + d];
#pragma unroll
                    for (int e = 0; e < 8; ++e) s[e] += kv * vL[j * 33 + vg + e]; }
                const float dc = dL[d];
#pragma unroll
                for (int e = 0; e < 8; ++e) SL[d * 33 + vg + e] = dc * s[e];
            }
            __syncthreads();
        }
    }
}


typedef short s16x4 __attribute__((ext_vector_type(4)));
__device__ __forceinline__ s16x4 ds_tr16(const LAS unsigned char* p) { return __builtin_amdgcn_ds_read_tr16_b64_v4i16((LAS s16x4*)p); }
__device__ __forceinline__ bf16x8 cat8(s16x4 lo, s16x4 hi) { return (bf16x8){lo[0], lo[1], lo[2], lo[3], hi[0], hi[1], hi[2], hi[3]}; }
constexpr int GS_QSTR = 272, GS_VSTR = 80;
constexpr int GS_QE = 0, GS_KE = 64 * GS_QSTR, GS_V = 2 * 64 * GS_QSTR, GS_BUF = GS_V + 64 * GS_VSTR;
constexpr int GS_ST = 2 * GS_BUF, GS_STB = 32 * GS_QSTR;
static_assert(GS_ST + 2 * GS_STB <= RING_BYTES, "GLA scan LDS");
__device__ __forceinline__ void gla_scan_mfma(const bf16_t* qe, const bf16_t* ke, const bf16_t* v, const float* decay, bf16_t* of, bf16_t* ob, LAS unsigned char* lds, int wg, int nwg, const int tid) {
    const int lane = tid & 63, wave = __builtin_amdgcn_readfirstlane(tid >> 6), fr = lane & 15, fq = lane >> 4;
    const int tb = wave >> 1, c = wave & 1, T0 = 2 * (wave >> 1);
    const int trq = (lane & 15) >> 2, trp = lane & 3;
    for (int it = wg; it < BATCH * GH * 2 * 8; it += nwg) {
        const int js = it & 7, dir = (it >> 3) & 1, h = (it >> 4) & 3, b = it >> 6;
        const bf16_t* qed = qe + (size_t)dir * M * GQK + h * GDK; const bf16_t* ked = ke + (size_t)dir * M * GQK + h * GDK;
        const bf16_t* vd = v + h * GDV + js * 32;
        bf16_t* od = (dir == 0 ? of : ob) + h * GDV + js * 32;
        const float* decp = decay + ((((size_t)b * GH + h) * 2 + dir) * NCH) * GDK;
        f32x4 S0 = (f32x4){0.f, 0.f, 0.f, 0.f}, S1 = (f32x4){0.f, 0.f, 0.f, 0.f};
        u32x4 lq[2], lk[2], lv = (u32x4){0u, 0u, 0u, 0u}; f32x4 dcur[2], dnext[2];
#define GS_ISSUE(n_) do { const size_t tok0_ = (size_t)b * SEQ + (size_t)(n_) * CH; \
            _Pragma("unroll") for (int i_ = 0; i_ < 2; ++i_) { const size_t r_ = tok0_ + (tid >> 4) + 32 * i_; \
                lq[i_] = *(const u32x4*)(qed + r_ * GQK + (tid & 15) * 8); lk[i_] = *(const u32x4*)(ked + r_ * GQK + (tid & 15) * 8); } \
            if (tid < 256) lv = *(const u32x4*)(vd + (tok0_ + (tid >> 2)) * GV + (tid & 3) * 8); \
            dnext[0] = *(const f32x4*)(decp + (size_t)(n_) * GDK + 16 * T0 + 4 * fq); dnext[1] = *(const f32x4*)(decp + (size_t)(n_) * GDK + 16 * T0 + 16 + 4 * fq); } while (0)
#define GS_COMMIT(buf_) do { LAS unsigned char* B_ = lds + (buf_) * GS_BUF; \
            _Pragma("unroll") for (int i_ = 0; i_ < 2; ++i_) { const int r_ = (tid >> 4) + 32 * i_; \
                *(LAS u32x4*)(B_ + GS_QE + r_ * GS_QSTR + (tid & 15) * 16) = lq[i_]; *(LAS u32x4*)(B_ + GS_KE + r_ * GS_QSTR + (tid & 15) * 16) = lk[i_]; } \
            if (tid < 256) *(LAS u32x4*)(B_ + GS_V + (tid >> 2) * GS_VSTR + (tid & 3) * 16) = lv; } while (0)
        for (int e = tid; e < GS_STB / 16; e += NTHREADS) *(LAS u32x4*)(lds + GS_ST + e * 16) = (u32x4){0u, 0u, 0u, 0u};
        { const int n0 = dir == 0 ? 0 : NCH - 1; GS_ISSUE(n0); GS_COMMIT(0); dcur[0] = dnext[0]; dcur[1] = dnext[1]; }
        for (int s = 0; s < NCH; ++s) {
            const int n = dir == 0 ? s : NCH - 1 - s, cur = s & 1;
            asm volatile("s_waitcnt lgkmcnt(0)" ::: "memory"); __builtin_amdgcn_s_barrier(); asm volatile("" ::: "memory");
            if (s + 1 < NCH) { const int nn = dir == 0 ? s + 1 : NCH - 2 - s; GS_ISSUE(nn); }
            const LAS unsigned char* Bq = lds + cur * GS_BUF + GS_QE; const LAS unsigned char* Bk = lds + cur * GS_BUF + GS_KE; const LAS unsigned char* Bv = lds + cur * GS_BUF + GS_V;
            const LAS unsigned char* St = lds + GS_ST + cur * GS_STB; LAS unsigned char* Stn = lds + GS_ST + (cur ^ 1) * GS_STB;
            bf16x8 qf[4];
#pragma unroll
            for (int ks = 0; ks < 4; ++ks) qf[ks] = *(const LAS bf16x8*)(Bq + (16 * tb + fr) * GS_QSTR + (32 * ks + 8 * fq) * 2);
            f32x4 at[4];
#pragma unroll
            for (int a = 0; a < 4; ++a) {
                f32x4 acc = (f32x4){0.f, 0.f, 0.f, 0.f};
#pragma unroll
                for (int ks = 0; ks < 4; ++ks) { const bf16x8 kf = *(const LAS bf16x8*)(Bk + (16 * a + fr) * GS_QSTR + (32 * ks + 8 * fq) * 2);
                    acc = __builtin_amdgcn_mfma_f32_16x16x32_bf16(kf, qf[ks], acc, 0, 0, 0); }
                const int ti = 16 * tb + fr;
#pragma unroll
                for (int r = 0; r < 4; ++r) { const int tj = 16 * a + 4 * fq + r; const bool keep = dir == 0 ? (tj <= ti) : (tj >= ti); acc[r] = keep ? acc[r] : 0.f; }
                at[a] = acc;
            }
            bf16x8 vf[2];
#pragma unroll
            for (int ks = 0; ks < 2; ++ks) { const LAS unsigned char* p = Bv + (32 * ks + 4 * fq + trq) * GS_VSTR + (16 * c + 4 * trp) * 2;
                vf[ks] = cat8(ds_tr16(p), ds_tr16(p + 16 * GS_VSTR)); }
            f32x4 o = (f32x4){0.f, 0.f, 0.f, 0.f};
#pragma unroll
            for (int ks = 0; ks < 2; ++ks) { u32x4 w; w.x = pk2(at[2 * ks][0], at[2 * ks][1]); w.y = pk2(at[2 * ks][2], at[2 * ks][3]); w.z = pk2(at[2 * ks + 1][0], at[2 * ks + 1][1]); w.w = pk2(at[2 * ks + 1][2], at[2 * ks + 1][3]);
                o = __builtin_amdgcn_mfma_f32_16x16x32_bf16(vf[ks], __builtin_bit_cast(bf16x8, w), o, 0, 0, 0); }
#pragma unroll
            for (int ks = 0; ks < 4; ++ks) { const bf16x8 sf = *(const LAS bf16x8*)(St + (16 * c + fr) * GS_QSTR + (32 * ks + 8 * fq) * 2);
                o = __builtin_amdgcn_mfma_f32_16x16x32_bf16(sf, qf[ks], o, 0, 0, 0); }
            { u32x2 w; w.x = pk2(o[0], o[1]); w.y = pk2(o[2], o[3]);
              *(u32x2*)(od + ((size_t)b * SEQ + (size_t)n * CH + 16 * tb + fr) * GV + 16 * c + 4 * fq) = w; }
#pragma unroll
            for (int ks = 0; ks < 2; ++ks) {
                const LAS unsigned char* p0 = Bk + (32 * ks + 4 * fq + trq) * GS_QSTR + (16 * T0 + 4 * trp) * 2;
                const bf16x8 k0 = cat8(ds_tr16(p0), ds_tr16(p0 + 16 * GS_QSTR));
                const bf16x8 k1 = cat8(ds_tr16(p0 + 32), ds_tr16(p0 + 32 + 16 * GS_QSTR));
                S0 = __builtin_amdgcn_mfma_f32_16x16x32_bf16(k0, vf[ks], S0, 0, 0, 0);
                S1 = __builtin_amdgcn_mfma_f32_16x16x32_bf16(k1, vf[ks], S1, 0, 0, 0);
            }
            S0 = S0 * dcur[0]; S1 = S1 * dcur[1];
            { u32x2 w0, w1; w0.x = pk2(S0[0], S0[1]); w0.y = pk2(S0[2], S0[3]); w1.x = pk2(S1[0], S1[1]); w1.y = pk2(S1[2], S1[3]);
              *(LAS u32x2*)(Stn + (16 * c + fr) * GS_QSTR + (16 * T0 + 4 * fq) * 2) = w0; *(LAS u32x2*)(Stn + (16 * c + fr) * GS_QSTR + (16 * T0 + 16 + 4 * fq) * 2) = w1; }
            if (s + 1 < NCH) { GS_COMMIT(cur ^ 1); dcur[0] = dnext[0]; dcur[1] = dnext[1]; }
        }
        asm volatile("s_waitcnt lgkmcnt(0)" ::: "memory"); __builtin_amdgcn_s_barrier(); asm volatile("" ::: "memory");
#undef GS_ISSUE
#undef GS_COMMIT
    }
}

__device__ __forceinline__ void gla_combine(bf16_t* of, const bf16_t* ob, const bf16_t* r, const float* og, int gw, int ngw, int lane) {
    for (int row = gw; row < M; row += ngw) {
        const size_t off = (size_t)row * GV + lane * 16;
        const u32x4 a0 = *(const u32x4*)(of + off), a1 = *(const u32x4*)(of + off + 8);
        const u32x4 b0 = *(const u32x4*)(ob + off), b1 = *(const u32x4*)(ob + off + 8);
        const u32x4 r0 = *(const u32x4*)(r + off), r1 = *(const u32x4*)(r + off + 8);
        float o[16], rr[16];
#pragma unroll
        for (int j = 0; j < 4; ++j) { o[2 * j] = bflo(a0[j]) + bflo(b0[j]); o[2 * j + 1] = bfhi(a0[j]) + bfhi(b0[j]); o[8 + 2 * j] = bflo(a1[j]) + bflo(b1[j]); o[8 + 2 * j + 1] = bfhi(a1[j]) + bfhi(b1[j]);
            rr[2 * j] = bflo(r0[j]); rr[2 * j + 1] = bfhi(r0[j]); rr[8 + 2 * j] = bflo(r1[j]); rr[8 + 2 * j + 1] = bfhi(r1[j]); }
        float ss = 0.f;
#pragma unroll
        for (int j = 0; j < 16; ++j) ss += o[j] * o[j];
        ss += __shfl_xor(ss, 1); ss += __shfl_xor(ss, 2); ss += __shfl_xor(ss, 4); ss += __shfl_xor(ss, 8);
        const float rs = 1.0f / sqrtf(ss * (1.0f / GDV) + EPS);
        const int dv0 = (lane & 15) * 16;
        float g[16];
#pragma unroll
        for (int j = 0; j < 16; ++j) { const float y = o[j] * rs * og[dv0 + j]; const float x = rr[j]; g[j] = y * x / (1.0f + __expf(-x)); }
        u32x4 w0, w1;
#pragma unroll
        for (int j = 0; j < 4; ++j) { w0[j] = pk2(g[2 * j], g[2 * j + 1]); w1[j] = pk2(g[8 + 2 * j], g[8 + 2 * j + 1]); }
        *(u32x4*)(of + off) = w0; *(u32x4*)(of + off + 8) = w1;
    }
}

struct Args { const float* in[15]; float* out; unsigned char* ws; int ph_lo, ph_hi; };
static_assert(sizeof(Args) == 15 * 8 + 8 + 8 + 8, "Args has no padding");

__global__ void __launch_bounds__(NTHREADS, 2) fwd_kernel(Args args) {
    extern __shared__ __attribute__((aligned(16))) unsigned char lds_raw[];
    LAS unsigned char* lds = (LAS unsigned char*)lds_raw;
    const int tid0 = threadIdx.x;
#define KARG_BASE() const __attribute__((address_space(4))) unsigned char* ka_ = (const __attribute__((address_space(4))) unsigned char*)__builtin_amdgcn_kernarg_segment_ptr(); asm volatile("" : "+s"(ka_))
#define IN_PTR(i) (*(const float* const __attribute__((address_space(4)))*)(ka_ + 8 * (i)))
#define OUT_PTR() (*(float* const __attribute__((address_space(4)))*)(ka_ + 8 * 15))
#define WS_PTR() (*(unsigned char* const __attribute__((address_space(4)))*)(ka_ + 8 * 16))
#define WSP(T, off) ((T*)(ws + (off)))
    for (int u = tid0; u < (LDS_BYTES - LDSCTL_OFF) / 4; u += NTHREADS) ((LAS unsigned*)(lds + LDSCTL_OFF))[u] = 0u;
    __syncthreads();
    volatile LAS unsigned* MISC = (volatile LAS unsigned*)(lds + MISC_OFF);
    const int lo = args.ph_lo, hi = args.ph_hi;
    const bool multi = (hi - lo) > 1;
    XcdBarrier bar; bar.bar = (unsigned*)(args.ws + WS_CTL) + 4096; bar.x = 0; bar.st = nullptr;
    if (multi) bar = xcd_barrier_post((unsigned*)(args.ws + WS_CTL) + 4096, MISC + 8);
#ifndef FAST_GEMM
#define FAST_GEMM 15
#endif
    bool rep_done = false;
    for (int ph = lo; ph < hi; ++ph) {
        int tid = threadIdx.x; asm volatile("" : "+v"(tid));
        int wg = blockIdx.x, G = gridDim.x; asm volatile("" : "+s"(wg), "+s"(G));
        const int lane = tid & 63, wave = __builtin_amdgcn_readfirstlane(tid >> 6);
        const int gw = wg * NWAVES + wave, ngw = G * NWAVES;
        switch (ph) {
        case 0: {
            KARG_BASE(); unsigned char* ws = WS_PTR();
            const float* x = IN_PTR(0); const float* norm_mix = IN_PTR(1); const float* norm_mlp = IN_PTR(2); const float* attn_w_qkv = IN_PTR(3); const float* attn_w_o = IN_PTR(6);
            const float* gla_w_in = IN_PTR(7); const float* gla_w_o = IN_PTR(11); const float* mlp_w_in = IN_PTR(12); const float* mlp_w_out = IN_PTR(13);
            bf16_t* Wqkv = WSP(bf16_t, W_QKV); bf16_t* Wo0 = WSP(bf16_t, W_O0); bf16_t* W1a = WSP(bf16_t, W_1A); bf16_t* W2a = WSP(bf16_t, W_2A);
            bf16_t* Wgin = WSP(bf16_t, W_GIN); bf16_t* Wo1 = WSP(bf16_t, W_O1); bf16_t* W1b = WSP(bf16_t, W_1B); bf16_t* W2b = WSP(bf16_t, W_2B);
            bf16_t* XB = WSP(bf16_t, WS_XB); float* SSQ0 = WSP(float, WS_SSQ); f32x2* ROPE = WSP(f32x2, WS_ROPE);
            LAS float* scr = (LAS float*)(lds + wave * 16384);
            constexpr int I_QKV = 16 * 48, I_O = 16 * 32, I_1 = 16 * 128, I_2 = 64 * 32, I_GIN = 16 * 97;
            constexpr int NITEMS = I_QKV + I_O + I_1 + I_2 + I_GIN + I_O + I_1 + I_2;
            for (int it = gw; it < NITEMS; it += ngw) {
                int r = it;
                if (r < I_QKV) { transpose_item(attn_w_qkv, norm_mix, D, QKV_N, Wqkv, scr, r, lane); continue; } r -= I_QKV;
                if (r < I_O) { transpose_item(attn_w_o, nullptr, D, D, Wo0, scr, r, lane); continue; } r -= I_O;
                if (r < I_1) { transpose_item(mlp_w_in, norm_mlp, D, FF, W1a, scr, r, lane); continue; } r -= I_1;
                if (r < I_2) { transpose_item(mlp_w_out, nullptr, FF, D, W2a, scr, r, lane); continue; } r -= I_2;
                if (r < I_GIN) { transpose_item(gla_w_in, norm_mix + D, D, GIN, Wgin, scr, r, lane); continue; } r -= I_GIN;
                if (r < I_O) { transpose_item(gla_w_o, nullptr, D, D, Wo1, scr, r, lane); continue; } r -= I_O;
                if (r < I_1) { transpose_item(mlp_w_in + (size_t)D * FF, norm_mlp + D, D, FF, W1b, scr, r, lane); continue; } r -= I_1;
                transpose_item(mlp_w_out + (size_t)FF * D, nullptr, FF, D, W2b, scr, r, lane);
            }
            for (int e = gw * 64 + lane; e < 32 * D / 8; e += ngw * 64) *(u32x4*)(Wgin + (size_t)GIN * D + (size_t)e * 8) = (u32x4){0u, 0u, 0u, 0u};
            for (int m = gw; m < M; m += ngw) {
                const f32x4* xr = (const f32x4*)(x + (size_t)m * D) + lane;
                f32x4 v[4]; float s = 0.f;
#pragma unroll
                for (int j = 0; j < 4; ++j) { v[j] = xr[64 * j]; s += (v[j].x * v[j].x + v[j].y * v[j].y) + (v[j].z * v[j].z + v[j].w * v[j].w); }
                s = wave_sum(s);
                u32x2* o8 = (u32x2*)(XB + (size_t)m * D) + lane;
#pragma unroll
                for (int j = 0; j < 4; ++j) { u32x2 w; w.x = pk2(v[j].x, v[j].y); w.y = pk2(v[j].z, v[j].w); o8[64 * j] = w; }
                if (lane < 16) SSQ0[(size_t)m * 16 + lane] = lane == 0 ? s : 0.f;
            }
            if (wg == 0) {
                for (int e = tid; e < 64 * 16; e += NTHREADS) {
                    const int pos = e >> 4, i = e & 15;
                    double invd = (i & 3) == 0 ? 1.0 : (i & 3) == 1 ? 0.56234132519034908 : (i & 3) == 2 ? 0.31622776601683794 : 0.17782794100389228;
                    invd *= (i >> 2) == 0 ? 1.0 : (i >> 2) == 1 ? 0.1 : (i >> 2) == 2 ? 0.01 : 0.001;
                    const float invf = (float)invd; const float ang = (float)pos * invf;
                    double s, c; sincos_d((double)ang, s, c);
                    ROPE[e] = (f32x2){(float)c, (float)s};
                }
            }
        } break;
        case 1: {
            KARG_BASE(); unsigned char* ws = WS_PTR(); const float* attn_qn = IN_PTR(4); const float* attn_kn = IN_PTR(5);
            const bf16_t* XB = WSP(bf16_t, WS_XB); const bf16_t* Wqkv = WSP(bf16_t, W_QKV); const float* SSQ0 = WSP(float, WS_SSQ); const f32x2* ROPE = WSP(f32x2, WS_ROPE);
            bf16_t* Qb = WSP(bf16_t, WS_BIG); bf16_t* Kb = WSP(bf16_t, WS_BIG + 32 * MiB); bf16_t* Vb = WSP(bf16_t, WS_BIG + 40 * MiB);
            if (FAST_GEMM & 1) { pg8::Gemm g{XB, Wqkv, M, QKV_N, D}; pg8::StaticOrder S; S.init(M, QKV_N, G, wg);
                pg8::EpiQKV8 E{SSQ0, attn_qn, attn_kn, ROPE, Qb, Kb, Vb};
                pg8::gemm_phase<pg8::EpiQKV8, pg8::StaticOrder, true, true>(lds, g, S, E, tid); }
            else { EpiQKV E{SSQ0, attn_qn, attn_kn, ROPE, Qb, Kb, Vb}; gemm_simple(XB, Wqkv, M, QKV_N, D, E, gw, ngw, lane); }
        } break;
        case 2: {
            KARG_BASE(); unsigned char* ws = WS_PTR();
            bf16_t* Qb = WSP(bf16_t, WS_BIG); bf16_t* Kb = WSP(bf16_t, WS_BIG + 32 * MiB); bf16_t* Vb = WSP(bf16_t, WS_BIG + 40 * MiB);
#ifndef FAST_ATTN
#define FAST_ATTN 1
#endif
            if (FAST_ATTN) {
                const attn_body::AttnTensors AT{(const attn_body::bf16*)Qb, (const attn_body::bf16*)Kb, (const attn_body::bf16*)Vb, (attn_body::bf16*)Qb};
                const attn_body::StaticOrder S(G, wg);
                attn_body::attn_phase<attn_body::StaticOrder>((char*)lds_raw, AT, S, tid);
            } else attn_simple(Qb, Kb, Vb, Qb, gw, ngw, lane);
        } break;
        case 3: case 5: case 10: case 12: {
            KARG_BASE(); unsigned char* ws = WS_PTR(); float* out = OUT_PTR();
            const bf16_t* A = WSP(bf16_t, ph == 10 ? WS_QK : WS_BIG);
            const bf16_t* Bt = WSP(bf16_t, ph == 3 ? W_O0 : ph == 5 ? W_2A : ph == 10 ? W_O1 : W_2B);
            const int K = (ph == 3 || ph == 10) ? D : FF;
            const float* base = ph == 3 ? IN_PTR(0) : out;
            bf16_t* xb = ph == 12 ? nullptr : WSP(bf16_t, WS_XB);
            float* ssq = ph == 12 ? nullptr : WSP(float, WS_SSQ + (ph == 3 ? 1 : ph == 5 ? 2 : 3) * (size_t)M * 64);
            if (FAST_GEMM & 2) { pg8::Gemm g{A, Bt, M, D, K}; pg8::StaticOrder S; S.init(M, D, G, wg);
                pg8::EpiRes8 E{base, out, xb, ssq};
                pg8::gemm_phase<pg8::EpiRes8, pg8::StaticOrder, true, true>(lds, g, S, E, tid); }
            else { EpiRes E{base, out, xb, ssq}; gemm_simple(A, Bt, M, D, K, E, gw, ngw, lane); }
        } break;
        case 4: case 11: {
            KARG_BASE(); unsigned char* ws = WS_PTR();
            const bf16_t* XB = WSP(bf16_t, WS_XB); bf16_t* HB = WSP(bf16_t, WS_BIG);
            const bf16_t* Bt = WSP(bf16_t, ph == 4 ? W_1A : W_1B); const float* ssq = WSP(float, WS_SSQ + (ph == 4 ? 1 : 3) * (size_t)M * 64);
            if (FAST_GEMM & 4) { pg8::Gemm g{XB, Bt, M, FF, D}; pg8::StaticOrder S; S.init(M, FF, G, wg);
                pg8::EpiUp8 E{ssq, HB};
                pg8::gemm_phase<pg8::EpiUp8, pg8::StaticOrder, true, true>(lds, g, S, E, tid); }
            else { EpiUp E{ssq, HB}; gemm_simple(XB, Bt, M, FF, D, E, gw, ngw, lane); }
        } break;
        case 6: {
            KARG_BASE(); unsigned char* ws = WS_PTR();
            const bf16_t* XB = WSP(bf16_t, WS_XB); const bf16_t* Wgin = WSP(bf16_t, W_GIN); const float* SSQ2 = WSP(float, WS_SSQ + 2 * (size_t)M * 64); float* Zb = WSP(float, WS_Z);
            bf16_t* Gv = WSP(bf16_t, WS_BIG); bf16_t* Gr = WSP(bf16_t, WS_BIG + 32 * MiB); bf16_t* Gq = WSP(bf16_t, WS_QK); bf16_t* Gk = WSP(bf16_t, WS_QK + 16 * MiB);
            if (FAST_GEMM & 8) { pg8::Gemm g{XB, Wgin, M, 3072, D}; pg8::StaticOrder S; S.init(M, 3072, G, wg);
                pg8::EpiGin8 E{SSQ2, Gq, Gk, Gv, Gr};
                pg8::gemm_phase<pg8::EpiGin8, pg8::StaticOrder, true, true>(lds, g, S, E, tid); }
            else { EpiGin E{SSQ2, Gq, Gk, Gv, Gr}; gemm_simple(XB, Wgin, M, 3072, D, E, gw, ngw, lane); }
            EpiZ Ez{SSQ2, Zb}; gemm_simple(XB, Wgin + (size_t)3072 * D, M, 64, D, Ez, gw, ngw, lane);
        } break;
        case 7: {
            KARG_BASE(); unsigned char* ws = WS_PTR();
            gla_pre(WSP(bf16_t, WS_QK), WSP(bf16_t, WS_QK + 16 * MiB), WSP(float, WS_Z), IN_PTR(8), IN_PTR(9), WSP(bf16_t, WS_BIG + 64 * MiB), WSP(bf16_t, WS_BIG + 96 * MiB), WSP(float, WS_DECAY), wg, G, tid);
        } break;
        case 8: {
            KARG_BASE(); unsigned char* ws = WS_PTR();
#ifndef FAST_SCAN
#define FAST_SCAN 1
#endif
            if (FAST_SCAN) gla_scan_mfma(WSP(bf16_t, WS_BIG + 64 * MiB), WSP(bf16_t, WS_BIG + 96 * MiB), WSP(bf16_t, WS_BIG), WSP(float, WS_DECAY), WSP(bf16_t, WS_QK), WSP(bf16_t, WS_XB), lds, wg, G, tid);
            else gla_scan_simple(WSP(bf16_t, WS_BIG + 64 * MiB), WSP(bf16_t, WS_BIG + 96 * MiB), WSP(bf16_t, WS_BIG), WSP(float, WS_DECAY), WSP(bf16_t, WS_QK), WSP(bf16_t, WS_XB), lds, wg, G, tid);
        } break;
        case 9: {
            KARG_BASE(); unsigned char* ws = WS_PTR();
            gla_combine(WSP(bf16_t, WS_QK), WSP(bf16_t, WS_XB), WSP(bf16_t, WS_BIG + 32 * MiB), IN_PTR(10), gw, ngw, lane);
        } break;
        default: {
            KARG_BASE(); float* out = OUT_PTR(); const float* final_norm = IN_PTR(14);
            for (int m = gw; m < M; m += ngw) {
                f32x4* xr = (f32x4*)(out + (size_t)m * D) + lane;
                f32x4 v[4]; float s = 0.f;
#pragma unroll
                for (int j = 0; j < 4; ++j) { v[j] = xr[64 * j]; s += (v[j].x * v[j].x + v[j].y * v[j].y) + (v[j].z * v[j].z + v[j].w * v[j].w); }
                s = wave_sum(s);
                const float rs = 1.0f / sqrtf(s * (1.0f / D) + EPS);
#pragma unroll
                for (int j = 0; j < 4; ++j) { const f32x4 g = *((const f32x4*)final_norm + lane + 64 * j); xr[64 * j] = v[j] * rs * g; }
            }
        } break;
        }
#ifndef REPEAT_MASK
#define REPEAT_MASK 0
#endif
        if (REPEAT_MASK && ((REPEAT_MASK >> ph) & 1) && !rep_done) { rep_done = true; xcd_barrier(bar); --ph; continue; }
        rep_done = false;
        if (ph + 1 < hi) xcd_barrier(bar);
    }
}

#ifndef MK_SINGLE
#define MK_SINGLE 1
#endif
extern "C" void kernel_launch(void* const* d_in, const int* in_sizes, int n_in, void* d_out, int out_size, void* d_ws, size_t ws_size, hipStream_t stream) {
    static int grid = 0;
    if (grid == 0) {
        if (n_in != 15 || in_sizes[0] != M * D || out_size != M * D || ws_size < WS_END) { fprintf(stderr, "kernel_launch: unexpected shapes (n_in %d, in0 %d, out %d, ws %zu)\n", n_in, n_in > 0 ? in_sizes[0] : -1, out_size, ws_size); grid = -1; return; }
        int dev = 0, cus = 0, per_cu = 0;
        if (hipGetDevice(&dev) != hipSuccess || hipDeviceGetAttribute(&cus, hipDeviceAttributeMultiprocessorCount, dev) != hipSuccess) { grid = -1; return; }
        if (hipFuncSetAttribute((const void*)fwd_kernel, hipFuncAttributeMaxDynamicSharedMemorySize, LDS_BYTES) != hipSuccess) { fprintf(stderr, "kernel_launch: hipFuncSetAttribute failed\n"); grid = -1; return; }
        if (hipOccupancyMaxActiveBlocksPerMultiprocessor(&per_cu, (const void*)fwd_kernel, NTHREADS, LDS_BYTES) != hipSuccess || per_cu < 1) { fprintf(stderr, "kernel_launch: occupancy query says %d\n", per_cu); }
        (void)hipGetLastError();
        grid = cus;
    }
    if (grid < 0) return;
    (void)hipMemsetAsync((char*)d_ws + WS_CTL, 0, CTL_ZERO_BYTES, stream);
    Args a{};
    for (int i = 0; i < 15; ++i) a.in[i] = (const float*)d_in[i];
    a.out = (float*)d_out; a.ws = (unsigned char*)d_ws;
#if MK_SINGLE
    a.ph_lo = 0; a.ph_hi = NPHASES;
    hipLaunchKernelGGL(fwd_kernel, dim3(grid), dim3(NTHREADS), LDS_BYTES, stream, a);
#else
    for (int p = 0; p < NPHASES; ++p) { a.ph_lo = p; a.ph_hi = p + 1; hipLaunchKernelGGL(fwd_kernel, dim3(grid), dim3(NTHREADS), LDS_BYTES, stream, a); }
#endif
}
```

```cpp
#include <hip/hip_runtime.h>
#include <cstdio>
#include <cstdint>
#include <hip/hip_bf16.h>
#include <cmath>

#define GAS __attribute__((address_space(1)))
#define LAS __attribute__((address_space(3)))
typedef unsigned short bf16_t;
typedef short bf16x8 __attribute__((ext_vector_type(8)));
typedef float f32x4 __attribute__((ext_vector_type(4)));
typedef float f32x2 __attribute__((ext_vector_type(2)));
typedef unsigned u32x4 __attribute__((ext_vector_type(4)));
typedef unsigned u32x2 __attribute__((ext_vector_type(2)));

constexpr int BATCH = 4, SEQ = 4096, D = 1024, M = BATCH * SEQ;
constexpr int NH = 16, NKV = 4, HD = 64, QKV_N = 1536, KVP = NKV * HD;
constexpr int GH = 4, GDK = 128, GDV = 256, GQK = 512, GV = 1024, RANK = 16, GIN = 3104, CH = 64, NCH = SEQ / CH;
constexpr int FF = 4096;
constexpr float EPS = 1e-6f;
constexpr float C2 = 0.125f * 1.4426950408889634f;
constexpr int NWAVES = 8, NTHREADS = 512;
constexpr int NPHASES = 14;

constexpr size_t MiB = 1u << 20;
constexpr size_t WS_CTL = 0, CTL_ZERO_BYTES = 1 * MiB;
constexpr size_t WS_ROPE = 1 * MiB;
constexpr size_t WS_SSQ = 2 * MiB;
constexpr size_t WS_Z = 7 * MiB;
constexpr size_t WS_DECAY = 11 * MiB;
constexpr size_t WS_W = 12 * MiB;
constexpr size_t W_QKV = WS_W, W_O0 = W_QKV + 3 * MiB, W_1A = W_O0 + 2 * MiB, W_2A = W_1A + 8 * MiB, W_GIN = W_2A + 8 * MiB,
                 W_O1 = W_GIN + 6 * MiB + 128 * 1024, W_1B = W_O1 + 2 * MiB, W_2B = W_1B + 8 * MiB, W_END = W_2B + 8 * MiB;
constexpr size_t WS_XB = 58 * MiB;
constexpr size_t WS_BIG = 90 * MiB;
constexpr size_t WS_QK = 218 * MiB;
constexpr size_t WS_END = 250 * MiB;
static_assert(W_END <= WS_XB, "weights fit");

__device__ __forceinline__ unsigned f2bf(float f) { unsigned u = __builtin_bit_cast(unsigned, f); return (u + 0x7fffu + ((u >> 16) & 1u)) >> 16; }
__device__ __forceinline__ unsigned pk2(float lo, float hi) { return f2bf(lo) | (f2bf(hi) << 16); }
__device__ __forceinline__ float bf2f(unsigned short u) { return __uint_as_float((unsigned)u << 16); }
__device__ __forceinline__ float bflo(unsigned w) { return __uint_as_float(w << 16); }
__device__ __forceinline__ float bfhi(unsigned w) { return __uint_as_float(w & 0xffff0000u); }
#define LDS_WAIT() asm volatile("s_waitcnt lgkmcnt(0)" ::: "memory")
#define VM_WAIT() asm volatile("s_waitcnt vmcnt(0)" ::: "memory")
__device__ __forceinline__ float wave_sum(float v) {
#pragma unroll
    for (int o = 1; o < 64; o <<= 1) v += __shfl_xor(v, o);
    return v;
}
__device__ __forceinline__ float rstd_from_slots(const float* ssq, int row) {
    const f32x4* p = (const f32x4*)(ssq + (size_t)row * 16);
    const f32x4 a = p[0], b = p[1], c = p[2], d = p[3];
    const float s = (((a.x + a.y) + (a.z + a.w)) + ((b.x + b.y) + (b.z + b.w))) + (((c.x + c.y) + (c.z + c.w)) + ((d.x + d.y) + (d.z + d.w)));
    return 1.0f / sqrtf(s * (1.0f / D) + EPS);
}

#define RLX_AGENT __ATOMIC_RELAXED, __HIP_MEMORY_SCOPE_AGENT
#define XB_TMO      128
#define XB_XCNT(j)  (256  + 64 * (j))
#define XB_XSUB(j)  (1280 + 64 * (j))
#define XB_XGEN(j)  (2304 + 64 * (j))
#define XB_TOP      3328
#define XB_TOPGEN   3392
#define XCD_BAR_WORDS 3456
#define XB_SPIN_CAP (1u << 22)
__device__ __forceinline__ unsigned xb_ld(unsigned* p)              { return __hip_atomic_load(p, __ATOMIC_RELAXED, __HIP_MEMORY_SCOPE_AGENT); }
__device__ __forceinline__ unsigned xb_add(unsigned* p, unsigned v) { return __hip_atomic_fetch_add(p, v, __ATOMIC_RELAXED, __HIP_MEMORY_SCOPE_AGENT); }
__device__ __forceinline__ unsigned xb_xcc_id() { return (unsigned)__builtin_amdgcn_s_getreg((3 << 11) | 20) & 0xFu; }
#define XB_SPIN(cond, bar) do { unsigned _sp = 0; while (cond) { __builtin_amdgcn_s_sleep(1); \
    if ((++_sp & 255u) == 0u) { if (xb_ld(&(bar)[XB_TMO])) break; if (_sp > XB_SPIN_CAP) { atomicAdd(&(bar)[XB_TMO], 1u); break; } } } } while (0)
struct XcdBarrier { unsigned* bar; unsigned x; volatile LAS unsigned* st; };
__device__ __forceinline__ XcdBarrier xcd_barrier_post(unsigned* bar, volatile LAS unsigned* st) {
    XcdBarrier b; b.bar = bar; b.x = xb_xcc_id(); b.st = st;
    if (threadIdx.x == 0) (void)xb_add(&bar[XB_XCNT(b.x)], 1u);
    return b;
}
__device__ __forceinline__ void xcd_barrier_complete(unsigned* bar, unsigned x, unsigned& nloc, unsigned& nx) {
    const unsigned G = gridDim.x * gridDim.y * gridDim.z;
    unsigned sum, cnt, mine, sp = 0u;
    for (;;) {
        sum = 0u; cnt = 0u; mine = 0u;
#pragma unroll
        for (unsigned j = 0; j < 16; ++j) { const unsigned c = xb_ld(&bar[XB_XCNT(j)]); sum += c; cnt += (c > 0u) ? 1u : 0u; mine = (j == x) ? c : mine; }
        if (sum == G) break;
        __builtin_amdgcn_s_sleep(1);
        if ((++sp & 255u) == 0u) { if (xb_ld(&bar[XB_TMO])) break; if (sp > XB_SPIN_CAP) { atomicAdd(&bar[XB_TMO], 1u); break; } }
    }
    nloc = mine > 0u ? mine : 1u; nx = cnt > 0u ? cnt : 1u;
}
__device__ __forceinline__ void xcd_barrier(const XcdBarrier& b) {
    asm volatile("s_waitcnt vmcnt(0)" ::: "memory");
    __syncthreads();
    if (threadIdx.x == 0) {
        unsigned* bar = b.bar;
        __builtin_amdgcn_s_waitcnt(0);
        unsigned nloc = b.st[0], nx = b.st[1];
        if (nloc == 0u) { xcd_barrier_complete(bar, b.x, nloc, nx); b.st[0] = nloc; b.st[1] = nx; }
        const unsigned old = xb_add(&bar[XB_XSUB(b.x)], 1u);
        const unsigned gen = old / nloc;
        if (old + 1u == (gen + 1u) * nloc) {
            __builtin_amdgcn_fence(__ATOMIC_RELEASE, "agent");
            asm volatile("s_waitcnt vmcnt(0)" ::: "memory");
            const unsigned og = xb_add(&bar[XB_TOP], 1u);
            const unsigned tg = og / nx;
            if (og + 1u == (tg + 1u) * nx) xb_add(&bar[XB_TOPGEN], 1u);
            else XB_SPIN(xb_ld(&bar[XB_TOPGEN]) == tg, bar);
            __builtin_amdgcn_fence(__ATOMIC_ACQUIRE, "agent");
            xb_add(&bar[XB_XGEN(b.x)], 1u);
            asm volatile("s_waitcnt vmcnt(0)" ::: "memory");
        } else {
            XB_SPIN(xb_ld(&bar[XB_XGEN(b.x)]) == gen, bar);
            __builtin_amdgcn_fence(__ATOMIC_ACQUIRE, "agent");
            asm volatile("s_waitcnt vmcnt(0)" ::: "memory");
        }
    }
    __syncthreads();
}

constexpr int RING_BYTES = 131072;
constexpr int LDSCTL_OFF = RING_BYTES, MISC_OFF = LDSCTL_OFF + 320;
constexpr int LDS_BYTES = 147456;

namespace pg8 {
#define PG8_LAS __attribute__((address_space(3)))
typedef unsigned short bf16_t;
typedef short bf16x8 __attribute__((ext_vector_type(8)));
typedef float f32x4 __attribute__((ext_vector_type(4)));
typedef unsigned u32x4 __attribute__((ext_vector_type(4)));
constexpr int BM = 256, BK = 64, HALF = 128, HTB = HALF * BK * 2  , STAGE_BYTES = 8 * HTB, NXCD = 8, WGM = 8;

__host__ __device__ __forceinline__ int lds_byte(int r, int c) { const int st = (r >> 4) * 2 + (c >> 5), rr = r & 15, cc = c & 31, ob = rr * 64 + cc * 2; return st * 1024 + (ob ^ (((ob >> 9) & 1) << 5)); }
__host__ __device__ __forceinline__ void stage_rc(int b, int& R, int& C) { const int st = b / 1024, sb = b % 1024, swz = sb ^ (((sb >> 9) & 1) << 5); R = (st >> 1) * 16 + swz / 64; C = (st & 1) * 32 + (swz % 64) / 2; }
__host__ __device__ __forceinline__ int perm32(int rho) { const int n = rho >> 4, i = rho & 15; return 8 * (i >> 2) + 4 * n + (i & 3); }

struct Unit { int pm, pn; };
struct Gemm { const bf16_t* A; const bf16_t* Bt; int M, N, K; };

struct StaticOrder {
    int nM, nN, nwg, G, c;
    __host__ __device__ void init(int M, int N, int G_, int c_) { nM = M / BM; nN = N / BM; nwg = nM * nN; G = G_; c = c_; }
    __host__ __device__ bool next(int i, Unit& u) const {
        const long L = (long)i * G + c; if (L >= nwg) return false;
        int wgid = (int)L; { const int q = nwg / NXCD, r = nwg % NXCD, xcd = wgid % NXCD, off = wgid / NXCD; wgid = (xcd < r ? xcd * (q + 1) : r * (q + 1) + (xcd - r) * q) + off; }
        const int nig = WGM * nN, gid = wgid / nig, fm = gid * WGM, gsz = (nM - fm) < WGM ? (nM - fm) : WGM;
        u.pm = fm + ((wgid % nig) % gsz); u.pn = (wgid % nig) / gsz; return true;
    }
    __device__ __forceinline__ void a_ready(const Unit&) const {}
    __device__ __forceinline__ void done(const Unit&) const {}
};
__device__ __forceinline__ unsigned cvt_pk_bf16(float lo, float hi) { unsigned r; asm volatile("v_cvt_pk_bf16_f32 %0, %1, %2" : "=v"(r) : "v"(lo), "v"(hi)); return r; }
typedef float f32x2 __attribute__((ext_vector_type(2)));
template <class Epi, class Sched, bool ALIGN_EPI = false, bool SP2 = false>
__device__ __forceinline__ void gemm_phase(PG8_LAS unsigned char* lds, const Gemm g, const Sched& S, const Epi& E, const int tid) {
    const int wid = __builtin_amdgcn_readfirstlane(tid >> 6), lane = tid & 63, wr = wid >> 2, wc = wid & 3, fr = lane & 15, fq = lane >> 4;
    const int K = g.K, nt = K / BK;
    unsigned voffA[2], voffB[2];
#pragma unroll
    for (int i = 0; i < 2; ++i) { int R, C; stage_rc(tid * 16 + i * 8192, R, C); const int Rb = Epi::BMODE == 1 ? ((R & ~31) + perm32(R & 31)) : Epi::BMODE == 2 ? (64 * (R >> 5) + (R & 31)) : R;
        voffA[i] = (unsigned)(R * K + C) * 2u; voffB[i] = (unsigned)(Rb * K + C) * 2u; }
    const size_t kstep = (size_t)(BK * 2);
    const size_t hstep = (size_t)HALF * K * 2;
    const size_t tstep = 2 * hstep;
    const size_t bhstep = Epi::BMODE == 2 ? (size_t)32 * K * 2 : hstep;
    const unsigned ldsw = (unsigned)wid * 1024u;
    const int aoff = lds_byte(wr * 64 + fr, fq * 8), boff = lds_byte(wc * 32 + fr, fq * 8);
#define PG8_SA(b, h) (((b) * 2 + (h)) * HTB)
#define PG8_SB(b, h) ((4 + (b) * 2 + (h)) * HTB)
#define PG8_STAGE(bufoff, gbase, voff) do { _Pragma("unroll") for (int _i = 0; _i < 2; ++_i) \
        __builtin_amdgcn_global_load_lds((const unsigned*)((const char*)(gbase) + (voff)[_i]), (PG8_LAS unsigned*)(lds + (bufoff) + ldsw + _i * 8192), 16, 0, 0); } while (0)
#define PG8_LDA(dst, b, h) do { _Pragma("unroll") for (int m = 0; m < 4; ++m) _Pragma("unroll") for (int k = 0; k < 2; ++k) dst[m][k] = *(const PG8_LAS bf16x8*)(lds + PG8_SA(b, h) + aoff + m * 2048 + k * 1024); } while (0)
#define PG8_LDB(dst, b, h) do { _Pragma("unroll") for (int n = 0; n < 2; ++n) _Pragma("unroll") for (int k = 0; k < 2; ++k) dst[n][k] = *(const PG8_LAS bf16x8*)(lds + PG8_SB(b, h) + boff + n * 2048 + k * 1024); } while (0)
#define PG8_MMA(ai, bj, At, Bt) do { __builtin_amdgcn_s_setprio(1); _Pragma("unroll") for (int m = 0; m < 4; ++m) _Pragma("unroll") for (int n = 0; n < 2; ++n) _Pragma("unroll") for (int k = 0; k < 2; ++k) \
        acc[ai][bj][m][n] = __builtin_amdgcn_mfma_f32_16x16x32_bf16(Bt[n][k], At[m][k], acc[ai][bj][m][n], 0, 0, 0); __builtin_amdgcn_s_setprio(0); } while (0)
#define PG8_WAIT_V(n) asm volatile("s_waitcnt vmcnt(" #n ")" ::: "memory")
#define PG8_WAIT_L(n) asm volatile("s_waitcnt lgkmcnt(" #n ")" ::: "memory")
#define PG8_BAR __builtin_amdgcn_s_barrier()
#define PG8_SCHED __builtin_amdgcn_sched_barrier(0)
    Unit cur, nxt; int ui = 0;
    if (!S.next(0, cur)) return;
    f32x4 acc[2][2][4][2];
#pragma unroll
    for (int a = 0; a < 2; ++a)
#pragma unroll
        for (int b = 0; b < 2; ++b)
#pragma unroll
            for (int m = 0; m < 4; ++m)
#pragma unroll
                for (int n = 0; n < 2; ++n) acc[a][b][m][n] = (f32x4){0.f, 0.f, 0.f, 0.f};
    bf16x8 At[4][2], B0[2][2], B1[2][2];
    const char* cA = (const char*)g.A + (size_t)cur.pm * tstep; const char* cB = (const char*)g.Bt + (size_t)cur.pn * tstep;
    S.a_ready(cur);
    if constexpr (SP2) {
        PG8_STAGE(PG8_SB(0, 0), cB, voffB); PG8_STAGE(PG8_SB(0, 1), cB + bhstep, voffB); PG8_STAGE(PG8_SA(0, 0), cA, voffA); PG8_STAGE(PG8_SA(0, 1), cA + hstep, voffA);
        if (wr == 1) PG8_BAR;
        PG8_WAIT_V(2); PG8_BAR;
        PG8_STAGE(PG8_SB(1, 0), cB + kstep, voffB); PG8_STAGE(PG8_SA(1, 0), cA + kstep, voffA); PG8_STAGE(PG8_SB(1, 1), cB + bhstep + kstep, voffB);
        PG8_WAIT_V(6); PG8_BAR;
    } else {
        PG8_STAGE(PG8_SB(0, 0), cB, voffB); PG8_STAGE(PG8_SA(0, 0), cA, voffA); PG8_STAGE(PG8_SB(0, 1), cB + bhstep, voffB); PG8_STAGE(PG8_SA(0, 1), cA + hstep, voffA);
        if (wr == 1) PG8_BAR;
        PG8_WAIT_V(4); PG8_BAR;
        PG8_STAGE(PG8_SB(1, 0), cB + kstep, voffB); PG8_STAGE(PG8_SA(1, 0), cA + kstep, voffA); PG8_STAGE(PG8_SB(1, 1), cB + bhstep + kstep, voffB);
        PG8_WAIT_V(6); PG8_BAR;
    }
    for (;;) {
        const bool has_next = S.next(ui + 1, nxt);
        const char* nA = has_next ? (const char*)g.A + (size_t)nxt.pm * tstep : cA; const char* nB = has_next ? (const char*)g.Bt + (size_t)nxt.pn * tstep : cB;
        for (int t = 0; t < nt; t += 2) {
            const bool last = (t == nt - 2);
            const char* a1 = cA + (size_t)(t + 1) * kstep;
            const char* a2 = last ? nA : cA + (size_t)(t + 2) * kstep; const char* b2 = last ? nB : cB + (size_t)(t + 2) * kstep;
            const char* a3 = a2 + kstep; const char* b3 = b2 + kstep;
            if (last && has_next) S.a_ready(nxt);
            if constexpr (SP2) {
            PG8_LDB(B0, 0, 0); PG8_LDB(B1, 0, 1); PG8_SCHED; PG8_LDA(At, 0, 0); PG8_STAGE(PG8_SA(1, 1), a1 + hstep, voffA);
            PG8_WAIT_V(8); PG8_WAIT_L(0); PG8_BAR; PG8_MMA(0, 0, At, B0); PG8_MMA(0, 1, At, B1); PG8_BAR; PG8_SCHED;
            PG8_LDA(At, 0, 1); PG8_STAGE(PG8_SB(0, 0), b2, voffB); PG8_STAGE(PG8_SB(0, 1), b2 + bhstep, voffB); PG8_STAGE(PG8_SA(0, 0), a2, voffA);
            PG8_WAIT_V(8); PG8_WAIT_L(0); PG8_BAR; PG8_MMA(1, 0, At, B0); PG8_MMA(1, 1, At, B1); PG8_BAR; PG8_SCHED;
            PG8_LDB(B0, 1, 0); PG8_LDB(B1, 1, 1); PG8_SCHED; PG8_LDA(At, 1, 0); PG8_STAGE(PG8_SA(0, 1), a2 + hstep, voffA);
            PG8_WAIT_V(8); PG8_WAIT_L(0); PG8_BAR; PG8_MMA(0, 0, At, B0); PG8_MMA(0, 1, At, B1); PG8_BAR; PG8_SCHED;
            PG8_LDA(At, 1, 1); PG8_STAGE(PG8_SB(1, 0), b3, voffB); PG8_STAGE(PG8_SB(1, 1), b3 + bhstep, voffB); PG8_STAGE(PG8_SA(1, 0), a3, voffA);
            PG8_WAIT_V(8); PG8_WAIT_L(0); PG8_BAR; PG8_MMA(1, 0, At, B0); PG8_MMA(1, 1, At, B1); PG8_BAR; PG8_SCHED;
            } else {
            PG8_LDB(B0, 0, 0); PG8_SCHED; PG8_LDA(At, 0, 0); PG8_STAGE(PG8_SA(1, 1), a1 + hstep, voffA);
            PG8_WAIT_L(8); PG8_BAR; PG8_WAIT_L(0); PG8_MMA(0, 0, At, B0); PG8_BAR; PG8_SCHED;
            PG8_LDB(B1, 0, 1); PG8_STAGE(PG8_SB(0, 0), b2, voffB);
            PG8_BAR; PG8_WAIT_L(0); PG8_MMA(0, 1, At, B1); PG8_BAR;
            PG8_LDA(At, 0, 1); PG8_STAGE(PG8_SA(0, 0), a2, voffA);
            PG8_BAR; PG8_WAIT_L(0); PG8_MMA(1, 0, At, B0); PG8_BAR; PG8_SCHED;
            PG8_STAGE(PG8_SB(0, 1), b2 + bhstep, voffB);
            PG8_WAIT_V(6); PG8_BAR; PG8_MMA(1, 1, At, B1); PG8_BAR;
            PG8_LDB(B0, 1, 0); PG8_SCHED; PG8_LDA(At, 1, 0); PG8_STAGE(PG8_SA(0, 1), a2 + hstep, voffA);
            PG8_WAIT_L(8); PG8_BAR; PG8_WAIT_L(0); PG8_MMA(0, 0, At, B0); PG8_BAR; PG8_SCHED;
            PG8_LDB(B1, 1, 1); PG8_STAGE(PG8_SB(1, 0), b3, voffB);
            PG8_BAR; PG8_WAIT_L(0); PG8_MMA(0, 1, At, B1); PG8_BAR;
            PG8_LDA(At, 1, 1); PG8_STAGE(PG8_SA(1, 0), a3, voffA);
            PG8_BAR; PG8_WAIT_L(0); PG8_MMA(1, 0, At, B0); PG8_BAR; PG8_SCHED;
            PG8_STAGE(PG8_SB(1, 1), b3 + bhstep, voffB);
            PG8_WAIT_V(6); PG8_BAR; PG8_MMA(1, 1, At, B1); PG8_BAR;
            }
        }
        if constexpr (ALIGN_EPI) { if (wr == 0) PG8_BAR; }
        if constexpr (!Epi::AFTER_DRAIN) { E(acc, cur, wr, wc, fr, fq); S.done(cur); }
        if (!has_next) break;
#pragma unroll
        for (int a = 0; a < 2; ++a)
#pragma unroll
            for (int b = 0; b < 2; ++b)
#pragma unroll
                for (int m = 0; m < 4; ++m)
#pragma unroll
                    for (int n = 0; n < 2; ++n) acc[a][b][m][n] = (f32x4){0.f, 0.f, 0.f, 0.f};
        cur = nxt; cA = nA; cB = nB; ++ui;
        if constexpr (ALIGN_EPI) { if (wr == 1) PG8_BAR; }
    }
    PG8_WAIT_V(0);
    if constexpr (!ALIGN_EPI) { if (wr == 0) PG8_BAR; }
    PG8_BAR;
    if constexpr (Epi::AFTER_DRAIN) { E.fused(acc, cur, wr, wc, fr, fq, lds, wid, lane); S.done(cur); }
#undef PG8_SA
#undef PG8_SB
#undef PG8_STAGE
#undef PG8_LDA
#undef PG8_LDB
#undef PG8_MMA
#undef PG8_WAIT_V
#undef PG8_WAIT_L
#undef PG8_BAR
#undef PG8_SCHED
}
}

namespace pg8 {
typedef unsigned u32x2 __attribute__((ext_vector_type(2)));
struct EpiQKV8 {
    static constexpr int BMODE = 2; static constexpr bool PERM = false, AFTER_DRAIN = false;
    const float* ssq; const float* qg; const float* kg; const ::f32x2* rope; bf16_t* Q; bf16_t* Kb; bf16_t* Vb;
    __device__ __forceinline__ void operator()(const f32x4 (&acc)[2][2][4][2], const Unit& u, int wr, int wc, int fr, int fq) const {
        const int pn = u.pn;
#pragma unroll
        for (int ai = 0; ai < 2; ++ai)
#pragma unroll
            for (int m = 0; m < 4; ++m) {
                const int row = u.pm * BM + ai * HALF + wr * 64 + m * 16 + fr; const float rs = rstd_from_slots(ssq, row);
                f32x4 v[2][2];
#pragma unroll
                for (int bj = 0; bj < 2; ++bj)
#pragma unroll
                    for (int n = 0; n < 2; ++n) v[bj][n] = acc[ai][bj][m][n] * rs;
                if (pn < 5) {
                    const bool isq = pn < 4; const float* g = isq ? qg : kg;
                    float ss = 0.f;
#pragma unroll
                    for (int bj = 0; bj < 2; ++bj)
#pragma unroll
                        for (int n = 0; n < 2; ++n) ss += (v[bj][n].x * v[bj][n].x + v[bj][n].y * v[bj][n].y) + (v[bj][n].z * v[bj][n].z + v[bj][n].w * v[bj][n].w);
                    ss += __shfl_xor(ss, 16); ss += __shfl_xor(ss, 32);
                    const float r = 1.0f / sqrtf(ss * (1.0f / 64.0f) + EPS);
#pragma unroll
                    for (int bj = 0; bj < 2; ++bj)
#pragma unroll
                        for (int n = 0; n < 2; ++n) { const f32x4 gv = *(const f32x4*)(g + 32 * bj + 16 * n + 4 * fq); v[bj][n] = v[bj][n] * r * gv; }
                    const int t = row % SEQ, prow = t >> 6, pcol = t & 63;
                    const float sc = isq ? C2 : 1.0f;
#pragma unroll
                    for (int bj = 0; bj < 2; ++bj) {
                        const int pos = bj == 0 ? prow : pcol;
                        const f32x4 cs01 = *(const f32x4*)(rope + pos * 16 + 4 * fq), cs23 = *(const f32x4*)(rope + pos * 16 + 4 * fq + 2);
                        const float cc[4] = {cs01.x, cs01.z, cs23.x, cs23.z}, sn[4] = {cs01.y, cs01.w, cs23.y, cs23.w};
                        const f32x4 x1 = v[bj][0], x2 = v[bj][1]; f32x4 o1, o2;
#pragma unroll
                        for (int j = 0; j < 4; ++j) { o1[j] = (x1[j] * cc[j] - x2[j] * sn[j]) * sc; o2[j] = (x2[j] * cc[j] + x1[j] * sn[j]) * sc; }
                        v[bj][0] = o1; v[bj][1] = o2;
                    }
                }
                bf16_t* dst = pn < 4 ? Q + (size_t)row * D + pn * 256 + wc * 64 : pn == 4 ? Kb + (size_t)row * KVP + wc * 64 : Vb + (size_t)row * KVP + wc * 64;
#pragma unroll
                for (int bj = 0; bj < 2; ++bj)
#pragma unroll
                    for (int n = 0; n < 2; ++n) { u32x2 w; w.x = cvt_pk_bf16(v[bj][n].x, v[bj][n].y); w.y = cvt_pk_bf16(v[bj][n].z, v[bj][n].w); *(u32x2*)(dst + 32 * bj + 16 * n + 4 * fq) = w; }
            }
    }
};
struct EpiRes8 {
    static constexpr int BMODE = 0; static constexpr bool PERM = false, AFTER_DRAIN = false;
    const float* base; float* out; bf16_t* xb; float* ssq;
    __device__ __forceinline__ void operator()(const f32x4 (&acc)[2][2][4][2], const Unit& u, int wr, int wc, int fr, int fq) const {
        const int col0 = u.pn * BM + wc * 32 + 4 * fq;
#pragma unroll
        for (int ai = 0; ai < 2; ++ai)
#pragma unroll
            for (int m = 0; m < 4; ++m) {
                const int row = u.pm * BM + ai * HALF + wr * 64 + m * 16 + fr; float ss = 0.f;
#pragma unroll
                for (int bj = 0; bj < 2; ++bj)
#pragma unroll
                    for (int n = 0; n < 2; ++n) { const size_t off = (size_t)row * D + col0 + bj * HALF + n * 16;
                        const f32x4 h = *(const f32x4*)(base + off) + acc[ai][bj][m][n]; *(f32x4*)(out + off) = h;
                        ss += (h.x * h.x + h.y * h.y) + (h.z * h.z + h.w * h.w);
                        if (xb) { u32x2 w; w.x = cvt_pk_bf16(h.x, h.y); w.y = cvt_pk_bf16(h.z, h.w); *(u32x2*)(xb + off) = w; } }
                ss += __shfl_xor(ss, 16); ss += __shfl_xor(ss, 32);
                if (ssq && fq == 0) ssq[(size_t)row * 16 + u.pn * 4 + wc] = ss;
                asm volatile("" ::: "memory");
            }
    }
};
struct EpiUp8 {
    static constexpr int BMODE = 1; static constexpr bool PERM = true, AFTER_DRAIN = false;
    const float* ssq; bf16_t* HB;
    __device__ __forceinline__ void operator()(const f32x4 (&acc)[2][2][4][2], const Unit& u, int wr, int wc, int fr, int fq) const {
        const int col0 = u.pn * BM + wc * 32 + 8 * fq;
#pragma unroll
        for (int ai = 0; ai < 2; ++ai)
#pragma unroll
            for (int m = 0; m < 4; ++m) {
                const int row = u.pm * BM + ai * HALF + wr * 64 + m * 16 + fr; const float rs = rstd_from_slots(ssq, row);
                bf16_t* rowp = HB + (size_t)row * FF + col0;
#pragma unroll
                for (int bj = 0; bj < 2; ++bj) { f32x4 v0 = acc[ai][bj][m][0] * rs, v1 = acc[ai][bj][m][1] * rs;
#pragma unroll
                    for (int j = 0; j < 4; ++j) { const float a = fmaxf(v0[j], 0.f), b = fmaxf(v1[j], 0.f); v0[j] = a * a; v1[j] = b * b; }
                    u32x4 w; w.x = cvt_pk_bf16(v0[0], v0[1]); w.y = cvt_pk_bf16(v0[2], v0[3]); w.z = cvt_pk_bf16(v1[0], v1[1]); w.w = cvt_pk_bf16(v1[2], v1[3]);
                    *(u32x4*)(rowp + bj * HALF) = w; }
            }
    }
};
struct EpiGin8 {
    static constexpr int BMODE = 1; static constexpr bool PERM = true, AFTER_DRAIN = false;
    const float* ssq; bf16_t* q; bf16_t* k; bf16_t* v; bf16_t* r;
    __device__ __forceinline__ void operator()(const f32x4 (&acc)[2][2][4][2], const Unit& u, int wr, int wc, int fr, int fq) const {
        const int pn = u.pn;
        bf16_t* basep; int ld, ct; float sc = 1.0f;
        if (pn < 2) { basep = q; ld = GQK; ct = pn; sc = 0.08838834764831845f; } else if (pn < 4) { basep = k; ld = GQK; ct = pn - 2; } else if (pn < 8) { basep = v; ld = GV; ct = pn - 4; } else { basep = r; ld = GV; ct = pn - 8; }
        const int col0 = ct * BM + wc * 32 + 8 * fq;
#pragma unroll
        for (int ai = 0; ai < 2; ++ai)
#pragma unroll
            for (int m = 0; m < 4; ++m) {
                const int row = u.pm * BM + ai * HALF + wr * 64 + m * 16 + fr; const float rs = rstd_from_slots(ssq, row) * sc;
                bf16_t* rowp = basep + (size_t)row * ld + col0;
#pragma unroll
                for (int bj = 0; bj < 2; ++bj) { const f32x4 v0 = acc[ai][bj][m][0] * rs, v1 = acc[ai][bj][m][1] * rs;
                    u32x4 w; w.x = cvt_pk_bf16(v0[0], v0[1]); w.y = cvt_pk_bf16(v0[2], v0[3]); w.z = cvt_pk_bf16(v1[0], v1[1]); w.w = cvt_pk_bf16(v1[2], v1[3]);
                    *(u32x4*)(rowp + bj * HALF) = w; }
            }
    }
};
}

namespace attn_body {
using bf16=__hip_bfloat16;
using bf16x8=__attribute__((ext_vector_type(8)))short;
using s16x4=__attribute__((ext_vector_type(4)))short;
using f32x16=__attribute__((ext_vector_type(16)))float;
using u32x4=__attribute__((ext_vector_type(4)))unsigned;
constexpr int BATCH=4,NHEAD=16,SEQ=4096,D=64,DM=NHEAD*D,KVP=256;
constexpr int NW=8,QBLK=32,QB=QBLK*NW,KVBLK=64,NQB=SEQ/QB;
constexpr int ATTN_PITCH=DM, ATTN_UNIT_ROWS=QB;
__device__ __forceinline__ int crow(int r,int hi){return (r&3)+8*(r>>2)+4*hi;}
#define SBAR() __builtin_amdgcn_sched_barrier(0)
__device__ __forceinline__ void cmask(f32x16&p0,f32x16&p1,int jb,int qrel,int hi){
  const float NEG=-INFINITY; int kb=64*jb+4*hi;
  #pragma unroll
  for(int r=0;r<16;++r){int kv=kb+(r&3)+8*(r>>2); if(kv>qrel)p0[r]=NEG; if(kv+32>qrel)p1[r]=NEG;}
}

constexpr int NSLOT=3, SLOTB=8192;
constexpr int LDS_K=0, LDS_V=NSLOT*SLOTB, LDS_WS=2*NSLOT*SLOTB, LDS_OST=LDS_WS+NW*64*4, LDS_BYTES=LDS_OST+NW*4096;
constexpr float C2=0.125f*1.4426950408889634f;
__device__ __forceinline__ void glds16(const void*gsrc,unsigned lds_dst){unsigned keep;
  asm volatile("s_mov_b32 %0, m0\n\ts_mov_b32 m0, %2\n\ts_nop 0\n\tglobal_load_lds_dwordx4 %1, off\n\ts_mov_b32 m0, %0":"=&s"(keep):"v"(gsrc),"s"(lds_dst):"memory");}
__device__ __forceinline__ float max3f(float a,float b,float c){float r;asm("v_max3_f32 %0, %1, %2, %3":"=v"(r):"v"(a),"v"(b),"v"(c));return r;}
__device__ __forceinline__ float max2f(float a,float b){float r;asm("v_max_f32_e32 %0, %1, %2":"=v"(r):"v"(a),"v"(b));return r;}
__device__ __forceinline__ float fadd_s(float a,float b){float r;asm("v_add_f32_e32 %0, %1, %2":"=v"(r):"v"(a),"v"(b));return r;}
__device__ __forceinline__ float fsub_s(float a,float b){float r;asm("v_sub_f32_e32 %0, %1, %2":"=v"(r):"v"(a),"v"(b));return r;}
typedef float f32x2_t __attribute__((ext_vector_type(2))); typedef __bf16 bf16x2_t __attribute__((ext_vector_type(2)));
__device__ __forceinline__ unsigned cvtpk_s(float lo,float hi){f32x2_t v={lo,hi};bf16x2_t b=__builtin_convertvector(v,bf16x2_t);return __builtin_bit_cast(unsigned,b);}
#define WAIT_BAR(N) asm volatile("s_waitcnt vmcnt(" #N ") lgkmcnt(0)\n\ts_barrier":::"memory")

__device__ __forceinline__ void qkt(f32x16&p0,f32x16&p1,const char*Kslot,const bf16x8*qr,const f32x16&negm,int r32,int hi){
  const char*kb=Kslot+hi*1024+r32*16;
  #pragma unroll
  for(int d0=0;d0<4;++d0){
    const bf16x8 b0=*reinterpret_cast<const bf16x8*>(kb+d0*2048);
    const bf16x8 b1=*reinterpret_cast<const bf16x8*>(kb+d0*2048+512);
    if(d0==0){p0=__builtin_amdgcn_mfma_f32_32x32x16_bf16(b0,qr[0],negm,0,0,0);p1=__builtin_amdgcn_mfma_f32_32x32x16_bf16(b1,qr[0],negm,0,0,0);}
    else{p0=__builtin_amdgcn_mfma_f32_32x32x16_bf16(b0,qr[d0],p0,0,0,0);p1=__builtin_amdgcn_mfma_f32_32x32x16_bf16(b1,qr[d0],p1,0,0,0);}}
}
typedef __attribute__((address_space(3))) const char* lds_cptr;
typedef short v4i16_t __attribute__((ext_vector_type(4)));
__device__ __forceinline__ void kload8(bf16x8*kf,lds_cptr kp){
  kf[0]=*(const __attribute__((address_space(3))) bf16x8*)(kp);      kf[1]=*(const __attribute__((address_space(3))) bf16x8*)(kp+512);
  kf[2]=*(const __attribute__((address_space(3))) bf16x8*)(kp+2048); kf[3]=*(const __attribute__((address_space(3))) bf16x8*)(kp+2560);
  kf[4]=*(const __attribute__((address_space(3))) bf16x8*)(kp+4096); kf[5]=*(const __attribute__((address_space(3))) bf16x8*)(kp+4608);
  kf[6]=*(const __attribute__((address_space(3))) bf16x8*)(kp+6144); kf[7]=*(const __attribute__((address_space(3))) bf16x8*)(kp+6656);
}
__device__ __forceinline__ void kload2(bf16x8*kf,lds_cptr kp,int j){ kf[2*j]=*(const __attribute__((address_space(3))) bf16x8*)(kp+j*2048); kf[2*j+1]=*(const __attribute__((address_space(3))) bf16x8*)(kp+j*2048+512); }
__device__ __forceinline__ s16x4 vtr(lds_cptr p){ return __builtin_bit_cast(s16x4,__builtin_amdgcn_ds_read_tr16_b64_v4i16((__attribute__((address_space(3))) v4i16_t*)p)); }
__device__ __forceinline__ float rowmax(const f32x16&p0,const f32x16&p1){
  float a=max3f(p0[0],p0[1],p1[0]),b=max3f(p0[2],p0[3],p1[1]);a=max3f(a,p1[2],p1[3]);
  #pragma unroll
  for(int r=4;r<16;r+=4){a=max3f(a,p0[r],p0[r+1]);b=max3f(b,p0[r+2],p0[r+3]);a=max3f(a,p1[r],p1[r+1]);b=max3f(b,p1[r+2],p1[r+3]);}
  const float m=max2f(a,b);
  auto rr=__builtin_amdgcn_permlane32_swap(__float_as_uint(m),__float_as_uint(m),false,false);
  return max2f(__uint_as_float(rr[0]),__uint_as_float(rr[1]));
}
__device__ __forceinline__ void pv(f32x16*o,int vb,bf16x8 pa0,bf16x8 pa1,bf16x8 pa2,bf16x8 pa3){
  #pragma unroll
  for(int d0=0;d0<2;++d0){s16x4 lo[4],hi[4];
    #pragma unroll
    for(int ks=0;ks<4;++ks){
      asm volatile("ds_read_b64_tr_b16 %0,%1 offset:%c2":"=&v"(lo[ks]):"v"(vb),"i"(d0*4096+ks*1024):"memory");
      asm volatile("ds_read_b64_tr_b16 %0,%1 offset:%c2":"=&v"(hi[ks]):"v"(vb),"i"(d0*4096+ks*1024+512):"memory");}
    asm volatile("s_waitcnt lgkmcnt(0)":::"memory");SBAR();
    #define PK(k) (bf16x8){lo[k][0],lo[k][1],lo[k][2],lo[k][3],hi[k][0],hi[k][1],hi[k][2],hi[k][3]}
    o[d0]=__builtin_amdgcn_mfma_f32_32x32x16_bf16(pa0,PK(0),o[d0],0,0,0);
    o[d0]=__builtin_amdgcn_mfma_f32_32x32x16_bf16(pa1,PK(1),o[d0],0,0,0);
    o[d0]=__builtin_amdgcn_mfma_f32_32x32x16_bf16(pa2,PK(2),o[d0],0,0,0);
    o[d0]=__builtin_amdgcn_mfma_f32_32x32x16_bf16(pa3,PK(3),o[d0],0,0,0);
    #undef PK
  }
}

#ifndef ATTN_STORE16
#define ATTN_STORE16(p,v) (*(u32x4*)(p)=(v))
#endif
template<int THRL> __device__ __forceinline__ void attn_unit(int b,int h,int qb,const bf16*Q,const bf16*__restrict__ K,const bf16*__restrict__ V,bf16*O,char*shm,const int tid){
  const int lane=tid&63,r32=lane&31,hi=lane>>5; const int wid=__builtin_amdgcn_readfirstlane(tid>>6);
  const long rowbase=(long)b*SEQ; const int q0=qb*QB;
  const bf16*Qw=Q+(rowbase+q0+wid*QBLK)*DM+h*D;
  const bf16*Kh=K+rowbase*KVP+(h>>2)*D,*Vh=V+rowbase*KVP+(h>>2)*D;
  const unsigned lds0=(unsigned)(uintptr_t)shm;
  float*wsf=(float*)(shm+LDS_WS)+wid*64;
  const bf16*ksrc=Kh+(long)lane*KVP+wid*8;
  const bf16*vsrc=Vh+(long)(16*(wid&3)+(lane>>2))*KVP+(wid>>2)*32+(lane&3)*8;
  const unsigned kdst=lds0+LDS_K+wid*1024, vdst=lds0+LDS_V+wid*1024;
  #define DMA_K(t,slot) glds16(ksrc+(long)(t)*KVBLK*KVP,(unsigned)__builtin_amdgcn_readfirstlane(kdst+(slot)))
  #define DMA_V(t,slot) glds16(vsrc+(long)(t)*KVBLK*KVP,(unsigned)__builtin_amdgcn_readfirstlane(vdst+(slot)))
  const int vb0=(int)(lds0+LDS_V)+((lane>>4)&1)*32+(lane&3)*8+(4*hi+((lane&15)>>2))*64;
  const char*Kbase=shm+LDS_K; bf16x8 kf[8];
  const lds_cptr shm3=(lds_cptr)shm; const lds_cptr kp0=shm3+LDS_K+hi*1024+r32*16; const lds_cptr vp0=shm3+LDS_V+((lane>>4)&1)*32+(lane&3)*8+(4*hi+((lane&15)>>2))*64;
  const int NT=SEQ/KVBLK;
  DMA_K(0,0);DMA_V(0,0);DMA_K(1,SLOTB);
  bf16x8 qr[4];
  #pragma unroll
  for(int d0=0;d0<4;++d0)qr[d0]=*reinterpret_cast<const bf16x8*>(&Qw[(long)r32*DM+d0*16+hi*8]);
  float mhat=0.f,l_reg=0.f;f32x16 o[2];o[0]=f32x16{};o[1]=f32x16{};f32x16 negm=f32x16{};asm volatile("":"+v"(negm));
  const int qrel=wid*QBLK+r32;
  #define CMASK(P0,P1,t) do{}while(0)
  bool resc=false;
  #define START(P0,P1) do{ const float rm=rowmax(P0,P1); resc=false; \
    { const float dl=rm; mhat=fadd_s(mhat,dl); \
      _Pragma("unroll") for(int r=0;r<16;++r){P0[r]=fsub_s(P0[r],dl);P1[r]=fsub_s(P1[r],dl);} \
      _Pragma("unroll") for(int r=0;r<16;++r)negm[r]=-mhat; asm volatile("":"+v"(negm)); } \
    _Pragma("unroll") for(int r=0;r<16;++r)P0[r]=__builtin_amdgcn_exp2f(P0[r]); }while(0)
  #define RESC() do{ if(resc){ asm volatile("s_waitcnt lgkmcnt(0)":::"memory"); \
      _Pragma("unroll") for(int d_=0;d_<2;++d_) _Pragma("unroll") for(int r=0;r<16;++r)o[d_][r]*=wsf[crow(r,hi)]; } }while(0)
  f32x16 pA0,pA1,pB0,pB1;
  int sl_prev=0,sl_cur=0,sl_next=SLOTB;
  #define ROT() do{sl_prev=sl_cur;sl_cur=sl_next;sl_next=(sl_next==(NSLOT-1)*SLOTB)?0:sl_next+SLOTB;}while(0)
  DMA_K(2,2*SLOTB);
  WAIT_BAR(3);
  qkt(pA0,pA1,Kbase,qr,negm,r32,hi);asm volatile("s_nop 15\n\ts_nop 7":"+v"(pA0),"+v"(pA1));CMASK(pA0,pA1,0);
  START(pA0,pA1);
  _Pragma("unroll") for(int r=0;r<16;++r)pA1[r]=__builtin_amdgcn_exp2f(pA1[r]);
  WAIT_BAR(0);
  DMA_K(3,0);DMA_V(1,SLOTB);
  ROT();
  kload8(kf,kp0+sl_cur);
  WAIT_BAR(2);
  s16x4 vlo[8],vhi[8]; u32x4 pw0,pw1,pw2,pw3;
  #define PKW(P,B) cvtpk_s(P[B],P[B+1])
  #define PAF(k) __builtin_bit_cast(bf16x8,pw##k)
  #define VFR(i) (bf16x8){vlo[i][0],vlo[i][1],vlo[i][2],vlo[i][3],vhi[i][0],vhi[i][1],vhi[i][2],vhi[i][3]}
  #define PIN(x) asm volatile("":"+v"(x))
  #define MX3(a,b,c) __builtin_fmaxf(__builtin_fmaxf((a),(b)),(c))
  #define GAPA(MF,A0,A1,A2,A3,W0,W1,PW) do{ MF; sacc+=A0; sacc+=A1; sacc+=A2; sacc+=A3; PIN(sacc); W0; W1; PIN(PW); SBAR(); }while(0)
  #define EX(v) __builtin_amdgcn_exp2f(v)
  #define GAPB(MF,X,B) do{ MF; X[B]=EX(X[B]); X[B+1]=EX(X[B+1]); X[B+2]=EX(X[B+2]); X[B+3]=EX(X[B+3]); PIN(X); SBAR(); }while(0)
  #define VRD(i) do{ vlo[i]=vtr(vp_+(((i)>>2)*4096+((i)&3)*1024)); vhi[i]=vtr(vp_+(((i)>>2)*4096+((i)&3)*1024+512)); }while(0)
  #define KRD(G,j) do{ if(G){ kload2(kf,kp0+sl_next,j); SBAR(); } }while(0)
  #define STEP(C0,C1,P0,P1,t,GK,GV,GL) do{ SBAR(); \
    const lds_cptr vp_=vp0+sl_prev; \
    VRD(0); SBAR(); float sacc=(P0[0]+P0[1]); \
    GAPA(C0=__builtin_amdgcn_mfma_f32_32x32x16_bf16(kf[0],qr[0],negm,0,0,0), P0[2],P0[3],P0[4],P0[5],     pw0[0]=PKW(P0,0), pw0[1]=PKW(P0,2), pw0); \
    VRD(4); SBAR(); GAPA(C1=__builtin_amdgcn_mfma_f32_32x32x16_bf16(kf[1],qr[0],negm,0,0,0), P0[6],P0[7],P0[8],P0[9],     pw0[2]=PKW(P0,4), pw0[3]=PKW(P0,6), pw0); \
    VRD(1); SBAR(); GAPA(C0=__builtin_amdgcn_mfma_f32_32x32x16_bf16(kf[2],qr[1],C0,0,0,0),   P0[10],P0[11],P0[12],P0[13], pw1[0]=PKW(P0,8), pw1[1]=PKW(P0,10), pw1); \
    VRD(5); SBAR(); GAPA(C1=__builtin_amdgcn_mfma_f32_32x32x16_bf16(kf[3],qr[1],C1,0,0,0),   P0[14],P0[15],P1[0],P1[1],   pw1[2]=PKW(P0,12),pw1[3]=PKW(P0,14), pw1); \
    VRD(2); SBAR(); GAPA(C0=__builtin_amdgcn_mfma_f32_32x32x16_bf16(kf[4],qr[2],C0,0,0,0),   P1[2],P1[3],P1[4],P1[5],     pw2[0]=PKW(P1,0), pw2[1]=PKW(P1,2), pw2); \
    VRD(6); SBAR(); GAPA(C1=__builtin_amdgcn_mfma_f32_32x32x16_bf16(kf[5],qr[2],C1,0,0,0),   P1[6],P1[7],P1[8],P1[9],     pw2[2]=PKW(P1,4), pw2[3]=PKW(P1,6), pw2); \
    VRD(3); SBAR(); GAPA(C0=__builtin_amdgcn_mfma_f32_32x32x16_bf16(kf[6],qr[3],C0,0,0,0),   P1[10],P1[11],P1[12],P1[13], pw3[0]=PKW(P1,8), pw3[1]=PKW(P1,10), pw3); \
    VRD(7); SBAR(); GAPA(C1=__builtin_amdgcn_mfma_f32_32x32x16_bf16(kf[7],qr[3],C1,0,0,0),   P1[14],P1[15],0.f,0.f,       pw3[2]=PKW(P1,12),pw3[3]=PKW(P1,14), pw3); \
    l_reg+=sacc; \
    if(GK){DMA_K((t)+3,sl_cur);} if(GV){DMA_V((t)+1,sl_next);} \
    CMASK(C0,C1,t); \
    { float a=MX3(C0[0],C0[1],C1[0]),b=MX3(C0[2],C0[3],C1[1]); a=MX3(a,C1[2],C1[3]); \
      _Pragma("unroll") for(int r=4;r<16;r+=4){a=MX3(a,C0[r],C0[r+1]);b=MX3(b,C0[r+2],C0[r+3]);a=MX3(a,C1[r],C1[r+1]);b=MX3(b,C1[r+2],C1[r+3]);} \
      float rm=__builtin_fmaxf(a,b); { auto rr=__builtin_amdgcn_permlane32_swap(__float_as_uint(rm),__float_as_uint(rm),false,false); rm=__builtin_fmaxf(__uint_as_float(rr[0]),__uint_as_float(rr[1])); } \
      resc=false; \
      if(__builtin_expect(__any(rm>(float)THRL),0)){ const float dl=__builtin_fmaxf(rm,0.f); mhat+=dl; \
        _Pragma("unroll") for(int r=0;r<16;++r){C0[r]-=dl;C1[r]-=dl;} \
        _Pragma("unroll") for(int r=0;r<16;++r)negm[r]=-mhat; asm volatile("":"+v"(negm)); \
        const float f=__builtin_amdgcn_exp2f(-dl); l_reg*=f; if(hi==0)wsf[r32]=f; resc=true; } } \
    SBAR(); \
    GAPB(o[0]=__builtin_amdgcn_mfma_f32_32x32x16_bf16(PAF(0),VFR(0),o[0],0,0,0), C0,0); \
    GAPB(o[1]=__builtin_amdgcn_mfma_f32_32x32x16_bf16(PAF(0),VFR(4),o[1],0,0,0), C0,4); \
    KRD(GL,0); GAPB(o[0]=__builtin_amdgcn_mfma_f32_32x32x16_bf16(PAF(1),VFR(1),o[0],0,0,0), C0,8); \
    KRD(GL,1); GAPB(o[1]=__builtin_amdgcn_mfma_f32_32x32x16_bf16(PAF(1),VFR(5),o[1],0,0,0), C0,12); \
    KRD(GL,2); GAPB(o[0]=__builtin_amdgcn_mfma_f32_32x32x16_bf16(PAF(2),VFR(2),o[0],0,0,0), C1,0); \
    KRD(GL,3); GAPB(o[1]=__builtin_amdgcn_mfma_f32_32x32x16_bf16(PAF(2),VFR(6),o[1],0,0,0), C1,4); \
    GAPB(o[0]=__builtin_amdgcn_mfma_f32_32x32x16_bf16(PAF(3),VFR(3),o[0],0,0,0), C1,8); \
    GAPB(o[1]=__builtin_amdgcn_mfma_f32_32x32x16_bf16(PAF(3),VFR(7),o[1],0,0,0), C1,12); \
    }while(0)
  int t=1;
  #undef CMASK
  #define CMASK(P0,P1,t) do{}while(0)
  for(;t+5<NT;t+=2){
    STEP(pB0,pB1,pA0,pA1,t,true,true,true);     WAIT_BAR(2); RESC(); ROT();
    STEP(pA0,pA1,pB0,pB1,t+1,true,true,true);   WAIT_BAR(2); RESC(); ROT();
  }
  #undef CMASK
  #define CMASK(P0,P1,t) do{}while(0)
  #define ENDW(tt) do{ if((tt)+3<NT){WAIT_BAR(2);} else if((tt)+2<NT){WAIT_BAR(1);} else {WAIT_BAR(0);} }while(0)
  for(;t+1<NT;t+=2){
    STEP(pB0,pB1,pA0,pA1,t,(t+3<NT),(t+1<NT),(t+1<NT));       ENDW(t);   RESC(); ROT();
    STEP(pA0,pA1,pB0,pB1,t+1,(t+4<NT),(t+2<NT),(t+2<NT));     ENDW(t+1); RESC(); ROT();
  }
  STEP(pB0,pB1,pA0,pA1,NT-1,false,false,false); RESC();
  { float sacc=pB0[0]+pB0[1]; _Pragma("unroll") for(int r=2;r<16;++r)sacc+=pB0[r]; _Pragma("unroll") for(int r=0;r<16;++r)sacc+=pB1[r]; l_reg+=sacc;
    pw0=(u32x4){PKW(pB0,0),PKW(pB0,2),PKW(pB0,4),PKW(pB0,6)};pw1=(u32x4){PKW(pB0,8),PKW(pB0,10),PKW(pB0,12),PKW(pB0,14)};pw2=(u32x4){PKW(pB1,0),PKW(pB1,2),PKW(pB1,4),PKW(pB1,6)};pw3=(u32x4){PKW(pB1,8),PKW(pB1,10),PKW(pB1,12),PKW(pB1,14)};
    SBAR(); pv(o,vb0+sl_cur,PAF(0),PAF(1),PAF(2),PAF(3)); }
  #undef PKW
  #undef PAF
  #undef VFR
  #undef PIN
  #undef MX3
  #undef GAPA
  #undef GAPB
  #undef EX
  #undef VRD
  #undef KRD
  #undef STEP
  #undef ENDW
  {auto rr=__builtin_amdgcn_permlane32_swap(__float_as_uint(l_reg),__float_as_uint(l_reg),false,false);l_reg=__uint_as_float(rr[0])+__uint_as_float(rr[1]);}
  if(hi==0)wsf[32+r32]=l_reg;asm volatile("s_waitcnt lgkmcnt(0)":::"memory");
  float rli[16];
  #pragma unroll
  for(int r=0;r<16;++r)rli[r]=__builtin_amdgcn_rcpf(wsf[32+crow(r,hi)]);
  bf16*Ow=O+(rowbase+q0+wid*QBLK)*DM+h*D;
  { bf16*stg=(bf16*)(shm+LDS_OST)+wid*2048;
    #pragma unroll
    for(int r=0;r<16;++r){const int orow=crow(r,hi);
      #pragma unroll
      for(int d0=0;d0<2;++d0)stg[orow*64+d0*32+r32]=__float2bfloat16(o[d0][r]*rli[r]);}
    asm volatile("s_waitcnt lgkmcnt(0)":::"memory");
    #pragma unroll
    for(int i=0;i<4;++i){const int row=i*8+(lane>>3),ch=lane&7; const u32x4 v=*(const u32x4*)(stg+row*64+ch*8); ATTN_STORE16(Ow+(long)row*DM+ch*8,v);} }
  asm volatile("s_waitcnt lgkmcnt(0)\n\ts_barrier":::"memory");
  #undef DMA_K
  #undef DMA_V
  #undef CMASK
  #undef START
  #undef RESC
  #undef ROT
}
constexpr int ATTN_LDS_BYTES=LDS_BYTES;
struct AttnTensors { const bf16* Q; const bf16* K; const bf16* V; bf16* O; };
struct AttnUnit { int bh; int qb; };
struct StaticOrder {
  int vcu,per;
  __device__ __forceinline__ explicit StaticOrder(int grid,int block):vcu((grid%8==0)?(block%8)*(grid/8)+block/8:block),per((BATCH*NHEAD*NQB+grid-1)/grid){}
  __device__ __forceinline__ bool next(int i,AttnUnit&u)const{ const int L=vcu*per+i; if(i>=per||L>=BATCH*NHEAD*NQB)return false; const int grp=L>>6,idx=L&63; u.bh=(grp>>2)*NHEAD+(grp&3)*4+(idx&3); u.qb=idx>>2; return true; }
  __device__ __forceinline__ void a_ready(const AttnUnit&)const{}
  __device__ __forceinline__ void done(const AttnUnit&)const{}
};
template<class Sched,int THRL=8> __device__ __forceinline__ void attn_phase(char*lds,const AttnTensors&T,const Sched&S,const int tid){
  AttnUnit u;
  for(int i=0;S.next(i,u);++i){ S.a_ready(u); attn_unit<THRL>(u.bh/NHEAD,u.bh%NHEAD,u.qb,T.Q,T.K,T.V,T.O,lds,tid); S.done(u); }
}
#undef SBAR
#undef WAIT_BAR
}

__device__ __forceinline__ void transpose_item(const float* W, const float* g, int K, int N, bf16_t* WT, LAS float* scr, int item, int lane) {
    const int nblk = N / 32, kb = item / nblk, nb = item % nblk, k0 = 64 * kb, n0 = 32 * nb;
#pragma unroll 8
    for (int i = 0; i < 32; ++i) { const int kk = 2 * i + (lane >> 5); const float gv = g ? g[k0 + kk] : 1.0f;
        scr[kk * 33 + (lane & 31)] = W[(size_t)(k0 + kk) * N + n0 + (lane & 31)] * gv; }
    LDS_WAIT(); asm volatile("" ::: "memory");
    const int c = lane & 7;
#pragma unroll
    for (int j = 0; j < 4; ++j) { const int n = (lane >> 3) + 8 * j; const LAS float* s = scr + (8 * c) * 33 + n;
        u32x4 o; o.x = pk2(s[0 * 33], s[1 * 33]); o.y = pk2(s[2 * 33], s[3 * 33]); o.z = pk2(s[4 * 33], s[5 * 33]); o.w = pk2(s[6 * 33], s[7 * 33]);
        *(u32x4*)(WT + (size_t)(n0 + n) * K + k0 + 8 * c) = o; }
    LDS_WAIT(); asm volatile("" ::: "memory");
}
__device__ __forceinline__ void sincos_d(double x, double& s, double& c) {
    const double TWO_PI = 6.283185307179586476925286766559;
    const double n = __builtin_rint(x / TWO_PI);
    const double r = x - n * TWO_PI, r2 = r * r;
    double ts = 1.0, tc = 1.0;
#pragma unroll
    for (int k = 13; k >= 1; --k) { ts = 1.0 - ts * r2 / (double)((2 * k) * (2 * k + 1)); tc = 1.0 - tc * r2 / (double)((2 * k - 1) * (2 * k)); }
    s = r * ts; c = tc;
}

template <class Epi>
__device__ __forceinline__ void gemm_simple(const bf16_t* A, const bf16_t* Bt, int Mrows, int N, int K, const Epi& E, int gw, int ngw, int lane) {
    const int fr = lane & 15, fq = lane >> 4;
    const int ntn = N / 64, ntm = Mrows / 32, ntiles = ntn * ntm;
    for (int t = gw; t < ntiles; t += ngw) {
        const int tn = t % ntn, tm = t / ntn;
        f32x4 acc[2][4];
#pragma unroll
        for (int m = 0; m < 2; ++m)
#pragma unroll
            for (int n = 0; n < 4; ++n) acc[m][n] = (f32x4){0.f, 0.f, 0.f, 0.f};
        const bf16_t* Ap = A + (size_t)(tm * 32 + fr) * K + fq * 8;
        const bf16_t* Bp = Bt + (size_t)(tn * 64 + fr) * K + fq * 8;
        for (int k0 = 0; k0 < K; k0 += 32) {
            bf16x8 a[2], b[4];
            a[0] = *(const bf16x8*)(Ap + k0); a[1] = *(const bf16x8*)(Ap + (size_t)16 * K + k0);
#pragma unroll
            for (int n = 0; n < 4; ++n) b[n] = *(const bf16x8*)(Bp + (size_t)n * 16 * K + k0);
#pragma unroll
            for (int m = 0; m < 2; ++m)
#pragma unroll
                for (int n = 0; n < 4; ++n) acc[m][n] = __builtin_amdgcn_mfma_f32_16x16x32_bf16(b[n], a[m], acc[m][n], 0, 0, 0);
        }
        E(tm * 32, tn * 64, acc, fr, fq);
    }
}

struct EpiQKV {
    const float* ssq; const float* qg; const float* kg; const f32x2* rope; bf16_t* Q; bf16_t* Kb; bf16_t* Vb;
    __device__ __forceinline__ void operator()(int row0, int col0, f32x4 (&acc)[2][4], int fr, int fq) const {
#pragma unroll
        for (int m = 0; m < 2; ++m) {
            const int row = row0 + 16 * m + fr; const float rs = rstd_from_slots(ssq, row);
            f32x4 v[4];
#pragma unroll
            for (int n = 0; n < 4; ++n) v[n] = acc[m][n] * rs;
            if (col0 < 1280) {
                const bool isq = col0 < 1024; const float* g = isq ? qg : kg;
                float ss = 0.f;
#pragma unroll
                for (int n = 0; n < 4; ++n) ss += (v[n].x * v[n].x + v[n].y * v[n].y) + (v[n].z * v[n].z + v[n].w * v[n].w);
                ss += __shfl_xor(ss, 16); ss += __shfl_xor(ss, 32);
                const float r = 1.0f / sqrtf(ss * (1.0f / 64.0f) + EPS);
#pragma unroll
                for (int n = 0; n < 4; ++n) { const f32x4 gv = *(const f32x4*)(g + 16 * n + 4 * fq); v[n] = v[n] * r * gv; }
                const int t = row % SEQ, prow = t >> 6, pcol = t & 63;
                const float sc = isq ? C2 : 1.0f;
#pragma unroll
                for (int hh = 0; hh < 2; ++hh) {
                    const int pos = hh == 0 ? prow : pcol;
                    f32x4 x1 = v[2 * hh], x2 = v[2 * hh + 1], o1, o2;
#pragma unroll
                    for (int j = 0; j < 4; ++j) { const f32x2 cs = rope[pos * 16 + 4 * fq + j];
                        o1[j] = (x1[j] * cs.x - x2[j] * cs.y) * sc; o2[j] = (x2[j] * cs.x + x1[j] * cs.y) * sc; }
                    v[2 * hh] = o1; v[2 * hh + 1] = o2;
                }
            }
            bf16_t* dst;
            if (col0 < 1024) dst = Q + (size_t)row * D + col0;
            else if (col0 < 1280) dst = Kb + (size_t)row * KVP + (col0 - 1024);
            else dst = Vb + (size_t)row * KVP + (col0 - 1280);
#pragma unroll
            for (int n = 0; n < 4; ++n) { u32x2 w; w.x = pk2(v[n].x, v[n].y); w.y = pk2(v[n].z, v[n].w); *(u32x2*)(dst + 16 * n + 4 * fq) = w; }
        }
    }
};
struct EpiRes {
    const float* base; float* out; bf16_t* xb; float* ssq;
    __device__ __forceinline__ void operator()(int row0, int col0, f32x4 (&acc)[2][4], int fr, int fq) const {
#pragma unroll
        for (int m = 0; m < 2; ++m) {
            const int row = row0 + 16 * m + fr; float ss = 0.f;
#pragma unroll
            for (int n = 0; n < 4; ++n) { const size_t off = (size_t)row * D + col0 + 16 * n + 4 * fq;
                const f32x4 h = *(const f32x4*)(base + off) + acc[m][n]; *(f32x4*)(out + off) = h;
                ss += (h.x * h.x + h.y * h.y) + (h.z * h.z + h.w * h.w);
                if (xb) { u32x2 w; w.x = pk2(h.x, h.y); w.y = pk2(h.z, h.w); *(u32x2*)(xb + off) = w; } }
            ss += __shfl_xor(ss, 16); ss += __shfl_xor(ss, 32);
            if (ssq && fq == 0) ssq[(size_t)row * 16 + (col0 >> 6)] = ss;
        }
    }
};
struct EpiUp {
    const float* ssq; bf16_t* HB;
    __device__ __forceinline__ void operator()(int row0, int col0, f32x4 (&acc)[2][4], int fr, int fq) const {
#pragma unroll
        for (int m = 0; m < 2; ++m) {
            const int row = row0 + 16 * m + fr; const float rs = rstd_from_slots(ssq, row);
#pragma unroll
            for (int n = 0; n < 4; ++n) { f32x4 v = acc[m][n] * rs;
#pragma unroll
                for (int j = 0; j < 4; ++j) { const float t = fmaxf(v[j], 0.f); v[j] = t * t; }
                u32x2 w; w.x = pk2(v.x, v.y); w.y = pk2(v.z, v.w); *(u32x2*)(HB + (size_t)row * FF + col0 + 16 * n + 4 * fq) = w; }
        }
    }
};
struct EpiGin {
    const float* ssq; bf16_t* q; bf16_t* k; bf16_t* v; bf16_t* r;
    __device__ __forceinline__ void operator()(int row0, int col0, f32x4 (&acc)[2][4], int fr, int fq) const {
#pragma unroll
        for (int m = 0; m < 2; ++m) {
            const int row = row0 + 16 * m + fr; float rs = rstd_from_slots(ssq, row);
            bf16_t* dst;
            if (col0 < 512) { dst = q + (size_t)row * GQK + col0; rs *= 0.08838834764831845f; }
            else if (col0 < 1024) dst = k + (size_t)row * GQK + (col0 - 512);
            else if (col0 < 2048) dst = v + (size_t)row * GV + (col0 - 1024);
            else dst = r + (size_t)row * GV + (col0 - 2048);
#pragma unroll
            for (int n = 0; n < 4; ++n) { const f32x4 x = acc[m][n] * rs; u32x2 w; w.x = pk2(x.x, x.y); w.y = pk2(x.z, x.w); *(u32x2*)(dst + 16 * n + 4 * fq) = w; }
        }
    }
};
struct EpiZ {
    const float* ssq; float* Z;
    __device__ __forceinline__ void operator()(int row0, int col0, f32x4 (&acc)[2][4], int fr, int fq) const {
#pragma unroll
        for (int m = 0; m < 2; ++m) {
            const int row = row0 + 16 * m + fr; const float rs = rstd_from_slots(ssq, row);
#pragma unroll
            for (int n = 0; n < 4; ++n) *(f32x4*)(Z + (size_t)row * 64 + col0 + 16 * n + 4 * fq) = acc[m][n] * rs;
        }
    }
};

__device__ __forceinline__ void attn_simple(const bf16_t* Q, const bf16_t* Kb, const bf16_t* Vb, bf16_t* O, int gw, int ngw, int lane) {
    const int fr = lane & 15, fq = lane >> 4;
    for (int u = gw; u < BATCH * NH * (SEQ / 16); u += ngw) {
        const int qt = u & 255, h = (u >> 8) & 15, b = u >> 12, kvh = h >> 2;
        const size_t rowbase = (size_t)b * SEQ;
        const bf16_t* Qp = Q + (rowbase + qt * 16 + fr) * D + h * HD + fq * 8;
        bf16x8 qf[2]; qf[0] = *(const bf16x8*)Qp; qf[1] = *(const bf16x8*)(Qp + 32);
        const bf16_t* Kh = Kb + rowbase * KVP + kvh * HD;
        const bf16_t* Vh = Vb + rowbase * KVP + kvh * HD;
        float mrun = -1e30f, lrun = 0.f;
        f32x4 oacc[4];
#pragma unroll
        for (int dt = 0; dt < 4; ++dt) oacc[dt] = (f32x4){0.f, 0.f, 0.f, 0.f};
        for (int kt = 0; kt < SEQ / 64; ++kt) {
            const int key0 = kt * 64;
            f32x4 sT[4];
#pragma unroll
            for (int blk = 0; blk < 4; ++blk) {
                const int key = key0 + 32 * (blk >> 1) + 8 * (fr >> 2) + 4 * (blk & 1) + (fr & 3);
                const bf16_t* kp = Kh + (size_t)key * KVP + fq * 8;
                const bf16x8 k0 = *(const bf16x8*)kp, k1 = *(const bf16x8*)(kp + 32);
                f32x4 z = (f32x4){0.f, 0.f, 0.f, 0.f};
                z = __builtin_amdgcn_mfma_f32_16x16x32_bf16(k0, qf[0], z, 0, 0, 0);
                z = __builtin_amdgcn_mfma_f32_16x16x32_bf16(k1, qf[1], z, 0, 0, 0);
                sT[blk] = z;
            }
            float mx = sT[0][0];
#pragma unroll
            for (int blk = 0; blk < 4; ++blk)
#pragma unroll
                for (int r = 0; r < 4; ++r) mx = fmaxf(mx, sT[blk][r]);
            mx = fmaxf(mx, __shfl_xor(mx, 16)); mx = fmaxf(mx, __shfl_xor(mx, 32));
            const float mnew = fmaxf(mrun, mx), alpha = __builtin_amdgcn_exp2f(mrun - mnew); mrun = mnew;
            float ps = 0.f; bf16x8 pf[2];
#pragma unroll
            for (int ks = 0; ks < 2; ++ks) {
                float p[8];
#pragma unroll
                for (int j = 0; j < 8; ++j) { p[j] = __builtin_amdgcn_exp2f(sT[2 * ks + (j >> 2)][j & 3] - mnew); ps += p[j]; }
                u32x4 w; w.x = pk2(p[0], p[1]); w.y = pk2(p[2], p[3]); w.z = pk2(p[4], p[5]); w.w = pk2(p[6], p[7]);
                pf[ks] = __builtin_bit_cast(bf16x8, w);
            }
            lrun = lrun * alpha + ps;
#pragma unroll
            for (int dt = 0; dt < 4; ++dt) oacc[dt] = oacc[dt] * alpha;
#pragma unroll
            for (int ks = 0; ks < 2; ++ks)
#pragma unroll
                for (int dt = 0; dt < 4; ++dt) {
                    const bf16_t* vp = Vh + (size_t)(key0 + 32 * ks + 8 * fq) * KVP + dt * 16 + fr;
                    bf16x8 vf;
#pragma unroll
                    for (int e = 0; e < 8; ++e) vf[e] = (short)vp[(size_t)e * KVP];
                    oacc[dt] = __builtin_amdgcn_mfma_f32_16x16x32_bf16(vf, pf[ks], oacc[dt], 0, 0, 0);
                }
        }
        lrun += __shfl_xor(lrun, 16); lrun += __shfl_xor(lrun, 32);
        const float inv = 1.0f / lrun;
        bf16_t* Op = O + (rowbase + qt * 16 + fr) * D + h * HD + 4 * fq;
#pragma unroll
        for (int dt = 0; dt < 4; ++dt) { const f32x4 o = oacc[dt] * inv; u32x2 w; w.x = pk2(o.x, o.y); w.y = pk2(o.z, o.w); *(u32x2*)(Op + dt * 16) = w; }
    }
}

__device__ __forceinline__ void gla_pre(const bf16_t* q, const bf16_t* k, const float* Z, const float* wgu, const float* bgate, bf16_t* qe, bf16_t* ke, float* decay, int wg, int nwg, int tid) {
    const int c = tid, h = c >> 7, d = c & 127;
    for (int it = wg; it < BATCH * NCH * 2; it += nwg) {
        const int dir = it & 1, n = (it >> 1) & (NCH - 1), b = it >> 7;
        float w[RANK];
#pragma unroll
        for (int r = 0; r < RANK; ++r) w[r] = wgu[((size_t)dir * RANK + r) * GQK + c];
        const float bg = bgate[dir * GQK + c];
        float bsum = 0.f;
        bf16_t* qed = qe + (size_t)dir * M * GQK; bf16_t* ked = ke + (size_t)dir * M * GQK;
        for (int s = 0; s < CH; ++s) {
            const int i = dir == 0 ? s : (CH - 1 - s);
            const size_t tok = (size_t)b * SEQ + n * CH + i;
            const f32x4* zp = (const f32x4*)(Z + tok * 64 + dir * RANK);
            const f32x4 z0 = zp[0], z1 = zp[1], z2 = zp[2], z3 = zp[3];
            float logit = bg;
            logit += z0.x * w[0] + z0.y * w[1] + z0.z * w[2] + z0.w * w[3];
            logit += z1.x * w[4] + z1.y * w[5] + z1.z * w[6] + z1.w * w[7];
            logit += z2.x * w[8] + z2.y * w[9] + z2.z * w[10] + z2.w * w[11];
            logit += z3.x * w[12] + z3.y * w[13] + z3.z * w[14] + z3.w * w[15];
            const float lg = (fminf(logit, 0.f) - log1pf(expf(-fabsf(logit)))) * (1.0f / 16.0f);
            bsum += lg;
            const float eb = expf(bsum), enb = expf(-bsum);
            qed[tok * GQK + c] = (bf16_t)f2bf(bf2f(q[tok * GQK + c]) * eb);
            ked[tok * GQK + c] = (bf16_t)f2bf(bf2f(k[tok * GQK + c]) * enb);
        }
        decay[((((size_t)b * GH + h) * 2 + dir) * NCH + n) * GDK + d] = expf(bsum);
    }
}


__device__ __forceinline__ void gla_pre2(const bf16_t* __restrict__ XB, const bf16_t* __restrict__ Wz, const float* __restrict__ ssq, const bf16_t* __restrict__ q, const bf16_t* __restrict__ k,
                                         const float* __restrict__ wgu, const float* __restrict__ bgate, bf16_t* __restrict__ qe, bf16_t* __restrict__ ke, float* __restrict__ decay,
                                         LAS unsigned char* lds, int wg, int nwg, const int tid) {
    const int lane = tid & 63, wave = __builtin_amdgcn_readfirstlane(tid >> 6), fr = lane & 15, fq = lane >> 4;
    LAS float* part = (LAS float*)lds;
    LAS float* zL = part + 8 * 8 * 256;
    LAS float* rsL = zL + 64 * 32;
    for (int it = wg; it < BATCH * NCH; it += nwg) {
        const int b = it >> 6, n = it & 63; const size_t tok0 = (size_t)b * SEQ + (size_t)n * CH;
        {
            bf16x8 af[4][4], bz[2][4];
#pragma unroll
            for (int tt = 0; tt < 4; ++tt)
#pragma unroll
                for (int ks = 0; ks < 4; ++ks) af[tt][ks] = *(const bf16x8*)(XB + (tok0 + 16 * tt + fr) * D + 128 * wave + 32 * ks + 8 * fq);
#pragma unroll
            for (int zt = 0; zt < 2; ++zt)
#pragma unroll
                for (int ks = 0; ks < 4; ++ks) bz[zt][ks] = *(const bf16x8*)(Wz + (size_t)(16 * zt + fr) * D + 128 * wave + 32 * ks + 8 * fq);
            if (tid < 64) rsL[tid] = rstd_from_slots(ssq, (int)tok0 + tid);
#pragma unroll
            for (int tt = 0; tt < 4; ++tt)
#pragma unroll
                for (int zt = 0; zt < 2; ++zt) { f32x4 acc = (f32x4){0.f, 0.f, 0.f, 0.f};
#pragma unroll
                    for (int ks = 0; ks < 4; ++ks) acc = __builtin_amdgcn_mfma_f32_16x16x32_bf16(bz[zt][ks], af[tt][ks], acc, 0, 0, 0);
                    *(LAS f32x4*)(part + ((wave * 8 + tt * 2 + zt) * 64 + lane) * 4) = acc; }
        }
        __syncthreads();
        {   const int tile = tid >> 6, l = tid & 63; f32x4 s = (f32x4){0.f, 0.f, 0.f, 0.f};
#pragma unroll
            for (int w = 0; w < 8; ++w) s += *(const LAS f32x4*)(part + ((w * 8 + tile) * 64 + l) * 4);
            const int tok = 16 * (tile >> 1) + (l & 15), zc = 16 * (tile & 1) + 4 * (l >> 4);
            *(LAS f32x4*)(zL + tok * 32 + zc) = s * rsL[tok]; }
        __syncthreads();
        {
            const int dir = tid >> 8, c = 2 * (tid & 255), h = c >> 7, d = c & 127;
            float w0[RANK], w1[RANK];
#pragma unroll
            for (int r = 0; r < RANK; ++r) { const f32x2 w = *(const f32x2*)(wgu + ((size_t)dir * RANK + r) * GQK + c); w0[r] = w.x; w1[r] = w.y; }
            const f32x2 bg = *(const f32x2*)(bgate + dir * GQK + c);
            float bs0 = 0.f, bs1 = 0.f;
            bf16_t* qed = qe + (size_t)dir * M * GQK + c; bf16_t* ked = ke + (size_t)dir * M * GQK + c;
            for (int bt = 0; bt < 4; ++bt) {
                unsigned qv[16], kv[16];
#pragma unroll
                for (int j = 0; j < 16; ++j) { const int i = dir == 0 ? 16 * bt + j : CH - 1 - (16 * bt + j);
                    qv[j] = *(const unsigned*)(q + (tok0 + i) * GQK + c); kv[j] = *(const unsigned*)(k + (tok0 + i) * GQK + c); }
#pragma unroll
                for (int j = 0; j < 16; ++j) { const int i = dir == 0 ? 16 * bt + j : CH - 1 - (16 * bt + j);
                    const LAS f32x4* zp = (const LAS f32x4*)(zL + i * 32 + dir * RANK);
                    const f32x4 z0 = zp[0], z1 = zp[1], z2 = zp[2], z3 = zp[3];
                    float l0 = bg.x, l1 = bg.y;
                    l0 += z0.x * w0[0] + z0.y * w0[1] + z0.z * w0[2] + z0.w * w0[3]; l1 += z0.x * w1[0] + z0.y * w1[1] + z0.z * w1[2] + z0.w * w1[3];
                    l0 += z1.x * w0[4] + z1.y * w0[5] + z1.z * w0[6] + z1.w * w0[7]; l1 += z1.x * w1[4] + z1.y * w1[5] + z1.z * w1[6] + z1.w * w1[7];
                    l0 += z2.x * w0[8] + z2.y * w0[9] + z2.z * w0[10] + z2.w * w0[11]; l1 += z2.x * w1[8] + z2.y * w1[9] + z2.z * w1[10] + z2.w * w1[11];
                    l0 += z3.x * w0[12] + z3.y * w0[13] + z3.z * w0[14] + z3.w * w0[15]; l1 += z3.x * w1[12] + z3.y * w1[13] + z3.z * w1[14] + z3.w * w1[15];
                    const float t0 = __builtin_amdgcn_exp2f(-l0 * 1.4426950408889634f), t1 = __builtin_amdgcn_exp2f(-l1 * 1.4426950408889634f);
                    bs0 -= __builtin_amdgcn_logf(1.0f + t0) * (0.6931471805599453f / 16.0f); bs1 -= __builtin_amdgcn_logf(1.0f + t1) * (0.6931471805599453f / 16.0f);
                    const float e0 = __builtin_amdgcn_exp2f(bs0 * 1.4426950408889634f), e1 = __builtin_amdgcn_exp2f(bs1 * 1.4426950408889634f);
                    const float n0 = __builtin_amdgcn_rcpf(e0), n1 = __builtin_amdgcn_rcpf(e1);
                    *(unsigned*)(qed + (tok0 + i) * GQK) = pk2(bflo(qv[j]) * e0, bfhi(qv[j]) * e1);
                    *(unsigned*)(ked + (tok0 + i) * GQK) = pk2(bflo(kv[j]) * n0, bfhi(kv[j]) * n1); }
            }
            *(f32x2*)(decay + ((((size_t)b * GH + h) * 2 + dir) * NCH + n) * GDK + d) = (f32x2){__builtin_amdgcn_exp2f(bs0 * 1.4426950408889634f), __builtin_amdgcn_exp2f(bs1 * 1.4426950408889634f)};
        }
        __syncthreads();
    }
}

__device__ __forceinline__ void gla_scan_simple(const bf16_t* qe, const bf16_t* ke, const bf16_t* v, const float* decay, bf16_t* of, bf16_t* ob, LAS unsigned char* lds, int wg, int nwg, int tid) {
    LAS float* qeL = (LAS float*)lds;
    LAS float* keL = qeL + 64 * 129;
    LAS float* vL = keL + 64 * 129;
    LAS float* AL = vL + 64 * 33;
    LAS float* SL = AL + 64 * 65;
    LAS float* dL = SL + 128 * 33;
    for (int it = wg; it < BATCH * GH * 2 * 8; it += nwg) {
        const int js = it & 7, dir = (it >> 3) & 1, h = (it >> 4) & 3, b = it >> 6;
        const bf16_t* qed = qe + (size_t)dir * M * GQK; const bf16_t* ked = ke + (size_t)dir * M * GQK;
        bf16_t* od = dir == 0 ? of : ob;
        for (int e = tid; e < 128 * 33; e += NTHREADS) SL[e] = 0.f;
        __syncthreads();
        for (int st = 0; st < NCH; ++st) {
            const int n = dir == 0 ? st : (NCH - 1 - st);
            const size_t tok0 = (size_t)b * SEQ + n * CH;
            {
                const int i = tid >> 3, ds = (tid & 7) * 16;
                const u32x4* qp = (const u32x4*)(qed + (tok0 + i) * GQK + h * GDK + ds);
                const u32x4* kp = (const u32x4*)(ked + (tok0 + i) * GQK + h * GDK + ds);
#pragma unroll
                for (int hh = 0; hh < 2; ++hh) { const u32x4 a = qp[hh], c = kp[hh];
#pragma unroll
                    for (int j = 0; j < 4; ++j) { qeL[i * 129 + ds + hh * 8 + 2 * j] = bflo(a[j]); qeL[i * 129 + ds + hh * 8 + 2 * j + 1] = bfhi(a[j]);
                                                  keL[i * 129 + ds + hh * 8 + 2 * j] = bflo(c[j]); keL[i * 129 + ds + hh * 8 + 2 * j + 1] = bfhi(c[j]); } }
                if (tid < 256) { const int iv = tid >> 2, vs = (tid & 3) * 8;
                    const u32x4 a = *(const u32x4*)(v + (tok0 + iv) * GV + h * GDV + js * 32 + vs);
#pragma unroll
                    for (int j = 0; j < 4; ++j) { vL[iv * 33 + vs + 2 * j] = bflo(a[j]); vL[iv * 33 + vs + 2 * j + 1] = bfhi(a[j]); } }
                if (tid < 128) dL[tid] = decay[((((size_t)b * GH + h) * 2 + dir) * NCH + n) * GDK + tid];
            }
            __syncthreads();
            {
                const int i = tid >> 3, jg = tid & 7;
                float a[8];
#pragma unroll
                for (int e = 0; e < 8; ++e) a[e] = 0.f;
                for (int d = 0; d < GDK; ++d) { const float qv = qeL[i * 129 + d];
#pragma unroll
                    for (int e = 0; e < 8; ++e) a[e] += qv * keL[(jg + 8 * e) * 129 + d]; }
#pragma unroll
                for (int e = 0; e < 8; ++e) { const int j = jg + 8 * e; const bool keep = dir == 0 ? (j <= i) : (j >= i); AL[i * 65 + j] = keep ? a[e] : 0.f; }
            }
            __syncthreads();
            {
                const int i = tid >> 3, vg = (tid & 7) * 4;
                float o[4] = {0.f, 0.f, 0.f, 0.f};
                for (int j = 0; j < CH; ++j) { const float a = AL[i * 65 + j];
#pragma unroll
                    for (int e = 0; e < 4; ++e) o[e] += a * vL[j * 33 + vg + e]; }
                for (int d = 0; d < GDK; ++d) { const float qv = qeL[i * 129 + d];
#pragma unroll
                    for (int e = 0; e < 4; ++e) o[e] += qv * SL[d * 33 + vg + e]; }
                u32x2 w; w.x = pk2(o[0], o[1]); w.y = pk2(o[2], o[3]);
                *(u32x2*)(od + (tok0 + i) * GV + h * GDV + js * 32 + vg) = w;
            }
            __syncthreads();
            {
                const int d = tid >> 2, vg = (tid & 3) * 8;
                float s[8];
#pragma unroll
                for (int e = 0; e < 8; ++e) s[e] = SL[d * 33 + vg + e];
                for (int j = 0; j < CH; ++j) { const float kv = keL[j * 129 + d];
#pragma unroll
                    for (int e = 0; e < 8; ++e) s[e] += kv * vL[j * 33 + vg + e]; }
                const float dc = dL[d];
#pragma unroll
                for (int e = 0; e < 8; ++e) SL[d * 33 + vg + e] = dc * s[e];
            }
            __syncthreads();
        }
    }
}


typedef short s16x4 __attribute__((ext_vector_type(4)));
__device__ __forceinline__ s16x4 ds_tr16(const LAS unsigned char* p) { return __builtin_amdgcn_ds_read_tr16_b64_v4i16((LAS s16x4*)p); }
__device__ __forceinline__ bf16x8 cat8(s16x4 lo, s16x4 hi) { return (bf16x8){lo[0], lo[1], lo[2], lo[3], hi[0], hi[1], hi[2], hi[3]}; }
constexpr int GS_QSTR = 272, GS_VSTR = 80;
constexpr int GS_QE = 0, GS_KE = 64 * GS_QSTR, GS_V = 2 * 64 * GS_QSTR, GS_BUF = GS_V + 64 * GS_VSTR;
constexpr int GS_ST = 2 * GS_BUF, GS_STB = 32 * GS_QSTR;
static_assert(GS_ST + 2 * GS_STB <= RING_BYTES, "GLA scan LDS");
__device__ __forceinline__ void gla_scan_mfma(const bf16_t* qe, const bf16_t* ke, const bf16_t* v, const float* decay, bf16_t* of, bf16_t* ob, LAS unsigned char* lds, int wg, int nwg, const int tid) {
    const int lane = tid & 63, wave = __builtin_amdgcn_readfirstlane(tid >> 6), fr = lane & 15, fq = lane >> 4;
    const int tb = wave >> 1, c = wave & 1, T0 = 2 * (wave >> 1);
    const int trq = (lane & 15) >> 2, trp = lane & 3;
    for (int it = wg; it < BATCH * GH * 2 * 8; it += nwg) {
        const int js = it & 7, dir = (it >> 3) & 1, h = (it >> 4) & 3, b = it >> 6;
        const bf16_t* qed = qe + (size_t)dir * M * GQK + h * GDK; const bf16_t* ked = ke + (size_t)dir * M * GQK + h * GDK;
        const bf16_t* vd = v + h * GDV + js * 32;
        bf16_t* od = (dir == 0 ? of : ob) + h * GDV + js * 32;
        const float* decp = decay + ((((size_t)b * GH + h) * 2 + dir) * NCH) * GDK;
        f32x4 S0 = (f32x4){0.f, 0.f, 0.f, 0.f}, S1 = (f32x4){0.f, 0.f, 0.f, 0.f};
        u32x4 lq[2], lk[2], lv = (u32x4){0u, 0u, 0u, 0u}; f32x4 dcur[2], dnext[2];
#define GS_ISSUE(n_) do { const size_t tok0_ = (size_t)b * SEQ + (size_t)(n_) * CH; \
            _Pragma("unroll") for (int i_ = 0; i_ < 2; ++i_) { const size_t r_ = tok0_ + (tid >> 4) + 32 * i_; \
                lq[i_] = *(const u32x4*)(qed + r_ * GQK + (tid & 15) * 8); lk[i_] = *(const u32x4*)(ked + r_ * GQK + (tid & 15) * 8); } \
            if (tid < 256) lv = *(const u32x4*)(vd + (tok0_ + (tid >> 2)) * GV + (tid & 3) * 8); \
            dnext[0] = *(const f32x4*)(decp + (size_t)(n_) * GDK + 16 * T0 + 4 * fq); dnext[1] = *(const f32x4*)(decp + (size_t)(n_) * GDK + 16 * T0 + 16 + 4 * fq); } while (0)
#define GS_COMMIT(buf_) do { LAS unsigned char* B_ = lds + (buf_) * GS_BUF; \
            _Pragma("unroll") for (int i_ = 0; i_ < 2; ++i_) { const int r_ = (tid >> 4) + 32 * i_; \
                *(LAS u32x4*)(B_ + GS_QE + r_ * GS_QSTR + (tid & 15) * 16) = lq[i_]; *(LAS u32x4*)(B_ + GS_KE + r_ * GS_QSTR + (tid & 15) * 16) = lk[i_]; } \
            if (tid < 256) *(LAS u32x4*)(B_ + GS_V + (tid >> 2) * GS_VSTR + (tid & 3) * 16) = lv; } while (0)
        for (int e = tid; e < GS_STB / 16; e += NTHREADS) *(LAS u32x4*)(lds + GS_ST + e * 16) = (u32x4){0u, 0u, 0u, 0u};
        { const int n0 = dir == 0 ? 0 : NCH - 1; GS_ISSUE(n0); GS_COMMIT(0); dcur[0] = dnext[0]; dcur[1] = dnext[1]; }
        for (int s = 0; s < NCH; ++s) {
            const int n = dir == 0 ? s : NCH - 1 - s, cur = s & 1;
            asm volatile("s_waitcnt lgkmcnt(0)" ::: "memory"); __builtin_amdgcn_s_barrier(); asm volatile("" ::: "memory");
            if (s + 1 < NCH) { const int nn = dir == 0 ? s + 1 : NCH - 2 - s; GS_ISSUE(nn); }
            const LAS unsigned char* Bq = lds + cur * GS_BUF + GS_QE; const LAS unsigned char* Bk = lds + cur * GS_BUF + GS_KE; const LAS unsigned char* Bv = lds + cur * GS_BUF + GS_V;
            const LAS unsigned char* St = lds + GS_ST + cur * GS_STB; LAS unsigned char* Stn = lds + GS_ST + (cur ^ 1) * GS_STB;
            bf16x8 qf[4];
#pragma unroll
            for (int ks = 0; ks < 4; ++ks) qf[ks] = *(const LAS bf16x8*)(Bq + (16 * tb + fr) * GS_QSTR + (32 * ks + 8 * fq) * 2);
            f32x4 at[4];
#pragma unroll
            for (int a = 0; a < 4; ++a) {
                f32x4 acc = (f32x4){0.f, 0.f, 0.f, 0.f};
#pragma unroll
                for (int ks = 0; ks < 4; ++ks) { const bf16x8 kf = *(const LAS bf16x8*)(Bk + (16 * a + fr) * GS_QSTR + (32 * ks + 8 * fq) * 2);
                    acc = __builtin_amdgcn_mfma_f32_16x16x32_bf16(kf, qf[ks], acc, 0, 0, 0); }
                const int ti = 16 * tb + fr;
#pragma unroll
                for (int r = 0; r < 4; ++r) { const int tj = 16 * a + 4 * fq + r; const bool keep = dir == 0 ? (tj <= ti) : (tj >= ti); acc[r] = keep ? acc[r] : 0.f; }
                at[a] = acc;
            }
            bf16x8 vf[2];
#pragma unroll
            for (int ks = 0; ks < 2; ++ks) { const LAS unsigned char* p = Bv + (32 * ks + 4 * fq + trq) * GS_VSTR + (16 * c + 4 * trp) * 2;
                vf[ks] = cat8(ds_tr16(p), ds_tr16(p + 16 * GS_VSTR)); }
            f32x4 o = (f32x4){0.f, 0.f, 0.f, 0.f};
#pragma unroll
            for (int ks = 0; ks < 4; ++ks) { const bf16x8 sf = *(const LAS bf16x8*)(St + (16 * c + fr) * GS_QSTR + (32 * ks + 8 * fq) * 2);
                o = __builtin_amdgcn_mfma_f32_16x16x32_bf16(sf, qf[ks], o, 0, 0, 0); }
#pragma unroll
            for (int ks = 0; ks < 2; ++ks) { u32x4 w; w.x = pk2(at[2 * ks][0], at[2 * ks][1]); w.y = pk2(at[2 * ks][2], at[2 * ks][3]); w.z = pk2(at[2 * ks + 1][0], at[2 * ks + 1][1]); w.w = pk2(at[2 * ks + 1][2], at[2 * ks + 1][3]);
                o = __builtin_amdgcn_mfma_f32_16x16x32_bf16(vf[ks], __builtin_bit_cast(bf16x8, w), o, 0, 0, 0); }
            { u32x2 w; w.x = pk2(o[0], o[1]); w.y = pk2(o[2], o[3]);
              *(u32x2*)(od + ((size_t)b * SEQ + (size_t)n * CH + 16 * tb + fr) * GV + 16 * c + 4 * fq) = w; }
#pragma unroll
            for (int ks = 0; ks < 2; ++ks) {
                const LAS unsigned char* p0 = Bk + (32 * ks + 4 * fq + trq) * GS_QSTR + (16 * T0 + 4 * trp) * 2;
                const bf16x8 k0 = cat8(ds_tr16(p0), ds_tr16(p0 + 16 * GS_QSTR));
                const bf16x8 k1 = cat8(ds_tr16(p0 + 32), ds_tr16(p0 + 32 + 16 * GS_QSTR));
                S0 = __builtin_amdgcn_mfma_f32_16x16x32_bf16(k0, vf[ks], S0, 0, 0, 0);
                S1 = __builtin_amdgcn_mfma_f32_16x16x32_bf16(k1, vf[ks], S1, 0, 0, 0);
            }
            S0 = S0 * dcur[0]; S1 = S1 * dcur[1];
            { u32x2 w0, w1; w0.x = pk2(S0[0], S0[1]); w0.y = pk2(S0[2], S0[3]); w1.x = pk2(S1[0], S1[1]); w1.y = pk2(S1[2], S1[3]);
              *(LAS u32x2*)(Stn + (16 * c + fr) * GS_QSTR + (16 * T0 + 4 * fq) * 2) = w0; *(LAS u32x2*)(Stn + (16 * c + fr) * GS_QSTR + (16 * T0 + 16 + 4 * fq) * 2) = w1; }
            if (s + 1 < NCH) { GS_COMMIT(cur ^ 1); dcur[0] = dnext[0]; dcur[1] = dnext[1]; }
        }
        asm volatile("s_waitcnt lgkmcnt(0)" ::: "memory"); __builtin_amdgcn_s_barrier(); asm volatile("" ::: "memory");
#undef GS_ISSUE
#undef GS_COMMIT
    }
}

__device__ __forceinline__ void gla_combine(bf16_t* of, const bf16_t* ob, const bf16_t* r, const float* og, int gw, int ngw, int lane) {
    for (int row = gw; row < M; row += ngw) {
        const size_t off = (size_t)row * GV + lane * 16;
        const u32x4 a0 = *(const u32x4*)(of + off), a1 = *(const u32x4*)(of + off + 8);
        const u32x4 b0 = *(const u32x4*)(ob + off), b1 = *(const u32x4*)(ob + off + 8);
        const u32x4 r0 = *(const u32x4*)(r + off), r1 = *(const u32x4*)(r + off + 8);
        float o[16], rr[16];
#pragma unroll
        for (int j = 0; j < 4; ++j) { o[2 * j] = bflo(a0[j]) + bflo(b0[j]); o[2 * j + 1] = bfhi(a0[j]) + bfhi(b0[j]); o[8 + 2 * j] = bflo(a1[j]) + bflo(b1[j]); o[8 + 2 * j + 1] = bfhi(a1[j]) + bfhi(b1[j]);
            rr[2 * j] = bflo(r0[j]); rr[2 * j + 1] = bfhi(r0[j]); rr[8 + 2 * j] = bflo(r1[j]); rr[8 + 2 * j + 1] = bfhi(r1[j]); }
        float ss = 0.f;
#pragma unroll
        for (int j = 0; j < 16; ++j) ss += o[j] * o[j];
        ss += __shfl_xor(ss, 1); ss += __shfl_xor(ss, 2); ss += __shfl_xor(ss, 4); ss += __shfl_xor(ss, 8);
        const float rs = 1.0f / sqrtf(ss * (1.0f / GDV) + EPS);
        const int dv0 = (lane & 15) * 16;
        float g[16];
#pragma unroll
        for (int j = 0; j < 16; ++j) { const float y = o[j] * rs * og[dv0 + j]; const float x = rr[j]; g[j] = y * x / (1.0f + __expf(-x)); }
        u32x4 w0, w1;
#pragma unroll
        for (int j = 0; j < 4; ++j) { w0[j] = pk2(g[2 * j], g[2 * j + 1]); w1[j] = pk2(g[8 + 2 * j], g[8 + 2 * j + 1]); }
        *(u32x4*)(of + off) = w0; *(u32x4*)(of + off + 8) = w1;
    }
}

struct Args { const float* in[15]; float* out; unsigned char* ws; int ph_lo, ph_hi; };
static_assert(sizeof(Args) == 15 * 8 + 8 + 8 + 8, "Args has no padding");

__global__ void __launch_bounds__(NTHREADS, 2) fwd_kernel(Args args) {
    extern __shared__ __attribute__((aligned(16))) unsigned char lds_raw[];
    LAS unsigned char* lds = (LAS unsigned char*)lds_raw;
    const int tid0 = threadIdx.x;
#define KARG_BASE() const __attribute__((address_space(4))) unsigned char* ka_ = (const __attribute__((address_space(4))) unsigned char*)__builtin_amdgcn_kernarg_segment_ptr(); asm volatile("" : "+s"(ka_))
#define IN_PTR(i) (*(const float* const __attribute__((address_space(4)))*)(ka_ + 8 * (i)))
#define OUT_PTR() (*(float* const __attribute__((address_space(4)))*)(ka_ + 8 * 15))
#define WS_PTR() (*(unsigned char* const __attribute__((address_space(4)))*)(ka_ + 8 * 16))
#define WSP(T, off) ((T*)(ws + (off)))
    for (int u = tid0; u < (LDS_BYTES - LDSCTL_OFF) / 4; u += NTHREADS) ((LAS unsigned*)(lds + LDSCTL_OFF))[u] = 0u;
    __syncthreads();
    volatile LAS unsigned* MISC = (volatile LAS unsigned*)(lds + MISC_OFF);
    const int lo = args.ph_lo, hi = args.ph_hi;
    const bool multi = (hi - lo) > 1;
    XcdBarrier bar; bar.bar = (unsigned*)(args.ws + WS_CTL) + 4096; bar.x = 0; bar.st = nullptr;
    if (multi) bar = xcd_barrier_post((unsigned*)(args.ws + WS_CTL) + 4096, MISC + 8);
#ifndef FAST_GEMM
#define FAST_GEMM 15
#endif
    bool rep_done = false;
    for (int ph = lo; ph < hi; ++ph) {
        int tid = threadIdx.x; asm volatile("" : "+v"(tid));
        int wg = blockIdx.x, G = gridDim.x; asm volatile("" : "+s"(wg), "+s"(G));
        const int lane = tid & 63, wave = __builtin_amdgcn_readfirstlane(tid >> 6);
        const int gw = wg * NWAVES + wave, ngw = G * NWAVES;
        switch (ph) {
        case 0: {
            KARG_BASE(); unsigned char* ws = WS_PTR();
            const float* x = IN_PTR(0); const float* norm_mix = IN_PTR(1); const float* norm_mlp = IN_PTR(2); const float* attn_w_qkv = IN_PTR(3); const float* attn_w_o = IN_PTR(6);
            const float* gla_w_in = IN_PTR(7); const float* gla_w_o = IN_PTR(11); const float* mlp_w_in = IN_PTR(12); const float* mlp_w_out = IN_PTR(13);
            bf16_t* Wqkv = WSP(bf16_t, W_QKV); bf16_t* Wo0 = WSP(bf16_t, W_O0); bf16_t* W1a = WSP(bf16_t, W_1A); bf16_t* W2a = WSP(bf16_t, W_2A);
            bf16_t* Wgin = WSP(bf16_t, W_GIN); bf16_t* Wo1 = WSP(bf16_t, W_O1); bf16_t* W1b = WSP(bf16_t, W_1B); bf16_t* W2b = WSP(bf16_t, W_2B);
            bf16_t* XB = WSP(bf16_t, WS_XB); float* SSQ0 = WSP(float, WS_SSQ); f32x2* ROPE = WSP(f32x2, WS_ROPE);
            LAS float* scr = (LAS float*)(lds + wave * 16384);
            constexpr int I_QKV = 16 * 48, I_O = 16 * 32, I_1 = 16 * 128, I_2 = 64 * 32, I_GIN = 16 * 97;
            constexpr int NITEMS = I_QKV + I_O + I_1 + I_2 + I_GIN + I_O + I_1 + I_2;
            for (int it = gw; it < NITEMS; it += ngw) {
                int r = it;
                if (r < I_QKV) { transpose_item(attn_w_qkv, norm_mix, D, QKV_N, Wqkv, scr, r, lane); continue; } r -= I_QKV;
                if (r < I_O) { transpose_item(attn_w_o, nullptr, D, D, Wo0, scr, r, lane); continue; } r -= I_O;
                if (r < I_1) { transpose_item(mlp_w_in, norm_mlp, D, FF, W1a, scr, r, lane); continue; } r -= I_1;
                if (r < I_2) { transpose_item(mlp_w_out, nullptr, FF, D, W2a, scr, r, lane); continue; } r -= I_2;
                if (r < I_GIN) { transpose_item(gla_w_in, norm_mix + D, D, GIN, Wgin, scr, r, lane); continue; } r -= I_GIN;
                if (r < I_O) { transpose_item(gla_w_o, nullptr, D, D, Wo1, scr, r, lane); continue; } r -= I_O;
                if (r < I_1) { transpose_item(mlp_w_in + (size_t)D * FF, norm_mlp + D, D, FF, W1b, scr, r, lane); continue; } r -= I_1;
                transpose_item(mlp_w_out + (size_t)FF * D, nullptr, FF, D, W2b, scr, r, lane);
            }
            for (int e = gw * 64 + lane; e < 32 * D / 8; e += ngw * 64) *(u32x4*)(Wgin + (size_t)GIN * D + (size_t)e * 8) = (u32x4){0u, 0u, 0u, 0u};
            for (int m = gw; m < M; m += ngw) {
                const f32x4* xr = (const f32x4*)(x + (size_t)m * D) + lane;
                f32x4 v[4]; float s = 0.f;
#pragma unroll
                for (int j = 0; j < 4; ++j) { v[j] = xr[64 * j]; s += (v[j].x * v[j].x + v[j].y * v[j].y) + (v[j].z * v[j].z + v[j].w * v[j].w); }
                s = wave_sum(s);
                u32x2* o8 = (u32x2*)(XB + (size_t)m * D) + lane;
#pragma unroll
                for (int j = 0; j < 4; ++j) { u32x2 w; w.x = pk2(v[j].x, v[j].y); w.y = pk2(v[j].z, v[j].w); o8[64 * j] = w; }
                if (lane < 16) SSQ0[(size_t)m * 16 + lane] = lane == 0 ? s : 0.f;
            }
            if (wg == 0) {
                for (int e = tid; e < 64 * 16; e += NTHREADS) {
                    const int pos = e >> 4, i = e & 15;
                    double invd = (i & 3) == 0 ? 1.0 : (i & 3) == 1 ? 0.56234132519034908 : (i & 3) == 2 ? 0.31622776601683794 : 0.17782794100389228;
                    invd *= (i >> 2) == 0 ? 1.0 : (i >> 2) == 1 ? 0.1 : (i >> 2) == 2 ? 0.01 : 0.001;
                    const float invf = (float)invd; const float ang = (float)pos * invf;
                    double s, c; sincos_d((double)ang, s, c);
                    ROPE[e] = (f32x2){(float)c, (float)s};
                }
            }
        } break;
        case 1: {
            KARG_BASE(); unsigned char* ws = WS_PTR(); const float* attn_qn = IN_PTR(4); const float* attn_kn = IN_PTR(5);
            const bf16_t* XB = WSP(bf16_t, WS_XB); const bf16_t* Wqkv = WSP(bf16_t, W_QKV); const float* SSQ0 = WSP(float, WS_SSQ); const f32x2* ROPE = WSP(f32x2, WS_ROPE);
            bf16_t* Qb = WSP(bf16_t, WS_BIG); bf16_t* Kb = WSP(bf16_t, WS_BIG + 32 * MiB); bf16_t* Vb = WSP(bf16_t, WS_BIG + 40 * MiB);
            if (FAST_GEMM & 1) { pg8::Gemm g{XB, Wqkv, M, QKV_N, D}; pg8::StaticOrder S; S.init(M, QKV_N, G, wg);
                pg8::EpiQKV8 E{SSQ0, attn_qn, attn_kn, ROPE, Qb, Kb, Vb};
                pg8::gemm_phase<pg8::EpiQKV8, pg8::StaticOrder, true, true>(lds, g, S, E, tid); }
            else { EpiQKV E{SSQ0, attn_qn, attn_kn, ROPE, Qb, Kb, Vb}; gemm_simple(XB, Wqkv, M, QKV_N, D, E, gw, ngw, lane); }
        } break;
        case 2: {
            KARG_BASE(); unsigned char* ws = WS_PTR();
            bf16_t* Qb = WSP(bf16_t, WS_BIG); bf16_t* Kb = WSP(bf16_t, WS_BIG + 32 * MiB); bf16_t* Vb = WSP(bf16_t, WS_BIG + 40 * MiB);
#ifndef FAST_ATTN
#define FAST_ATTN 1
#endif
            if (FAST_ATTN) {
                const attn_body::AttnTensors AT{(const attn_body::bf16*)Qb, (const attn_body::bf16*)Kb, (const attn_body::bf16*)Vb, (attn_body::bf16*)Qb};
                const attn_body::StaticOrder S(G, wg);
                attn_body::attn_phase<attn_body::StaticOrder>((char*)lds_raw, AT, S, tid);
            } else attn_simple(Qb, Kb, Vb, Qb, gw, ngw, lane);
        } break;
        case 3: case 5: case 10: case 12: {
            KARG_BASE(); unsigned char* ws = WS_PTR(); float* out = OUT_PTR();
            const bf16_t* A = WSP(bf16_t, ph == 10 ? WS_QK : WS_BIG);
            const bf16_t* Bt = WSP(bf16_t, ph == 3 ? W_O0 : ph == 5 ? W_2A : ph == 10 ? W_O1 : W_2B);
            const int K = (ph == 3 || ph == 10) ? D : FF;
            const float* base = ph == 3 ? IN_PTR(0) : out;
            bf16_t* xb = ph == 12 ? nullptr : WSP(bf16_t, WS_XB);
            float* ssq = ph == 12 ? nullptr : WSP(float, WS_SSQ + (ph == 3 ? 1 : ph == 5 ? 2 : 3) * (size_t)M * 64);
            if (FAST_GEMM & 2) { pg8::Gemm g{A, Bt, M, D, K}; pg8::StaticOrder S; S.init(M, D, G, wg);
                pg8::EpiRes8 E{base, out, xb, ssq};
                pg8::gemm_phase<pg8::EpiRes8, pg8::StaticOrder, true, true>(lds, g, S, E, tid); }
            else { EpiRes E{base, out, xb, ssq}; gemm_simple(A, Bt, M, D, K, E, gw, ngw, lane); }
        } break;
        case 4: case 11: {
            KARG_BASE(); unsigned char* ws = WS_PTR();
            const bf16_t* XB = WSP(bf16_t, WS_XB); bf16_t* HB = WSP(bf16_t, WS_BIG);
            const bf16_t* Bt = WSP(bf16_t, ph == 4 ? W_1A : W_1B); const float* ssq = WSP(float, WS_SSQ + (ph == 4 ? 1 : 3) * (size_t)M * 64);
            if (FAST_GEMM & 4) { pg8::Gemm g{XB, Bt, M, FF, D}; pg8::StaticOrder S; S.init(M, FF, G, wg);
                pg8::EpiUp8 E{ssq, HB};
                pg8::gemm_phase<pg8::EpiUp8, pg8::StaticOrder, true, true>(lds, g, S, E, tid); }
            else { EpiUp E{ssq, HB}; gemm_simple(XB, Bt, M, FF, D, E, gw, ngw, lane); }
        } break;
        case 6: {
            KARG_BASE(); unsigned char* ws = WS_PTR();
            const bf16_t* XB = WSP(bf16_t, WS_XB); const bf16_t* Wgin = WSP(bf16_t, W_GIN); const float* SSQ2 = WSP(float, WS_SSQ + 2 * (size_t)M * 64); float* Zb = WSP(float, WS_Z);
            bf16_t* Gv = WSP(bf16_t, WS_BIG); bf16_t* Gr = WSP(bf16_t, WS_BIG + 32 * MiB); bf16_t* Gq = WSP(bf16_t, WS_QK); bf16_t* Gk = WSP(bf16_t, WS_QK + 16 * MiB);
            if (FAST_GEMM & 8) { pg8::Gemm g{XB, Wgin, M, 3072, D}; pg8::StaticOrder S; S.init(M, 3072, G, wg);
                pg8::EpiGin8 E{SSQ2, Gq, Gk, Gv, Gr};
                pg8::gemm_phase<pg8::EpiGin8, pg8::StaticOrder, true, true>(lds, g, S, E, tid); }
            else { EpiGin E{SSQ2, Gq, Gk, Gv, Gr}; gemm_simple(XB, Wgin, M, 3072, D, E, gw, ngw, lane); }
#ifndef FAST_PRE
#define FAST_PRE 1
#endif
            if (!FAST_PRE) { EpiZ Ez{SSQ2, Zb}; gemm_simple(XB, Wgin + (size_t)3072 * D, M, 64, D, Ez, gw, ngw, lane); }
        } break;
        case 7: {
            KARG_BASE(); unsigned char* ws = WS_PTR();
            if (FAST_PRE) gla_pre2(WSP(bf16_t, WS_XB), WSP(bf16_t, W_GIN) + (size_t)3072 * D, WSP(float, WS_SSQ + 2 * (size_t)M * 64), WSP(bf16_t, WS_QK), WSP(bf16_t, WS_QK + 16 * MiB), IN_PTR(8), IN_PTR(9), WSP(bf16_t, WS_BIG + 64 * MiB), WSP(bf16_t, WS_BIG + 96 * MiB), WSP(float, WS_DECAY), lds, wg, G, tid);
            else gla_pre(WSP(bf16_t, WS_QK), WSP(bf16_t, WS_QK + 16 * MiB), WSP(float, WS_Z), IN_PTR(8), IN_PTR(9), WSP(bf16_t, WS_BIG + 64 * MiB), WSP(bf16_t, WS_BIG + 96 * MiB), WSP(float, WS_DECAY), wg, G, tid);
        } break;
        case 8: {
            KARG_BASE(); unsigned char* ws = WS_PTR();
#ifndef FAST_SCAN
#define FAST_SCAN 1
#endif
            if (FAST_SCAN) gla_scan_mfma(WSP(bf16_t, WS_BIG + 64 * MiB), WSP(bf16_t, WS_BIG + 96 * MiB), WSP(bf16_t, WS_BIG), WSP(float, WS_DECAY), WSP(bf16_t, WS_QK), WSP(bf16_t, WS_XB), lds, wg, G, tid);
            else gla_scan_simple(WSP(bf16_t, WS_BIG + 64 * MiB), WSP(bf16_t, WS_BIG + 96 * MiB), WSP(bf16_t, WS_BIG), WSP(float, WS_DECAY), WSP(bf16_t, WS_QK), WSP(bf16_t, WS_XB), lds, wg, G, tid);
        } break;
        case 9: {
            KARG_BASE(); unsigned char* ws = WS_PTR();
            gla_combine(WSP(bf16_t, WS_QK), WSP(bf16_t, WS_XB), WSP(bf16_t, WS_BIG + 32 * MiB), IN_PTR(10), gw, ngw, lane);
        } break;
        default: {
            KARG_BASE(); float* out = OUT_PTR(); const float* final_norm = IN_PTR(14);
            for (int m = gw; m < M; m += ngw) {
                f32x4* xr = (f32x4*)(out + (size_t)m * D) + lane;
                f32x4 v[4]; float s = 0.f;
#pragma unroll
                for (int j = 0; j < 4; ++j) { v[j] = xr[64 * j]; s += (v[j].x * v[j].x + v[j].y * v[j].y) + (v[j].z * v[j].z + v[j].w * v[j].w); }
                s = wave_sum(s);
                const float rs = 1.0f / sqrtf(s * (1.0f / D) + EPS);
#pragma unroll
                for (int j = 0; j < 4; ++j) { const f32x4 g = *((const f32x4*)final_norm + lane + 64 * j); xr[64 * j] = v[j] * rs * g; }
            }
        } break;
        }
#ifndef REPEAT_MASK
#define REPEAT_MASK 0
#endif
        if (REPEAT_MASK && ((REPEAT_MASK >> ph) & 1) && !rep_done) { rep_done = true; xcd_barrier(bar); --ph; continue; }
        rep_done = false;
        if (ph + 1 < hi) xcd_barrier(bar);
    }
}

#ifndef MK_SINGLE
#define MK_SINGLE 1
#endif
extern "C" void kernel_launch(void* const* d_in, const int* in_sizes, int n_in, void* d_out, int out_size, void* d_ws, size_t ws_size, hipStream_t stream) {
    static int grid = 0;
    if (grid == 0) {
        if (n_in != 15 || in_sizes[0] != M * D || out_size != M * D || ws_size < WS_END) { fprintf(stderr, "kernel_launch: unexpected shapes (n_in %d, in0 %d, out %d, ws %zu)\n", n_in, n_in > 0 ? in_sizes[0] : -1, out_size, ws_size); grid = -1; return; }
        int dev = 0, cus = 0, per_cu = 0;
        if (hipGetDevice(&dev) != hipSuccess || hipDeviceGetAttribute(&cus, hipDeviceAttributeMultiprocessorCount, dev) != hipSuccess) { grid = -1; return; }
        if (hipFuncSetAttribute((const void*)fwd_kernel, hipFuncAttributeMaxDynamicSharedMemorySize, LDS_BYTES) != hipSuccess) { fprintf(stderr, "kernel_launch: hipFuncSetAttribute failed\n"); grid = -1; return; }
        if (hipOccupancyMaxActiveBlocksPerMultiprocessor(&per_cu, (const void*)fwd_kernel, NTHREADS, LDS_BYTES) != hipSuccess || per_cu < 1) { fprintf(stderr, "kernel_launch: occupancy query says %d\n", per_cu); }
        (void)hipGetLastError();
        grid = cus;
    }
    if (grid < 0) return;
    (void)hipMemsetAsync((char*)d_ws + WS_CTL, 0, CTL_ZERO_BYTES, stream);
    Args a{};
    for (int i = 0; i < 15; ++i) a.in[i] = (const float*)d_in[i];
    a.out = (float*)d_out; a.ws = (unsigned char*)d_ws;
#if MK_SINGLE
    a.ph_lo = 0; a.ph_hi = NPHASES;
    hipLaunchKernelGGL(fwd_kernel, dim3(grid), dim3(NTHREADS), LDS_BYTES, stream, a);
#else
    for (int p = 0; p < NPHASES; ++p) { a.ph_lo = p; a.ph_hi = p + 1; hipLaunchKernelGGL(fwd_kernel, dim3(grid), dim3(NTHREADS), LDS_BYTES, stream, a); }
#endif
}
```

```cpp
#include <hip/hip_runtime.h>
#include <cstdio>
#include <cstdint>
#include <hip/hip_bf16.h>
#include <cmath>

#define GAS __attribute__((address_space(1)))
#define LAS __attribute__((address_space(3)))
typedef unsigned short bf16_t;
typedef short bf16x8 __attribute__((ext_vector_type(8)));
typedef float f32x4 __attribute__((ext_vector_type(4)));
typedef float f32x2 __attribute__((ext_vector_type(2)));
typedef unsigned u32x4 __attribute__((ext_vector_type(4)));
typedef unsigned u32x2 __attribute__((ext_vector_type(2)));

constexpr int BATCH = 4, SEQ = 4096, D = 1024, M = BATCH * SEQ;
constexpr int NH = 16, NKV = 4, HD = 64, QKV_N = 1536, KVP = NKV * HD;
constexpr int GH = 4, GDK = 128, GDV = 256, GQK = 512, GV = 1024, RANK = 16, GIN = 3104, CH = 64, NCH = SEQ / CH;
constexpr int FF = 4096;
constexpr float EPS = 1e-6f;
constexpr float C2 = 0.125f * 1.4426950408889634f;
constexpr int NWAVES = 8, NTHREADS = 512;
constexpr int NPHASES = 14;

constexpr size_t MiB = 1u << 20;
constexpr size_t WS_CTL = 0, CTL_ZERO_BYTES = 1 * MiB;
constexpr size_t WS_ROPE = 1 * MiB;
constexpr size_t WS_SSQ = 2 * MiB;
constexpr size_t WS_Z = 7 * MiB;
constexpr size_t WS_DECAY = 11 * MiB;
constexpr size_t WS_W = 12 * MiB;
constexpr size_t W_QKV = WS_W, W_O0 = W_QKV + 3 * MiB, W_1A = W_O0 + 2 * MiB, W_2A = W_1A + 8 * MiB, W_GIN = W_2A + 8 * MiB,
                 W_O1 = W_GIN + 6 * MiB + 128 * 1024, W_1B = W_O1 + 2 * MiB, W_2B = W_1B + 8 * MiB, W_END = W_2B + 8 * MiB;
constexpr size_t WS_XB = 58 * MiB;
constexpr size_t WS_BIG = 90 * MiB;
constexpr size_t WS_QK = 218 * MiB;
constexpr size_t WS_END = 250 * MiB;
static_assert(W_END <= WS_XB, "weights fit");

__device__ __forceinline__ unsigned f2bf(float f) { unsigned u = __builtin_bit_cast(unsigned, f); return (u + 0x7fffu + ((u >> 16) & 1u)) >> 16; }
__device__ __forceinline__ unsigned pk2(float lo, float hi) { return f2bf(lo) | (f2bf(hi) << 16); }
__device__ __forceinline__ float bf2f(unsigned short u) { return __uint_as_float((unsigned)u << 16); }
__device__ __forceinline__ float bflo(unsigned w) { return __uint_as_float(w << 16); }
__device__ __forceinline__ float bfhi(unsigned w) { return __uint_as_float(w & 0xffff0000u); }
#define LDS_WAIT() asm volatile("s_waitcnt lgkmcnt(0)" ::: "memory")
#define VM_WAIT() asm volatile("s_waitcnt vmcnt(0)" ::: "memory")
__device__ __forceinline__ float wave_sum(float v) {
#pragma unroll
    for (int o = 1; o < 64; o <<= 1) v += __shfl_xor(v, o);
    return v;
}
__device__ __forceinline__ float rstd_from_slots(const float* ssq, int row) {
    const f32x4* p = (const f32x4*)(ssq + (size_t)row * 16);
    const f32x4 a = p[0], b = p[1], c = p[2], d = p[3];
    const float s = (((a.x + a.y) + (a.z + a.w)) + ((b.x + b.y) + (b.z + b.w))) + (((c.x + c.y) + (c.z + c.w)) + ((d.x + d.y) + (d.z + d.w)));
    return 1.0f / sqrtf(s * (1.0f / D) + EPS);
}

#define RLX_AGENT __ATOMIC_RELAXED, __HIP_MEMORY_SCOPE_AGENT
#define XB_TMO      128
#define XB_XCNT(j)  (256  + 64 * (j))
#define XB_XSUB(j)  (1280 + 64 * (j))
#define XB_XGEN(j)  (2304 + 64 * (j))
#define XB_TOP      3328
#define XB_TOPGEN   3392
#define XCD_BAR_WORDS 3456
#define XB_SPIN_CAP (1u << 22)
__device__ __forceinline__ unsigned xb_ld(unsigned* p)              { return __hip_atomic_load(p, __ATOMIC_RELAXED, __HIP_MEMORY_SCOPE_AGENT); }
__device__ __forceinline__ unsigned xb_add(unsigned* p, unsigned v) { return __hip_atomic_fetch_add(p, v, __ATOMIC_RELAXED, __HIP_MEMORY_SCOPE_AGENT); }
__device__ __forceinline__ unsigned xb_xcc_id() { return (unsigned)__builtin_amdgcn_s_getreg((3 << 11) | 20) & 0xFu; }
#define XB_SPIN(cond, bar) do { unsigned _sp = 0; while (cond) { __builtin_amdgcn_s_sleep(1); \
    if ((++_sp & 255u) == 0u) { if (xb_ld(&(bar)[XB_TMO])) break; if (_sp > XB_SPIN_CAP) { atomicAdd(&(bar)[XB_TMO], 1u); break; } } } } while (0)
struct XcdBarrier { unsigned* bar; unsigned x; volatile LAS unsigned* st; };
__device__ __forceinline__ XcdBarrier xcd_barrier_post(unsigned* bar, volatile LAS unsigned* st) {
    XcdBarrier b; b.bar = bar; b.x = xb_xcc_id(); b.st = st;
    if (threadIdx.x == 0) (void)xb_add(&bar[XB_XCNT(b.x)], 1u);
    return b;
}
__device__ __forceinline__ void xcd_barrier_complete(unsigned* bar, unsigned x, unsigned& nloc, unsigned& nx) {
    const unsigned G = gridDim.x * gridDim.y * gridDim.z;
    unsigned sum, cnt, mine, sp = 0u;
    for (;;) {
        sum = 0u; cnt = 0u; mine = 0u;
#pragma unroll
        for (unsigned j = 0; j < 16; ++j) { const unsigned c = xb_ld(&bar[XB_XCNT(j)]); sum += c; cnt += (c > 0u) ? 1u : 0u; mine = (j == x) ? c : mine; }
        if (sum == G) break;
        __builtin_amdgcn_s_sleep(1);
        if ((++sp & 255u) == 0u) { if (xb_ld(&bar[XB_TMO])) break; if (sp > XB_SPIN_CAP) { atomicAdd(&bar[XB_TMO], 1u); break; } }
    }
    nloc = mine > 0u ? mine : 1u; nx = cnt > 0u ? cnt : 1u;
}
__device__ __forceinline__ void xcd_barrier(const XcdBarrier& b) {
    asm volatile("s_waitcnt vmcnt(0)" ::: "memory");
    __syncthreads();
    if (threadIdx.x == 0) {
        unsigned* bar = b.bar;
        __builtin_amdgcn_s_waitcnt(0);
        unsigned nloc = b.st[0], nx = b.st[1];
        if (nloc == 0u) { xcd_barrier_complete(bar, b.x, nloc, nx); b.st[0] = nloc; b.st[1] = nx; }
        const unsigned old = xb_add(&bar[XB_XSUB(b.x)], 1u);
        const unsigned gen = old / nloc;
        if (old + 1u == (gen + 1u) * nloc) {
            __builtin_amdgcn_fence(__ATOMIC_RELEASE, "agent");
            asm volatile("s_waitcnt vmcnt(0)" ::: "memory");
            const unsigned og = xb_add(&bar[XB_TOP], 1u);
            const unsigned tg = og / nx;
            if (og + 1u == (tg + 1u) * nx) xb_add(&bar[XB_TOPGEN], 1u);
            else XB_SPIN(xb_ld(&bar[XB_TOPGEN]) == tg, bar);
            __builtin_amdgcn_fence(__ATOMIC_ACQUIRE, "agent");
            xb_add(&bar[XB_XGEN(b.x)], 1u);
            asm volatile("s_waitcnt vmcnt(0)" ::: "memory");
        } else {
            XB_SPIN(xb_ld(&bar[XB_XGEN(b.x)]) == gen, bar);
            __builtin_amdgcn_fence(__ATOMIC_ACQUIRE, "agent");
            asm volatile("s_waitcnt vmcnt(0)" ::: "memory");
        }
    }
    __syncthreads();
}

constexpr int RING_BYTES = 131072;
constexpr int LDSCTL_OFF = RING_BYTES, MISC_OFF = LDSCTL_OFF + 320;
constexpr int LDS_BYTES = 147456;

namespace pg8 {
#define PG8_LAS __attribute__((address_space(3)))
typedef unsigned short bf16_t;
typedef short bf16x8 __attribute__((ext_vector_type(8)));
typedef float f32x4 __attribute__((ext_vector_type(4)));
typedef unsigned u32x4 __attribute__((ext_vector_type(4)));
constexpr int BM = 256, BK = 64, HALF = 128, HTB = HALF * BK * 2  , STAGE_BYTES = 8 * HTB, NXCD = 8, WGM = 8;

__host__ __device__ __forceinline__ int lds_byte(int r, int c) { const int st = (r >> 4) * 2 + (c >> 5), rr = r & 15, cc = c & 31, ob = rr * 64 + cc * 2; return st * 1024 + (ob ^ (((ob >> 9) & 1) << 5)); }
__host__ __device__ __forceinline__ void stage_rc(int b, int& R, int& C) { const int st = b / 1024, sb = b % 1024, swz = sb ^ (((sb >> 9) & 1) << 5); R = (st >> 1) * 16 + swz / 64; C = (st & 1) * 32 + (swz % 64) / 2; }
__host__ __device__ __forceinline__ int perm32(int rho) { const int n = rho >> 4, i = rho & 15; return 8 * (i >> 2) + 4 * n + (i & 3); }

struct Unit { int pm, pn; };
struct Gemm { const bf16_t* A; const bf16_t* Bt; int M, N, K; };

struct StaticOrder {
    int nM, nN, nwg, G, c;
    __host__ __device__ void init(int M, int N, int G_, int c_) { nM = M / BM; nN = N / BM; nwg = nM * nN; G = G_; c = c_; }
    __host__ __device__ bool next(int i, Unit& u) const {
        const long L = (long)i * G + c; if (L >= nwg) return false;
        int wgid = (int)L; { const int q = nwg / NXCD, r = nwg % NXCD, xcd = wgid % NXCD, off = wgid / NXCD; wgid = (xcd < r ? xcd * (q + 1) : r * (q + 1) + (xcd - r) * q) + off; }
        const int nig = WGM * nN, gid = wgid / nig, fm = gid * WGM, gsz = (nM - fm) < WGM ? (nM - fm) : WGM;
        u.pm = fm + ((wgid % nig) % gsz); u.pn = (wgid % nig) / gsz; return true;
    }
    __device__ __forceinline__ void a_ready(const Unit&) const {}
    __device__ __forceinline__ void done(const Unit&) const {}
};
__device__ __forceinline__ unsigned cvt_pk_bf16(float lo, float hi) { unsigned r; asm volatile("v_cvt_pk_bf16_f32 %0, %1, %2" : "=v"(r) : "v"(lo), "v"(hi)); return r; }
typedef float f32x2 __attribute__((ext_vector_type(2)));
template <class Epi, class Sched, bool ALIGN_EPI = false, bool SP2 = false>
__device__ __forceinline__ void gemm_phase(PG8_LAS unsigned char* lds, const Gemm g, const Sched& S, const Epi& E, const int tid) {
    const int wid = __builtin_amdgcn_readfirstlane(tid >> 6), lane = tid & 63, wr = wid >> 2, wc = wid & 3, fr = lane & 15, fq = lane >> 4;
    const int K = g.K, nt = K / BK;
    unsigned voffA[2], voffB[2];
#pragma unroll
    for (int i = 0; i < 2; ++i) { int R, C; stage_rc(tid * 16 + i * 8192, R, C); const int Rb = Epi::BMODE == 1 ? ((R & ~31) + perm32(R & 31)) : Epi::BMODE == 2 ? (64 * (R >> 5) + (R & 31)) : R;
        voffA[i] = (unsigned)(R * K + C) * 2u; voffB[i] = (unsigned)(Rb * K + C) * 2u; }
    const size_t kstep = (size_t)(BK * 2);
    const size_t hstep = (size_t)HALF * K * 2;
    const size_t tstep = 2 * hstep;
    const size_t bhstep = Epi::BMODE == 2 ? (size_t)32 * K * 2 : hstep;
    const unsigned ldsw = (unsigned)wid * 1024u;
    const int aoff = lds_byte(wr * 64 + fr, fq * 8), boff = lds_byte(wc * 32 + fr, fq * 8);
#define PG8_SA(b, h) (((b) * 2 + (h)) * HTB)
#define PG8_SB(b, h) ((4 + (b) * 2 + (h)) * HTB)
#define PG8_STAGE(bufoff, gbase, voff) do { _Pragma("unroll") for (int _i = 0; _i < 2; ++_i) \
        __builtin_amdgcn_global_load_lds((const unsigned*)((const char*)(gbase) + (voff)[_i]), (PG8_LAS unsigned*)(lds + (bufoff) + ldsw + _i * 8192), 16, 0, 0); } while (0)
#define PG8_LDA(dst, b, h) do { _Pragma("unroll") for (int m = 0; m < 4; ++m) _Pragma("unroll") for (int k = 0; k < 2; ++k) dst[m][k] = *(const PG8_LAS bf16x8*)(lds + PG8_SA(b, h) + aoff + m * 2048 + k * 1024); } while (0)
#define PG8_LDB(dst, b, h) do { _Pragma("unroll") for (int n = 0; n < 2; ++n) _Pragma("unroll") for (int k = 0; k < 2; ++k) dst[n][k] = *(const PG8_LAS bf16x8*)(lds + PG8_SB(b, h) + boff + n * 2048 + k * 1024); } while (0)
#define PG8_MMA(ai, bj, At, Bt) do { __builtin_amdgcn_s_setprio(1); _Pragma("unroll") for (int m = 0; m < 4; ++m) _Pragma("unroll") for (int n = 0; n < 2; ++n) _Pragma("unroll") for (int k = 0; k < 2; ++k) \
        acc[ai][bj][m][n] = __builtin_amdgcn_mfma_f32_16x16x32_bf16(Bt[n][k], At[m][k], acc[ai][bj][m][n], 0, 0, 0); __builtin_amdgcn_s_setprio(0); } while (0)
#define PG8_WAIT_V(n) asm volatile("s_waitcnt vmcnt(" #n ")" ::: "memory")
#define PG8_WAIT_L(n) asm volatile("s_waitcnt lgkmcnt(" #n ")" ::: "memory")
#define PG8_BAR __builtin_amdgcn_s_barrier()
#define PG8_SCHED __builtin_amdgcn_sched_barrier(0)
    Unit cur, nxt; int ui = 0;
    if (!S.next(0, cur)) return;
    f32x4 acc[2][2][4][2];
#pragma unroll
    for (int a = 0; a < 2; ++a)
#pragma unroll
        for (int b = 0; b < 2; ++b)
#pragma unroll
            for (int m = 0; m < 4; ++m)
#pragma unroll
                for (int n = 0; n < 2; ++n) acc[a][b][m][n] = (f32x4){0.f, 0.f, 0.f, 0.f};
    bf16x8 At[4][2], B0[2][2], B1[2][2];
    const char* cA = (const char*)g.A + (size_t)cur.pm * tstep; const char* cB = (const char*)g.Bt + (size_t)cur.pn * tstep;
    S.a_ready(cur);
    if constexpr (SP2) {
        PG8_STAGE(PG8_SB(0, 0), cB, voffB); PG8_STAGE(PG8_SB(0, 1), cB + bhstep, voffB); PG8_STAGE(PG8_SA(0, 0), cA, voffA); PG8_STAGE(PG8_SA(0, 1), cA + hstep, voffA);
        if (wr == 1) PG8_BAR;
        PG8_WAIT_V(2); PG8_BAR;
        PG8_STAGE(PG8_SB(1, 0), cB + kstep, voffB); PG8_STAGE(PG8_SA(1, 0), cA + kstep, voffA); PG8_STAGE(PG8_SB(1, 1), cB + bhstep + kstep, voffB);
        PG8_WAIT_V(6); PG8_BAR;
    } else {
        PG8_STAGE(PG8_SB(0, 0), cB, voffB); PG8_STAGE(PG8_SA(0, 0), cA, voffA); PG8_STAGE(PG8_SB(0, 1), cB + bhstep, voffB); PG8_STAGE(PG8_SA(0, 1), cA + hstep, voffA);
        if (wr == 1) PG8_BAR;
        PG8_WAIT_V(4); PG8_BAR;
        PG8_STAGE(PG8_SB(1, 0), cB + kstep, voffB); PG8_STAGE(PG8_SA(1, 0), cA + kstep, voffA); PG8_STAGE(PG8_SB(1, 1), cB + bhstep + kstep, voffB);
        PG8_WAIT_V(6); PG8_BAR;
    }
    for (;;) {
        const bool has_next = S.next(ui + 1, nxt);
        const char* nA = has_next ? (const char*)g.A + (size_t)nxt.pm * tstep : cA; const char* nB = has_next ? (const char*)g.Bt + (size_t)nxt.pn * tstep : cB;
        for (int t = 0; t < nt; t += 2) {
            const bool last = (t == nt - 2);
            const char* a1 = cA + (size_t)(t + 1) * kstep;
            const char* a2 = last ? nA : cA + (size_t)(t + 2) * kstep; const char* b2 = last ? nB : cB + (size_t)(t + 2) * kstep;
            const char* a3 = a2 + kstep; const char* b3 = b2 + kstep;
            if (last && has_next) S.a_ready(nxt);
            if constexpr (SP2) {
            PG8_LDB(B0, 0, 0); PG8_LDB(B1, 0, 1); PG8_SCHED; PG8_LDA(At, 0, 0); PG8_STAGE(PG8_SA(1, 1), a1 + hstep, voffA);
            PG8_WAIT_V(8); PG8_WAIT_L(0); PG8_BAR; PG8_MMA(0, 0, At, B0); PG8_MMA(0, 1, At, B1); PG8_BAR; PG8_SCHED;
            PG8_LDA(At, 0, 1); PG8_STAGE(PG8_SB(0, 0), b2, voffB); PG8_STAGE(PG8_SB(0, 1), b2 + bhstep, voffB); PG8_STAGE(PG8_SA(0, 0), a2, voffA);
            PG8_WAIT_V(8); PG8_WAIT_L(0); PG8_BAR; PG8_MMA(1, 0, At, B0); PG8_MMA(1, 1, At, B1); PG8_BAR; PG8_SCHED;
            PG8_LDB(B0, 1, 0); PG8_LDB(B1, 1, 1); PG8_SCHED; PG8_LDA(At, 1, 0); PG8_STAGE(PG8_SA(0, 1), a2 + hstep, voffA);
            PG8_WAIT_V(8); PG8_WAIT_L(0); PG8_BAR; PG8_MMA(0, 0, At, B0); PG8_MMA(0, 1, At, B1); PG8_BAR; PG8_SCHED;
            PG8_LDA(At, 1, 1); PG8_STAGE(PG8_SB(1, 0), b3, voffB); PG8_STAGE(PG8_SB(1, 1), b3 + bhstep, voffB); PG8_STAGE(PG8_SA(1, 0), a3, voffA);
            PG8_WAIT_V(8); PG8_WAIT_L(0); PG8_BAR; PG8_MMA(1, 0, At, B0); PG8_MMA(1, 1, At, B1); PG8_BAR; PG8_SCHED;
            } else {
            PG8_LDB(B0, 0, 0); PG8_SCHED; PG8_LDA(At, 0, 0); PG8_STAGE(PG8_SA(1, 1), a1 + hstep, voffA);
            PG8_WAIT_L(8); PG8_BAR; PG8_WAIT_L(0); PG8_MMA(0, 0, At, B0); PG8_BAR; PG8_SCHED;
            PG8_LDB(B1, 0, 1); PG8_STAGE(PG8_SB(0, 0), b2, voffB);
            PG8_BAR; PG8_WAIT_L(0); PG8_MMA(0, 1, At, B1); PG8_BAR;
            PG8_LDA(At, 0, 1); PG8_STAGE(PG8_SA(0, 0), a2, voffA);
            PG8_BAR; PG8_WAIT_L(0); PG8_MMA(1, 0, At, B0); PG8_BAR; PG8_SCHED;
            PG8_STAGE(PG8_SB(0, 1), b2 + bhstep, voffB);
            PG8_WAIT_V(6); PG8_BAR; PG8_MMA(1, 1, At, B1); PG8_BAR;
            PG8_LDB(B0, 1, 0); PG8_SCHED; PG8_LDA(At, 1, 0); PG8_STAGE(PG8_SA(0, 1), a2 + hstep, voffA);
            PG8_WAIT_L(8); PG8_BAR; PG8_WAIT_L(0); PG8_MMA(0, 0, At, B0); PG8_BAR; PG8_SCHED;
            PG8_LDB(B1, 1, 1); PG8_STAGE(PG8_SB(1, 0), b3, voffB);
            PG8_BAR; PG8_WAIT_L(0); PG8_MMA(0, 1, At, B1); PG8_BAR;
            PG8_LDA(At, 1, 1); PG8_STAGE(PG8_SA(1, 0), a3, voffA);
            PG8_BAR; PG8_WAIT_L(0); PG8_MMA(1, 0, At, B0); PG8_BAR; PG8_SCHED;
            PG8_STAGE(PG8_SB(1, 1), b3 + bhstep, voffB);
            PG8_WAIT_V(6); PG8_BAR; PG8_MMA(1, 1, At, B1); PG8_BAR;
            }
        }
        if constexpr (ALIGN_EPI) { if (wr == 0) PG8_BAR; }
        if constexpr (!Epi::AFTER_DRAIN) { E(acc, cur, wr, wc, fr, fq); S.done(cur); }
        if (!has_next) break;
#pragma unroll
        for (int a = 0; a < 2; ++a)
#pragma unroll
            for (int b = 0; b < 2; ++b)
#pragma unroll
                for (int m = 0; m < 4; ++m)
#pragma unroll
                    for (int n = 0; n < 2; ++n) acc[a][b][m][n] = (f32x4){0.f, 0.f, 0.f, 0.f};
        cur = nxt; cA = nA; cB = nB; ++ui;
        if constexpr (ALIGN_EPI) { if (wr == 1) PG8_BAR; }
    }
    PG8_WAIT_V(0);
    if constexpr (!ALIGN_EPI) { if (wr == 0) PG8_BAR; }
    PG8_BAR;
    if constexpr (Epi::AFTER_DRAIN) { E.fused(acc, cur, wr, wc, fr, fq, lds, wid, lane); S.done(cur); }
#undef PG8_SA
#undef PG8_SB
#undef PG8_STAGE
#undef PG8_LDA
#undef PG8_LDB
#undef PG8_MMA
#undef PG8_WAIT_V
#undef PG8_WAIT_L
#undef PG8_BAR
#undef PG8_SCHED
}
}

namespace pg8 {
typedef unsigned u32x2 __attribute__((ext_vector_type(2)));
struct EpiQKV8 {
    static constexpr int BMODE = 2; static constexpr bool PERM = false, AFTER_DRAIN = false;
    const float* ssq; const float* qg; const float* kg; const ::f32x2* rope; bf16_t* Q; bf16_t* Kb; bf16_t* Vb;
    __device__ __forceinline__ void operator()(const f32x4 (&acc)[2][2][4][2], const Unit& u, int wr, int wc, int fr, int fq) const {
        const int pn = u.pn;
#pragma unroll
        for (int ai = 0; ai < 2; ++ai)
#pragma unroll
            for (int m = 0; m < 4; ++m) {
                const int row = u.pm * BM + ai * HALF + wr * 64 + m * 16 + fr; const float rs = rstd_from_slots(ssq, row);
                f32x4 v[2][2];
#pragma unroll
                for (int bj = 0; bj < 2; ++bj)
#pragma unroll
                    for (int n = 0; n < 2; ++n) v[bj][n] = acc[ai][bj][m][n] * rs;
                if (pn < 5) {
                    const bool isq = pn < 4; const float* g = isq ? qg : kg;
                    float ss = 0.f;
#pragma unroll
                    for (int bj = 0; bj < 2; ++bj)
#pragma unroll
                        for (int n = 0; n < 2; ++n) ss += (v[bj][n].x * v[bj][n].x + v[bj][n].y * v[bj][n].y) + (v[bj][n].z * v[bj][n].z + v[bj][n].w * v[bj][n].w);
                    ss += __shfl_xor(ss, 16); ss += __shfl_xor(ss, 32);
                    const float r = 1.0f / sqrtf(ss * (1.0f / 64.0f) + EPS);
#pragma unroll
                    for (int bj = 0; bj < 2; ++bj)
#pragma unroll
                        for (int n = 0; n < 2; ++n) { const f32x4 gv = *(const f32x4*)(g + 32 * bj + 16 * n + 4 * fq); v[bj][n] = v[bj][n] * r * gv; }
                    const int t = row % SEQ, prow = t >> 6, pcol = t & 63;
                    const float sc = isq ? C2 : 1.0f;
#pragma unroll
                    for (int bj = 0; bj < 2; ++bj) {
                        const int pos = bj == 0 ? prow : pcol;
                        const f32x4 cs01 = *(const f32x4*)(rope + pos * 16 + 4 * fq), cs23 = *(const f32x4*)(rope + pos * 16 + 4 * fq + 2);
                        const float cc[4] = {cs01.x, cs01.z, cs23.x, cs23.z}, sn[4] = {cs01.y, cs01.w, cs23.y, cs23.w};
                        const f32x4 x1 = v[bj][0], x2 = v[bj][1]; f32x4 o1, o2;
#pragma unroll
                        for (int j = 0; j < 4; ++j) { o1[j] = (x1[j] * cc[j] - x2[j] * sn[j]) * sc; o2[j] = (x2[j] * cc[j] + x1[j] * sn[j]) * sc; }
                        v[bj][0] = o1; v[bj][1] = o2;
                    }
                }
                bf16_t* dst = pn < 4 ? Q + (size_t)row * D + pn * 256 + wc * 64 : pn == 4 ? Kb + (size_t)row * KVP + wc * 64 : Vb + (size_t)row * KVP + wc * 64;
#pragma unroll
                for (int bj = 0; bj < 2; ++bj)
#pragma unroll
                    for (int n = 0; n < 2; ++n) { u32x2 w; w.x = cvt_pk_bf16(v[bj][n].x, v[bj][n].y); w.y = cvt_pk_bf16(v[bj][n].z, v[bj][n].w); *(u32x2*)(dst + 32 * bj + 16 * n + 4 * fq) = w; }
            }
    }
};
struct EpiRes8 {
    static constexpr int BMODE = 0; static constexpr bool PERM = false, AFTER_DRAIN = false;
    const float* basef; bf16_t* xb; float* ssq;
    __device__ __forceinline__ void operator()(const f32x4 (&acc)[2][2][4][2], const Unit& u, int wr, int wc, int fr, int fq) const {
        const int col0 = u.pn * BM + wc * 32 + 4 * fq;
#pragma unroll
        for (int ai = 0; ai < 2; ++ai)
#pragma unroll
            for (int m = 0; m < 4; ++m) {
                const int row = u.pm * BM + ai * HALF + wr * 64 + m * 16 + fr; float ss = 0.f;
#pragma unroll
                for (int bj = 0; bj < 2; ++bj)
#pragma unroll
                    for (int n = 0; n < 2; ++n) { const size_t off = (size_t)row * D + col0 + bj * HALF + n * 16;
                        f32x4 h;
                        if (basef) h = *(const f32x4*)(basef + off);
                        else { const u32x2 b = *(const u32x2*)(xb + off); h = (f32x4){__uint_as_float(b.x << 16), __uint_as_float(b.x & 0xffff0000u), __uint_as_float(b.y << 16), __uint_as_float(b.y & 0xffff0000u)}; }
                        h += acc[ai][bj][m][n];
                        ss += (h.x * h.x + h.y * h.y) + (h.z * h.z + h.w * h.w);
                        u32x2 w; w.x = cvt_pk_bf16(h.x, h.y); w.y = cvt_pk_bf16(h.z, h.w); *(u32x2*)(xb + off) = w; }
                ss += __shfl_xor(ss, 16); ss += __shfl_xor(ss, 32);
                if (fq == 0) ssq[(size_t)row * 16 + u.pn * 4 + wc] = ss;
                if (m & 1) asm volatile("" ::: "memory");
            }
    }
};
struct EpiUp8 {
    static constexpr int BMODE = 1; static constexpr bool PERM = true, AFTER_DRAIN = false;
    const float* ssq; bf16_t* HB;
    __device__ __forceinline__ void operator()(const f32x4 (&acc)[2][2][4][2], const Unit& u, int wr, int wc, int fr, int fq) const {
        const int col0 = u.pn * BM + wc * 32 + 8 * fq;
#pragma unroll
        for (int ai = 0; ai < 2; ++ai)
#pragma unroll
            for (int m = 0; m < 4; ++m) {
                const int row = u.pm * BM + ai * HALF + wr * 64 + m * 16 + fr; const float rs = rstd_from_slots(ssq, row);
                bf16_t* rowp = HB + (size_t)row * FF + col0;
#pragma unroll
                for (int bj = 0; bj < 2; ++bj) { f32x4 v0 = acc[ai][bj][m][0] * rs, v1 = acc[ai][bj][m][1] * rs;
#pragma unroll
                    for (int j = 0; j < 4; ++j) { const float a = fmaxf(v0[j], 0.f), b = fmaxf(v1[j], 0.f); v0[j] = a * a; v1[j] = b * b; }
                    u32x4 w; w.x = cvt_pk_bf16(v0[0], v0[1]); w.y = cvt_pk_bf16(v0[2], v0[3]); w.z = cvt_pk_bf16(v1[0], v1[1]); w.w = cvt_pk_bf16(v1[2], v1[3]);
                    *(u32x4*)(rowp + bj * HALF) = w; }
            }
    }
};
struct EpiGin8 {
    static constexpr int BMODE = 1; static constexpr bool PERM = true, AFTER_DRAIN = false;
    const float* ssq; bf16_t* q; bf16_t* k; bf16_t* v; bf16_t* r;
    __device__ __forceinline__ void operator()(const f32x4 (&acc)[2][2][4][2], const Unit& u, int wr, int wc, int fr, int fq) const {
        const int pn = u.pn;
        bf16_t* basep; int ld, ct; float sc = 1.0f;
        if (pn < 2) { basep = q; ld = GQK; ct = pn; sc = 0.08838834764831845f; } else if (pn < 4) { basep = k; ld = GQK; ct = pn - 2; } else if (pn < 8) { basep = v; ld = GV; ct = pn - 4; } else { basep = r; ld = GV; ct = pn - 8; }
        const int col0 = ct * BM + wc * 32 + 8 * fq;
#pragma unroll
        for (int ai = 0; ai < 2; ++ai)
#pragma unroll
            for (int m = 0; m < 4; ++m) {
                const int row = u.pm * BM + ai * HALF + wr * 64 + m * 16 + fr; const float rs = rstd_from_slots(ssq, row) * sc;
                bf16_t* rowp = basep + (size_t)row * ld + col0;
#pragma unroll
                for (int bj = 0; bj < 2; ++bj) { const f32x4 v0 = acc[ai][bj][m][0] * rs, v1 = acc[ai][bj][m][1] * rs;
                    u32x4 w; w.x = cvt_pk_bf16(v0[0], v0[1]); w.y = cvt_pk_bf16(v0[2], v0[3]); w.z = cvt_pk_bf16(v1[0], v1[1]); w.w = cvt_pk_bf16(v1[2], v1[3]);
                    *(u32x4*)(rowp + bj * HALF) = w; }
            }
    }
};
}

namespace attn_body {
using bf16=__hip_bfloat16;
using bf16x8=__attribute__((ext_vector_type(8)))short;
using s16x4=__attribute__((ext_vector_type(4)))short;
using f32x16=__attribute__((ext_vector_type(16)))float;
using u32x4=__attribute__((ext_vector_type(4)))unsigned;
constexpr int BATCH=4,NHEAD=16,SEQ=4096,D=64,DM=NHEAD*D,KVP=256;
constexpr int NW=8,QBLK=32,QB=QBLK*NW,KVBLK=64,NQB=SEQ/QB;
constexpr int ATTN_PITCH=DM, ATTN_UNIT_ROWS=QB;
__device__ __forceinline__ int crow(int r,int hi){return (r&3)+8*(r>>2)+4*hi;}
#define SBAR() __builtin_amdgcn_sched_barrier(0)
__device__ __forceinline__ void cmask(f32x16&p0,f32x16&p1,int jb,int qrel,int hi){
  const float NEG=-INFINITY; int kb=64*jb+4*hi;
  #pragma unroll
  for(int r=0;r<16;++r){int kv=kb+(r&3)+8*(r>>2); if(kv>qrel)p0[r]=NEG; if(kv+32>qrel)p1[r]=NEG;}
}

constexpr int NSLOT=3, SLOTB=8192;
constexpr int LDS_K=0, LDS_V=NSLOT*SLOTB, LDS_WS=2*NSLOT*SLOTB, LDS_OST=LDS_WS+NW*64*4, LDS_BYTES=LDS_OST+NW*4096;
constexpr float C2=0.125f*1.4426950408889634f;
__device__ __forceinline__ void glds16(const void*gsrc,unsigned lds_dst){unsigned keep;
  asm volatile("s_mov_b32 %0, m0\n\ts_mov_b32 m0, %2\n\ts_nop 0\n\tglobal_load_lds_dwordx4 %1, off\n\ts_mov_b32 m0, %0":"=&s"(keep):"v"(gsrc),"s"(lds_dst):"memory");}
__device__ __forceinline__ float max3f(float a,float b,float c){float r;asm("v_max3_f32 %0, %1, %2, %3":"=v"(r):"v"(a),"v"(b),"v"(c));return r;}
__device__ __forceinline__ float max2f(float a,float b){float r;asm("v_max_f32_e32 %0, %1, %2":"=v"(r):"v"(a),"v"(b));return r;}
__device__ __forceinline__ float fadd_s(float a,float b){float r;asm("v_add_f32_e32 %0, %1, %2":"=v"(r):"v"(a),"v"(b));return r;}
__device__ __forceinline__ float fsub_s(float a,float b){float r;asm("v_sub_f32_e32 %0, %1, %2":"=v"(r):"v"(a),"v"(b));return r;}
typedef float f32x2_t __attribute__((ext_vector_type(2))); typedef __bf16 bf16x2_t __attribute__((ext_vector_type(2)));
__device__ __forceinline__ unsigned cvtpk_s(float lo,float hi){f32x2_t v={lo,hi};bf16x2_t b=__builtin_convertvector(v,bf16x2_t);return __builtin_bit_cast(unsigned,b);}
#define WAIT_BAR(N) asm volatile("s_waitcnt vmcnt(" #N ") lgkmcnt(0)\n\ts_barrier":::"memory")

__device__ __forceinline__ void qkt(f32x16&p0,f32x16&p1,const char*Kslot,const bf16x8*qr,const f32x16&negm,int r32,int hi){
  const char*kb=Kslot+hi*1024+r32*16;
  #pragma unroll
  for(int d0=0;d0<4;++d0){
    const bf16x8 b0=*reinterpret_cast<const bf16x8*>(kb+d0*2048);
    const bf16x8 b1=*reinterpret_cast<const bf16x8*>(kb+d0*2048+512);
    if(d0==0){p0=__builtin_amdgcn_mfma_f32_32x32x16_bf16(b0,qr[0],negm,0,0,0);p1=__builtin_amdgcn_mfma_f32_32x32x16_bf16(b1,qr[0],negm,0,0,0);}
    else{p0=__builtin_amdgcn_mfma_f32_32x32x16_bf16(b0,qr[d0],p0,0,0,0);p1=__builtin_amdgcn_mfma_f32_32x32x16_bf16(b1,qr[d0],p1,0,0,0);}}
}
typedef __attribute__((address_space(3))) const char* lds_cptr;
typedef short v4i16_t __attribute__((ext_vector_type(4)));
__device__ __forceinline__ void kload8(bf16x8*kf,lds_cptr kp){
  kf[0]=*(const __attribute__((address_space(3))) bf16x8*)(kp);      kf[1]=*(const __attribute__((address_space(3))) bf16x8*)(kp+512);
  kf[2]=*(const __attribute__((address_space(3))) bf16x8*)(kp+2048); kf[3]=*(const __attribute__((address_space(3))) bf16x8*)(kp+2560);
  kf[4]=*(const __attribute__((address_space(3))) bf16x8*)(kp+4096); kf[5]=*(const __attribute__((address_space(3))) bf16x8*)(kp+4608);
  kf[6]=*(const __attribute__((address_space(3))) bf16x8*)(kp+6144); kf[7]=*(const __attribute__((address_space(3))) bf16x8*)(kp+6656);
}
__device__ __forceinline__ void kload2(bf16x8*kf,lds_cptr kp,int j){ kf[2*j]=*(const __attribute__((address_space(3))) bf16x8*)(kp+j*2048); kf[2*j+1]=*(const __attribute__((address_space(3))) bf16x8*)(kp+j*2048+512); }
__device__ __forceinline__ s16x4 vtr(lds_cptr p){ return __builtin_bit_cast(s16x4,__builtin_amdgcn_ds_read_tr16_b64_v4i16((__attribute__((address_space(3))) v4i16_t*)p)); }
__device__ __forceinline__ float rowmax(const f32x16&p0,const f32x16&p1){
  float a=max3f(p0[0],p0[1],p1[0]),b=max3f(p0[2],p0[3],p1[1]);a=max3f(a,p1[2],p1[3]);
  #pragma unroll
  for(int r=4;r<16;r+=4){a=max3f(a,p0[r],p0[r+1]);b=max3f(b,p0[r+2],p0[r+3]);a=max3f(a,p1[r],p1[r+1]);b=max3f(b,p1[r+2],p1[r+3]);}
  const float m=max2f(a,b);
  auto rr=__builtin_amdgcn_permlane32_swap(__float_as_uint(m),__float_as_uint(m),false,false);
  return max2f(__uint_as_float(rr[0]),__uint_as_float(rr[1]));
}
__device__ __forceinline__ void pv(f32x16*o,int vb,bf16x8 pa0,bf16x8 pa1,bf16x8 pa2,bf16x8 pa3){
  #pragma unroll
  for(int d0=0;d0<2;++d0){s16x4 lo[4],hi[4];
    #pragma unroll
    for(int ks=0;ks<4;++ks){
      asm volatile("ds_read_b64_tr_b16 %0,%1 offset:%c2":"=&v"(lo[ks]):"v"(vb),"i"(d0*4096+ks*1024):"memory");
      asm volatile("ds_read_b64_tr_b16 %0,%1 offset:%c2":"=&v"(hi[ks]):"v"(vb),"i"(d0*4096+ks*1024+512):"memory");}
    asm volatile("s_waitcnt lgkmcnt(0)":::"memory");SBAR();
    #define PK(k) (bf16x8){lo[k][0],lo[k][1],lo[k][2],lo[k][3],hi[k][0],hi[k][1],hi[k][2],hi[k][3]}
    o[d0]=__builtin_amdgcn_mfma_f32_32x32x16_bf16(pa0,PK(0),o[d0],0,0,0);
    o[d0]=__builtin_amdgcn_mfma_f32_32x32x16_bf16(pa1,PK(1),o[d0],0,0,0);
    o[d0]=__builtin_amdgcn_mfma_f32_32x32x16_bf16(pa2,PK(2),o[d0],0,0,0);
    o[d0]=__builtin_amdgcn_mfma_f32_32x32x16_bf16(pa3,PK(3),o[d0],0,0,0);
    #undef PK
  }
}

#ifndef ATTN_STORE16
#define ATTN_STORE16(p,v) (*(u32x4*)(p)=(v))
#endif
template<int THRL> __device__ __forceinline__ void attn_unit(int b,int h,int qb,const bf16*Q,const bf16*__restrict__ K,const bf16*__restrict__ V,bf16*O,char*shm,const int tid){
  const int lane=tid&63,r32=lane&31,hi=lane>>5; const int wid=__builtin_amdgcn_readfirstlane(tid>>6);
  const long rowbase=(long)b*SEQ; const int q0=qb*QB;
  const bf16*Qw=Q+(rowbase+q0+wid*QBLK)*DM+h*D;
  const bf16*Kh=K+rowbase*KVP+(h>>2)*D,*Vh=V+rowbase*KVP+(h>>2)*D;
  const unsigned lds0=(unsigned)(uintptr_t)shm;
  float*wsf=(float*)(shm+LDS_WS)+wid*64;
  const bf16*ksrc=Kh+(long)lane*KVP+wid*8;
  const bf16*vsrc=Vh+(long)(16*(wid&3)+(lane>>2))*KVP+(wid>>2)*32+(lane&3)*8;
  const unsigned kdst=lds0+LDS_K+wid*1024, vdst=lds0+LDS_V+wid*1024;
  #define DMA_K(t,slot) glds16(ksrc+(long)(t)*KVBLK*KVP,(unsigned)__builtin_amdgcn_readfirstlane(kdst+(slot)))
  #define DMA_V(t,slot) glds16(vsrc+(long)(t)*KVBLK*KVP,(unsigned)__builtin_amdgcn_readfirstlane(vdst+(slot)))
  const int vb0=(int)(lds0+LDS_V)+((lane>>4)&1)*32+(lane&3)*8+(4*hi+((lane&15)>>2))*64;
  const char*Kbase=shm+LDS_K; bf16x8 kf[8];
  const lds_cptr shm3=(lds_cptr)shm; const lds_cptr kp0=shm3+LDS_K+hi*1024+r32*16; const lds_cptr vp0=shm3+LDS_V+((lane>>4)&1)*32+(lane&3)*8+(4*hi+((lane&15)>>2))*64;
  const int NT=SEQ/KVBLK;
  DMA_K(0,0);DMA_V(0,0);DMA_K(1,SLOTB);
  bf16x8 qr[4];
  #pragma unroll
  for(int d0=0;d0<4;++d0)qr[d0]=*reinterpret_cast<const bf16x8*>(&Qw[(long)r32*DM+d0*16+hi*8]);
  float mhat=0.f,l_reg=0.f;f32x16 o[2];o[0]=f32x16{};o[1]=f32x16{};f32x16 negm=f32x16{};asm volatile("":"+v"(negm));
  const int qrel=wid*QBLK+r32;
  #define CMASK(P0,P1,t) do{}while(0)
  bool resc=false;
  #define START(P0,P1) do{ const float rm=rowmax(P0,P1); resc=false; \
    { const float dl=rm; mhat=fadd_s(mhat,dl); \
      _Pragma("unroll") for(int r=0;r<16;++r){P0[r]=fsub_s(P0[r],dl);P1[r]=fsub_s(P1[r],dl);} \
      _Pragma("unroll") for(int r=0;r<16;++r)negm[r]=-mhat; asm volatile("":"+v"(negm)); } \
    _Pragma("unroll") for(int r=0;r<16;++r)P0[r]=__builtin_amdgcn_exp2f(P0[r]); }while(0)
  #define RESC() do{ if(resc){ asm volatile("s_waitcnt lgkmcnt(0)":::"memory"); \
      _Pragma("unroll") for(int d_=0;d_<2;++d_) _Pragma("unroll") for(int r=0;r<16;++r)o[d_][r]*=wsf[crow(r,hi)]; } }while(0)
  f32x16 pA0,pA1,pB0,pB1;
  int sl_prev=0,sl_cur=0,sl_next=SLOTB;
  #define ROT() do{sl_prev=sl_cur;sl_cur=sl_next;sl_next=(sl_next==(NSLOT-1)*SLOTB)?0:sl_next+SLOTB;}while(0)
  DMA_K(2,2*SLOTB);
  WAIT_BAR(3);
  qkt(pA0,pA1,Kbase,qr,negm,r32,hi);asm volatile("s_nop 15\n\ts_nop 7":"+v"(pA0),"+v"(pA1));CMASK(pA0,pA1,0);
  START(pA0,pA1);
  _Pragma("unroll") for(int r=0;r<16;++r)pA1[r]=__builtin_amdgcn_exp2f(pA1[r]);
  WAIT_BAR(0);
  DMA_K(3,0);DMA_V(1,SLOTB);
  ROT();
  kload8(kf,kp0+sl_cur);
  WAIT_BAR(2);
  s16x4 vlo[8],vhi[8]; u32x4 pw0,pw1,pw2,pw3;
  #define PKW(P,B) cvtpk_s(P[B],P[B+1])
  #define PAF(k) __builtin_bit_cast(bf16x8,pw##k)
  #define VFR(i) (bf16x8){vlo[i][0],vlo[i][1],vlo[i][2],vlo[i][3],vhi[i][0],vhi[i][1],vhi[i][2],vhi[i][3]}
  #define PIN(x) asm volatile("":"+v"(x))
  #define MX3(a,b,c) __builtin_fmaxf(__builtin_fmaxf((a),(b)),(c))
  #define GAPA(MF,A0,A1,A2,A3,W0,W1,PW) do{ MF; sacc+=A0; sacc+=A1; sacc+=A2; sacc+=A3; PIN(sacc); W0; W1; PIN(PW); SBAR(); }while(0)
  #define EX(v) __builtin_amdgcn_exp2f(v)
  #define GAPB(MF,X,B) do{ MF; X[B]=EX(X[B]); X[B+1]=EX(X[B+1]); X[B+2]=EX(X[B+2]); X[B+3]=EX(X[B+3]); PIN(X); SBAR(); }while(0)
  #define VRD(i) do{ vlo[i]=vtr(vp_+(((i)>>2)*4096+((i)&3)*1024)); vhi[i]=vtr(vp_+(((i)>>2)*4096+((i)&3)*1024+512)); }while(0)
  #define KRD(G,j) do{ if(G){ kload2(kf,kp0+sl_next,j); SBAR(); } }while(0)
  #define STEP(C0,C1,P0,P1,t,GK,GV,GL) do{ SBAR(); \
    const lds_cptr vp_=vp0+sl_prev; \
    VRD(0); SBAR(); float sacc=(P0[0]+P0[1]); \
    GAPA(C0=__builtin_amdgcn_mfma_f32_32x32x16_bf16(kf[0],qr[0],negm,0,0,0), P0[2],P0[3],P0[4],P0[5],     pw0[0]=PKW(P0,0), pw0[1]=PKW(P0,2), pw0); \
    VRD(4); SBAR(); GAPA(C1=__builtin_amdgcn_mfma_f32_32x32x16_bf16(kf[1],qr[0],negm,0,0,0), P0[6],P0[7],P0[8],P0[9],     pw0[2]=PKW(P0,4), pw0[3]=PKW(P0,6), pw0); \
    VRD(1); SBAR(); GAPA(C0=__builtin_amdgcn_mfma_f32_32x32x16_bf16(kf[2],qr[1],C0,0,0,0),   P0[10],P0[11],P0[12],P0[13], pw1[0]=PKW(P0,8), pw1[1]=PKW(P0,10), pw1); \
    VRD(5); SBAR(); GAPA(C1=__builtin_amdgcn_mfma_f32_32x32x16_bf16(kf[3],qr[1],C1,0,0,0),   P0[14],P0[15],P1[0],P1[1],   pw1[2]=PKW(P0,12),pw1[3]=PKW(P0,14), pw1); \
    VRD(2); SBAR(); GAPA(C0=__builtin_amdgcn_mfma_f32_32x32x16_bf16(kf[4],qr[2],C0,0,0,0),   P1[2],P1[3],P1[4],P1[5],     pw2[0]=PKW(P1,0), pw2[1]=PKW(P1,2), pw2); \
    VRD(6); SBAR(); GAPA(C1=__builtin_amdgcn_mfma_f32_32x32x16_bf16(kf[5],qr[2],C1,0,0,0),   P1[6],P1[7],P1[8],P1[9],     pw2[2]=PKW(P1,4), pw2[3]=PKW(P1,6), pw2); \
    VRD(3); SBAR(); GAPA(C0=__builtin_amdgcn_mfma_f32_32x32x16_bf16(kf[6],qr[3],C0,0,0,0),   P1[10],P1[11],P1[12],P1[13], pw3[0]=PKW(P1,8), pw3[1]=PKW(P1,10), pw3); \
    VRD(7); SBAR(); GAPA(C1=__builtin_amdgcn_mfma_f32_32x32x16_bf16(kf[7],qr[3],C1,0,0,0),   P1[14],P1[15],0.f,0.f,       pw3[2]=PKW(P1,12),pw3[3]=PKW(P1,14), pw3); \
    l_reg+=sacc; \
    if(GK){DMA_K((t)+3,sl_cur);} if(GV){DMA_V((t)+1,sl_next);} \
    CMASK(C0,C1,t); \
    { float a=MX3(C0[0],C0[1],C1[0]),b=MX3(C0[2],C0[3],C1[1]); a=MX3(a,C1[2],C1[3]); \
      _Pragma("unroll") for(int r=4;r<16;r+=4){a=MX3(a,C0[r],C0[r+1]);b=MX3(b,C0[r+2],C0[r+3]);a=MX3(a,C1[r],C1[r+1]);b=MX3(b,C1[r+2],C1[r+3]);} \
      float rm=__builtin_fmaxf(a,b); { auto rr=__builtin_amdgcn_permlane32_swap(__float_as_uint(rm),__float_as_uint(rm),false,false); rm=__builtin_fmaxf(__uint_as_float(rr[0]),__uint_as_float(rr[1])); } \
      resc=false; \
      if(__builtin_expect(__any(rm>(float)THRL),0)){ const float dl=__builtin_fmaxf(rm,0.f); mhat+=dl; \
        _Pragma("unroll") for(int r=0;r<16;++r){C0[r]-=dl;C1[r]-=dl;} \
        _Pragma("unroll") for(int r=0;r<16;++r)negm[r]=-mhat; asm volatile("":"+v"(negm)); \
        const float f=__builtin_amdgcn_exp2f(-dl); l_reg*=f; if(hi==0)wsf[r32]=f; resc=true; } } \
    SBAR(); \
    GAPB(o[0]=__builtin_amdgcn_mfma_f32_32x32x16_bf16(PAF(0),VFR(0),o[0],0,0,0), C0,0); \
    GAPB(o[1]=__builtin_amdgcn_mfma_f32_32x32x16_bf16(PAF(0),VFR(4),o[1],0,0,0), C0,4); \
    KRD(GL,0); GAPB(o[0]=__builtin_amdgcn_mfma_f32_32x32x16_bf16(PAF(1),VFR(1),o[0],0,0,0), C0,8); \
    KRD(GL,1); GAPB(o[1]=__builtin_amdgcn_mfma_f32_32x32x16_bf16(PAF(1),VFR(5),o[1],0,0,0), C0,12); \
    KRD(GL,2); GAPB(o[0]=__builtin_amdgcn_mfma_f32_32x32x16_bf16(PAF(2),VFR(2),o[0],0,0,0), C1,0); \
    KRD(GL,3); GAPB(o[1]=__builtin_amdgcn_mfma_f32_32x32x16_bf16(PAF(2),VFR(6),o[1],0,0,0), C1,4); \
    GAPB(o[0]=__builtin_amdgcn_mfma_f32_32x32x16_bf16(PAF(3),VFR(3),o[0],0,0,0), C1,8); \
    GAPB(o[1]=__builtin_amdgcn_mfma_f32_32x32x16_bf16(PAF(3),VFR(7),o[1],0,0,0), C1,12); \
    }while(0)
  int t=1;
  #undef CMASK
  #define CMASK(P0,P1,t) do{}while(0)
  for(;t+5<NT;t+=2){
    STEP(pB0,pB1,pA0,pA1,t,true,true,true);     WAIT_BAR(2); RESC(); ROT();
    STEP(pA0,pA1,pB0,pB1,t+1,true,true,true);   WAIT_BAR(2); RESC(); ROT();
  }
  #undef CMASK
  #define CMASK(P0,P1,t) do{}while(0)
  #define ENDW(tt) do{ if((tt)+3<NT){WAIT_BAR(2);} else if((tt)+2<NT){WAIT_BAR(1);} else {WAIT_BAR(0);} }while(0)
  for(;t+1<NT;t+=2){
    STEP(pB0,pB1,pA0,pA1,t,(t+3<NT),(t+1<NT),(t+1<NT));       ENDW(t);   RESC(); ROT();
    STEP(pA0,pA1,pB0,pB1,t+1,(t+4<NT),(t+2<NT),(t+2<NT));     ENDW(t+1); RESC(); ROT();
  }
  STEP(pB0,pB1,pA0,pA1,NT-1,false,false,false); RESC();
  { float sacc=pB0[0]+pB0[1]; _Pragma("unroll") for(int r=2;r<16;++r)sacc+=pB0[r]; _Pragma("unroll") for(int r=0;r<16;++r)sacc+=pB1[r]; l_reg+=sacc;
    pw0=(u32x4){PKW(pB0,0),PKW(pB0,2),PKW(pB0,4),PKW(pB0,6)};pw1=(u32x4){PKW(pB0,8),PKW(pB0,10),PKW(pB0,12),PKW(pB0,14)};pw2=(u32x4){PKW(pB1,0),PKW(pB1,2),PKW(pB1,4),PKW(pB1,6)};pw3=(u32x4){PKW(pB1,8),PKW(pB1,10),PKW(pB1,12),PKW(pB1,14)};
    SBAR(); pv(o,vb0+sl_cur,PAF(0),PAF(1),PAF(2),PAF(3)); }
  #undef PKW
  #undef PAF
  #undef VFR
  #undef PIN
  #undef MX3
  #undef GAPA
  #undef GAPB
  #undef EX
  #undef VRD
  #undef KRD
  #undef STEP
  #undef ENDW
  {auto rr=__builtin_amdgcn_permlane32_swap(__float_as_uint(l_reg),__float_as_uint(l_reg),false,false);l_reg=__uint_as_float(rr[0])+__uint_as_float(rr[1]);}
  if(hi==0)wsf[32+r32]=l_reg;asm volatile("s_waitcnt lgkmcnt(0)":::"memory");
  float rli[16];
  #pragma unroll
  for(int r=0;r<16;++r)rli[r]=__builtin_amdgcn_rcpf(wsf[32+crow(r,hi)]);
  bf16*Ow=O+(rowbase+q0+wid*QBLK)*DM+h*D;
  { bf16*stg=(bf16*)(shm+LDS_OST)+wid*2048;
    #pragma unroll
    for(int r=0;r<16;++r){const int orow=crow(r,hi);
      #pragma unroll
      for(int d0=0;d0<2;++d0)stg[orow*64+d0*32+r32]=__float2bfloat16(o[d0][r]*rli[r]);}
    asm volatile("s_waitcnt lgkmcnt(0)":::"memory");
    #pragma unroll
    for(int i=0;i<4;++i){const int row=i*8+(lane>>3),ch=lane&7; const u32x4 v=*(const u32x4*)(stg+row*64+ch*8); ATTN_STORE16(Ow+(long)row*DM+ch*8,v);} }
  asm volatile("s_waitcnt lgkmcnt(0)\n\ts_barrier":::"memory");
  #undef DMA_K
  #undef DMA_V
  #undef CMASK
  #undef START
  #undef RESC
  #undef ROT
}
constexpr int ATTN_LDS_BYTES=LDS_BYTES;
struct AttnTensors { const bf16* Q; const bf16* K; const bf16* V; bf16* O; };
struct AttnUnit { int bh; int qb; };
struct StaticOrder {
  int vcu,per;
  __device__ __forceinline__ explicit StaticOrder(int grid,int block):vcu((grid%8==0)?(block%8)*(grid/8)+block/8:block),per((BATCH*NHEAD*NQB+grid-1)/grid){}
  __device__ __forceinline__ bool next(int i,AttnUnit&u)const{ const int L=vcu*per+i; if(i>=per||L>=BATCH*NHEAD*NQB)return false; const int grp=L>>6,idx=L&63; u.bh=(grp>>2)*NHEAD+(grp&3)*4+(idx&3); u.qb=idx>>2; return true; }
  __device__ __forceinline__ void a_ready(const AttnUnit&)const{}
  __device__ __forceinline__ void done(const AttnUnit&)const{}
};
template<class Sched,int THRL=8> __device__ __forceinline__ void attn_phase(char*lds,const AttnTensors&T,const Sched&S,const int tid){
  AttnUnit u;
  for(int i=0;S.next(i,u);++i){ S.a_ready(u); attn_unit<THRL>(u.bh/NHEAD,u.bh%NHEAD,u.qb,T.Q,T.K,T.V,T.O,lds,tid); S.done(u); }
}
#undef SBAR
#undef WAIT_BAR
}

__device__ __forceinline__ void transpose_item(const float* W, const float* g, int K, int N, bf16_t* WT, LAS float* scr, int item, int lane) {
    const int nblk = N / 32, kb = item / nblk, nb = item % nblk, k0 = 64 * kb, n0 = 32 * nb;
    float wv[32];
#pragma unroll
    for (int i = 0; i < 32; ++i) wv[i] = W[(size_t)(k0 + 2 * i + (lane >> 5)) * N + n0 + (lane & 31)];
#pragma unroll
    for (int i = 0; i < 32; ++i) { const int kk = 2 * i + (lane >> 5); const float gv = g ? g[k0 + kk] : 1.0f; scr[kk * 33 + (lane & 31)] = wv[i] * gv; }
    LDS_WAIT(); asm volatile("" ::: "memory");
    const int c = lane & 7;
#pragma unroll
    for (int j = 0; j < 4; ++j) { const int n = (lane >> 3) + 8 * j; const LAS float* s = scr + (8 * c) * 33 + n;
        u32x4 o; o.x = pk2(s[0 * 33], s[1 * 33]); o.y = pk2(s[2 * 33], s[3 * 33]); o.z = pk2(s[4 * 33], s[5 * 33]); o.w = pk2(s[6 * 33], s[7 * 33]);
        *(u32x4*)(WT + (size_t)(n0 + n) * K + k0 + 8 * c) = o; }
    LDS_WAIT(); asm volatile("" ::: "memory");
}
__device__ __forceinline__ void sincos_d(double x, double& s, double& c) {
    const double TWO_PI = 6.283185307179586476925286766559;
    const double n = __builtin_rint(x / TWO_PI);
    const double r = x - n * TWO_PI, r2 = r * r;
    double ts = 1.0, tc = 1.0;
#pragma unroll
    for (int k = 13; k >= 1; --k) { ts = 1.0 - ts * r2 / (double)((2 * k) * (2 * k + 1)); tc = 1.0 - tc * r2 / (double)((2 * k - 1) * (2 * k)); }
    s = r * ts; c = tc;
}

template <class Epi>
__device__ __forceinline__ void gemm_simple(const bf16_t* A, const bf16_t* Bt, int Mrows, int N, int K, const Epi& E, int gw, int ngw, int lane) {
    const int fr = lane & 15, fq = lane >> 4;
    const int ntn = N / 64, ntm = Mrows / 32, ntiles = ntn * ntm;
    for (int t = gw; t < ntiles; t += ngw) {
        const int tn = t % ntn, tm = t / ntn;
        f32x4 acc[2][4];
#pragma unroll
        for (int m = 0; m < 2; ++m)
#pragma unroll
            for (int n = 0; n < 4; ++n) acc[m][n] = (f32x4){0.f, 0.f, 0.f, 0.f};
        const bf16_t* Ap = A + (size_t)(tm * 32 + fr) * K + fq * 8;
        const bf16_t* Bp = Bt + (size_t)(tn * 64 + fr) * K + fq * 8;
        for (int k0 = 0; k0 < K; k0 += 32) {
            bf16x8 a[2], b[4];
            a[0] = *(const bf16x8*)(Ap + k0); a[1] = *(const bf16x8*)(Ap + (size_t)16 * K + k0);
#pragma unroll
            for (int n = 0; n < 4; ++n) b[n] = *(const bf16x8*)(Bp + (size_t)n * 16 * K + k0);
#pragma unroll
            for (int m = 0; m < 2; ++m)
#pragma unroll
                for (int n = 0; n < 4; ++n) acc[m][n] = __builtin_amdgcn_mfma_f32_16x16x32_bf16(b[n], a[m], acc[m][n], 0, 0, 0);
        }
        E(tm * 32, tn * 64, acc, fr, fq);
    }
}

struct EpiQKV {
    const float* ssq; const float* qg; const float* kg; const f32x2* rope; bf16_t* Q; bf16_t* Kb; bf16_t* Vb;
    __device__ __forceinline__ void operator()(int row0, int col0, f32x4 (&acc)[2][4], int fr, int fq) const {
#pragma unroll
        for (int m = 0; m < 2; ++m) {
            const int row = row0 + 16 * m + fr; const float rs = rstd_from_slots(ssq, row);
            f32x4 v[4];
#pragma unroll
            for (int n = 0; n < 4; ++n) v[n] = acc[m][n] * rs;
            if (col0 < 1280) {
                const bool isq = col0 < 1024; const float* g = isq ? qg : kg;
                float ss = 0.f;
#pragma unroll
                for (int n = 0; n < 4; ++n) ss += (v[n].x * v[n].x + v[n].y * v[n].y) + (v[n].z * v[n].z + v[n].w * v[n].w);
                ss += __shfl_xor(ss, 16); ss += __shfl_xor(ss, 32);
                const float r = 1.0f / sqrtf(ss * (1.0f / 64.0f) + EPS);
#pragma unroll
                for (int n = 0; n < 4; ++n) { const f32x4 gv = *(const f32x4*)(g + 16 * n + 4 * fq); v[n] = v[n] * r * gv; }
                const int t = row % SEQ, prow = t >> 6, pcol = t & 63;
                const float sc = isq ? C2 : 1.0f;
#pragma unroll
                for (int hh = 0; hh < 2; ++hh) {
                    const int pos = hh == 0 ? prow : pcol;
                    f32x4 x1 = v[2 * hh], x2 = v[2 * hh + 1], o1, o2;
#pragma unroll
                    for (int j = 0; j < 4; ++j) { const f32x2 cs = rope[pos * 16 + 4 * fq + j];
                        o1[j] = (x1[j] * cs.x - x2[j] * cs.y) * sc; o2[j] = (x2[j] * cs.x + x1[j] * cs.y) * sc; }
                    v[2 * hh] = o1; v[2 * hh + 1] = o2;
                }
            }
            bf16_t* dst;
            if (col0 < 1024) dst = Q + (size_t)row * D + col0;
            else if (col0 < 1280) dst = Kb + (size_t)row * KVP + (col0 - 1024);
            else dst = Vb + (size_t)row * KVP + (col0 - 1280);
#pragma unroll
            for (int n = 0; n < 4; ++n) { u32x2 w; w.x = pk2(v[n].x, v[n].y); w.y = pk2(v[n].z, v[n].w); *(u32x2*)(dst + 16 * n + 4 * fq) = w; }
        }
    }
};
struct EpiRes {
    const float* basef; bf16_t* xb; float* ssq;
    __device__ __forceinline__ void operator()(int row0, int col0, f32x4 (&acc)[2][4], int fr, int fq) const {
#pragma unroll
        for (int m = 0; m < 2; ++m) {
            const int row = row0 + 16 * m + fr; float ss = 0.f;
#pragma unroll
            for (int n = 0; n < 4; ++n) { const size_t off = (size_t)row * D + col0 + 16 * n + 4 * fq;
                f32x4 h;
                if (basef) h = *(const f32x4*)(basef + off);
                else { const u32x2 b = *(const u32x2*)(xb + off); h = (f32x4){bflo(b.x), bfhi(b.x), bflo(b.y), bfhi(b.y)}; }
                h += acc[m][n];
                ss += (h.x * h.x + h.y * h.y) + (h.z * h.z + h.w * h.w);
                u32x2 w; w.x = pk2(h.x, h.y); w.y = pk2(h.z, h.w); *(u32x2*)(xb + off) = w; }
            ss += __shfl_xor(ss, 16); ss += __shfl_xor(ss, 32);
            if (fq == 0) ssq[(size_t)row * 16 + (col0 >> 6)] = ss;
        }
    }
};
struct EpiUp {
    const float* ssq; bf16_t* HB;
    __device__ __forceinline__ void operator()(int row0, int col0, f32x4 (&acc)[2][4], int fr, int fq) const {
#pragma unroll
        for (int m = 0; m < 2; ++m) {
            const int row = row0 + 16 * m + fr; const float rs = rstd_from_slots(ssq, row);
#pragma unroll
            for (int n = 0; n < 4; ++n) { f32x4 v = acc[m][n] * rs;
#pragma unroll
                for (int j = 0; j < 4; ++j) { const float t = fmaxf(v[j], 0.f); v[j] = t * t; }
                u32x2 w; w.x = pk2(v.x, v.y); w.y = pk2(v.z, v.w); *(u32x2*)(HB + (size_t)row * FF + col0 + 16 * n + 4 * fq) = w; }
        }
    }
};
struct EpiGin {
    const float* ssq; bf16_t* q; bf16_t* k; bf16_t* v; bf16_t* r;
    __device__ __forceinline__ void operator()(int row0, int col0, f32x4 (&acc)[2][4], int fr, int fq) const {
#pragma unroll
        for (int m = 0; m < 2; ++m) {
            const int row = row0 + 16 * m + fr; float rs = rstd_from_slots(ssq, row);
            bf16_t* dst;
            if (col0 < 512) { dst = q + (size_t)row * GQK + col0; rs *= 0.08838834764831845f; }
            else if (col0 < 1024) dst = k + (size_t)row * GQK + (col0 - 512);
            else if (col0 < 2048) dst = v + (size_t)row * GV + (col0 - 1024);
            else dst = r + (size_t)row * GV + (col0 - 2048);
#pragma unroll
            for (int n = 0; n < 4; ++n) { const f32x4 x = acc[m][n] * rs; u32x2 w; w.x = pk2(x.x, x.y); w.y = pk2(x.z, x.w); *(u32x2*)(dst + 16 * n + 4 * fq) = w; }
        }
    }
};
struct EpiZ {
    const float* ssq; float* Z;
    __device__ __forceinline__ void operator()(int row0, int col0, f32x4 (&acc)[2][4], int fr, int fq) const {
#pragma unroll
        for (int m = 0; m < 2; ++m) {
            const int row = row0 + 16 * m + fr; const float rs = rstd_from_slots(ssq, row);
#pragma unroll
            for (int n = 0; n < 4; ++n) *(f32x4*)(Z + (size_t)row * 64 + col0 + 16 * n + 4 * fq) = acc[m][n] * rs;
        }
    }
};

__device__ __forceinline__ void attn_simple(const bf16_t* Q, const bf16_t* Kb, const bf16_t* Vb, bf16_t* O, int gw, int ngw, int lane) {
    const int fr = lane & 15, fq = lane >> 4;
    for (int u = gw; u < BATCH * NH * (SEQ / 16); u += ngw) {
        const int qt = u & 255, h = (u >> 8) & 15, b = u >> 12, kvh = h >> 2;
        const size_t rowbase = (size_t)b * SEQ;
        const bf16_t* Qp = Q + (rowbase + qt * 16 + fr) * D + h * HD + fq * 8;
        bf16x8 qf[2]; qf[0] = *(const bf16x8*)Qp; qf[1] = *(const bf16x8*)(Qp + 32);
        const bf16_t* Kh = Kb + rowbase * KVP + kvh * HD;
        const bf16_t* Vh = Vb + rowbase * KVP + kvh * HD;
        float mrun = -1e30f, lrun = 0.f;
        f32x4 oacc[4];
#pragma unroll
        for (int dt = 0; dt < 4; ++dt) oacc[dt] = (f32x4){0.f, 0.f, 0.f, 0.f};
        for (int kt = 0; kt < SEQ / 64; ++kt) {
            const int key0 = kt * 64;
            f32x4 sT[4];
#pragma unroll
            for (int blk = 0; blk < 4; ++blk) {
                const int key = key0 + 32 * (blk >> 1) + 8 * (fr >> 2) + 4 * (blk & 1) + (fr & 3);
                const bf16_t* kp = Kh + (size_t)key * KVP + fq * 8;
                const bf16x8 k0 = *(const bf16x8*)kp, k1 = *(const bf16x8*)(kp + 32);
                f32x4 z = (f32x4){0.f, 0.f, 0.f, 0.f};
                z = __builtin_amdgcn_mfma_f32_16x16x32_bf16(k0, qf[0], z, 0, 0, 0);
                z = __builtin_amdgcn_mfma_f32_16x16x32_bf16(k1, qf[1], z, 0, 0, 0);
                sT[blk] = z;
            }
            float mx = sT[0][0];
#pragma unroll
            for (int blk = 0; blk < 4; ++blk)
#pragma unroll
                for (int r = 0; r < 4; ++r) mx = fmaxf(mx, sT[blk][r]);
            mx = fmaxf(mx, __shfl_xor(mx, 16)); mx = fmaxf(mx, __shfl_xor(mx, 32));
            const float mnew = fmaxf(mrun, mx), alpha = __builtin_amdgcn_exp2f(mrun - mnew); mrun = mnew;
            float ps = 0.f; bf16x8 pf[2];
#pragma unroll
            for (int ks = 0; ks < 2; ++ks) {
                float p[8];
#pragma unroll
                for (int j = 0; j < 8; ++j) { p[j] = __builtin_amdgcn_exp2f(sT[2 * ks + (j >> 2)][j & 3] - mnew); ps += p[j]; }
                u32x4 w; w.x = pk2(p[0], p[1]); w.y = pk2(p[2], p[3]); w.z = pk2(p[4], p[5]); w.w = pk2(p[6], p[7]);
                pf[ks] = __builtin_bit_cast(bf16x8, w);
            }
            lrun = lrun * alpha + ps;
#pragma unroll
            for (int dt = 0; dt < 4; ++dt) oacc[dt] = oacc[dt] * alpha;
#pragma unroll
            for (int ks = 0; ks < 2; ++ks)
#pragma unroll
                for (int dt = 0; dt < 4; ++dt) {
                    const bf16_t* vp = Vh + (size_t)(key0 + 32 * ks + 8 * fq) * KVP + dt * 16 + fr;
                    bf16x8 vf;
#pragma unroll
                    for (int e = 0; e < 8; ++e) vf[e] = (short)vp[(size_t)e * KVP];
                    oacc[dt] = __builtin_amdgcn_mfma_f32_16x16x32_bf16(vf, pf[ks], oacc[dt], 0, 0, 0);
                }
        }
        lrun += __shfl_xor(lrun, 16); lrun += __shfl_xor(lrun, 32);
        const float inv = 1.0f / lrun;
        bf16_t* Op = O + (rowbase + qt * 16 + fr) * D + h * HD + 4 * fq;
#pragma unroll
        for (int dt = 0; dt < 4; ++dt) { const f32x4 o = oacc[dt] * inv; u32x2 w; w.x = pk2(o.x, o.y); w.y = pk2(o.z, o.w); *(u32x2*)(Op + dt * 16) = w; }
    }
}

__device__ __forceinline__ void gla_pre(const bf16_t* q, const bf16_t* k, const float* Z, const float* wgu, const float* bgate, bf16_t* qe, bf16_t* ke, float* decay, int wg, int nwg, int tid) {
    const int c = tid, h = c >> 7, d = c & 127;
    for (int it = wg; it < BATCH * NCH * 2; it += nwg) {
        const int dir = it & 1, n = (it >> 1) & (NCH - 1), b = it >> 7;
        float w[RANK];
#pragma unroll
        for (int r = 0; r < RANK; ++r) w[r] = wgu[((size_t)dir * RANK + r) * GQK + c];
        const float bg = bgate[dir * GQK + c];
        float bsum = 0.f;
        bf16_t* qed = qe + (size_t)dir * M * GQK; bf16_t* ked = ke + (size_t)dir * M * GQK;
        for (int s = 0; s < CH; ++s) {
            const int i = dir == 0 ? s : (CH - 1 - s);
            const size_t tok = (size_t)b * SEQ + n * CH + i;
            const f32x4* zp = (const f32x4*)(Z + tok * 64 + dir * RANK);
            const f32x4 z0 = zp[0], z1 = zp[1], z2 = zp[2], z3 = zp[3];
            float logit = bg;
            logit += z0.x * w[0] + z0.y * w[1] + z0.z * w[2] + z0.w * w[3];
            logit += z1.x * w[4] + z1.y * w[5] + z1.z * w[6] + z1.w * w[7];
            logit += z2.x * w[8] + z2.y * w[9] + z2.z * w[10] + z2.w * w[11];
            logit += z3.x * w[12] + z3.y * w[13] + z3.z * w[14] + z3.w * w[15];
            const float lg = (fminf(logit, 0.f) - log1pf(expf(-fabsf(logit)))) * (1.0f / 16.0f);
            bsum += lg;
            const float eb = expf(bsum), enb = expf(-bsum);
            qed[tok * GQK + c] = (bf16_t)f2bf(bf2f(q[tok * GQK + c]) * eb);
            ked[tok * GQK + c] = (bf16_t)f2bf(bf2f(k[tok * GQK + c]) * enb);
        }
        decay[((((size_t)b * GH + h) * 2 + dir) * NCH + n) * GDK + d] = expf(bsum);
    }
}


__device__ __forceinline__ void gla_pre2(const bf16_t* __restrict__ XB, const bf16_t* __restrict__ Wz, const float* __restrict__ ssq, const bf16_t* __restrict__ q, const bf16_t* __restrict__ k,
                                         const float* __restrict__ wgu, const float* __restrict__ bgate, bf16_t* __restrict__ qe, bf16_t* __restrict__ ke, float* __restrict__ decay,
                                         LAS unsigned char* lds, int wg, int nwg, const int tid) {
    const int lane = tid & 63, wave = __builtin_amdgcn_readfirstlane(tid >> 6), fr = lane & 15, fq = lane >> 4;
    LAS float* part = (LAS float*)lds;
    LAS float* zL = part + 8 * 8 * 256;
    LAS float* rsL = zL + 64 * 32;
    for (int it = wg; it < BATCH * NCH; it += nwg) {
        const int b = it >> 6, n = it & 63; const size_t tok0 = (size_t)b * SEQ + (size_t)n * CH;
        {
            bf16x8 af[4][4], bz[2][4];
#pragma unroll
            for (int tt = 0; tt < 4; ++tt)
#pragma unroll
                for (int ks = 0; ks < 4; ++ks) af[tt][ks] = *(const bf16x8*)(XB + (tok0 + 16 * tt + fr) * D + 128 * wave + 32 * ks + 8 * fq);
#pragma unroll
            for (int zt = 0; zt < 2; ++zt)
#pragma unroll
                for (int ks = 0; ks < 4; ++ks) bz[zt][ks] = *(const bf16x8*)(Wz + (size_t)(16 * zt + fr) * D + 128 * wave + 32 * ks + 8 * fq);
            if (tid < 64) rsL[tid] = rstd_from_slots(ssq, (int)tok0 + tid);
#pragma unroll
            for (int tt = 0; tt < 4; ++tt)
#pragma unroll
                for (int zt = 0; zt < 2; ++zt) { f32x4 acc = (f32x4){0.f, 0.f, 0.f, 0.f};
#pragma unroll
                    for (int ks = 0; ks < 4; ++ks) acc = __builtin_amdgcn_mfma_f32_16x16x32_bf16(bz[zt][ks], af[tt][ks], acc, 0, 0, 0);
                    *(LAS f32x4*)(part + ((wave * 8 + tt * 2 + zt) * 64 + lane) * 4) = acc; }
        }
        __syncthreads();
        {   const int tile = tid >> 6, l = tid & 63; f32x4 s = (f32x4){0.f, 0.f, 0.f, 0.f};
#pragma unroll
            for (int w = 0; w < 8; ++w) s += *(const LAS f32x4*)(part + ((w * 8 + tile) * 64 + l) * 4);
            const int tok = 16 * (tile >> 1) + (l & 15), zc = 16 * (tile & 1) + 4 * (l >> 4);
            *(LAS f32x4*)(zL + tok * 32 + zc) = s * rsL[tok]; }
        __syncthreads();
        {
            const int dir = tid >> 8, c = 2 * (tid & 255), h = c >> 7, d = c & 127;
            float w0[RANK], w1[RANK];
#pragma unroll
            for (int r = 0; r < RANK; ++r) { const f32x2 w = *(const f32x2*)(wgu + ((size_t)dir * RANK + r) * GQK + c); w0[r] = w.x; w1[r] = w.y; }
            const f32x2 bg = *(const f32x2*)(bgate + dir * GQK + c);
            float bs0 = 0.f, bs1 = 0.f;
            bf16_t* qed = qe + (size_t)dir * M * GQK + c; bf16_t* ked = ke + (size_t)dir * M * GQK + c;
            for (int bt = 0; bt < 4; ++bt) {
                unsigned qv[16], kv[16];
#pragma unroll
                for (int j = 0; j < 16; ++j) { const int i = dir == 0 ? 16 * bt + j : CH - 1 - (16 * bt + j);
                    qv[j] = *(const unsigned*)(q + (tok0 + i) * GQK + c); kv[j] = *(const unsigned*)(k + (tok0 + i) * GQK + c); }
#pragma unroll
                for (int j = 0; j < 16; ++j) { const int i = dir == 0 ? 16 * bt + j : CH - 1 - (16 * bt + j);
                    const LAS f32x4* zp = (const LAS f32x4*)(zL + i * 32 + dir * RANK);
                    const f32x4 z0 = zp[0], z1 = zp[1], z2 = zp[2], z3 = zp[3];
                    float l0 = bg.x, l1 = bg.y;
                    l0 += z0.x * w0[0] + z0.y * w0[1] + z0.z * w0[2] + z0.w * w0[3]; l1 += z0.x * w1[0] + z0.y * w1[1] + z0.z * w1[2] + z0.w * w1[3];
                    l0 += z1.x * w0[4] + z1.y * w0[5] + z1.z * w0[6] + z1.w * w0[7]; l1 += z1.x * w1[4] + z1.y * w1[5] + z1.z * w1[6] + z1.w * w1[7];
                    l0 += z2.x * w0[8] + z2.y * w0[9] + z2.z * w0[10] + z2.w * w0[11]; l1 += z2.x * w1[8] + z2.y * w1[9] + z2.z * w1[10] + z2.w * w1[11];
                    l0 += z3.x * w0[12] + z3.y * w0[13] + z3.z * w0[14] + z3.w * w0[15]; l1 += z3.x * w1[12] + z3.y * w1[13] + z3.z * w1[14] + z3.w * w1[15];
                    const float t0 = __builtin_amdgcn_exp2f(-l0 * 1.4426950408889634f), t1 = __builtin_amdgcn_exp2f(-l1 * 1.4426950408889634f);
                    bs0 -= __builtin_amdgcn_logf(1.0f + t0) * (0.6931471805599453f / 16.0f); bs1 -= __builtin_amdgcn_logf(1.0f + t1) * (0.6931471805599453f / 16.0f);
                    const float e0 = __builtin_amdgcn_exp2f(bs0 * 1.4426950408889634f), e1 = __builtin_amdgcn_exp2f(bs1 * 1.4426950408889634f);
                    const float n0 = __builtin_amdgcn_rcpf(e0), n1 = __builtin_amdgcn_rcpf(e1);
                    *(unsigned*)(qed + (tok0 + i) * GQK) = pk2(bflo(qv[j]) * e0, bfhi(qv[j]) * e1);
                    *(unsigned*)(ked + (tok0 + i) * GQK) = pk2(bflo(kv[j]) * n0, bfhi(kv[j]) * n1); }
            }
            *(f32x2*)(decay + ((((size_t)b * GH + h) * 2 + dir) * NCH + n) * GDK + d) = (f32x2){__builtin_amdgcn_exp2f(bs0 * 1.4426950408889634f), __builtin_amdgcn_exp2f(bs1 * 1.4426950408889634f)};
        }
        __syncthreads();
    }
}

__device__ __forceinline__ void gla_scan_simple(const bf16_t* qe, const bf16_t* ke, const bf16_t* v, const float* decay, bf16_t* of, bf16_t* ob, LAS unsigned char* lds, int wg, int nwg, int tid) {
    LAS float* qeL = (LAS float*)lds;
    LAS float* keL = qeL + 64 * 129;
    LAS float* vL = keL + 64 * 129;
    LAS float* AL = vL + 64 * 33;
    LAS float* SL = AL + 64 * 65;
    LAS float* dL = SL + 128 * 33;
    for (int it = wg; it < BATCH * GH * 2 * 8; it += nwg) {
        const int js = it & 7, dir = (it >> 3) & 1, h = (it >> 4) & 3, b = it >> 6;
        const bf16_t* qed = qe + (size_t)dir * M * GQK; const bf16_t* ked = ke + (size_t)dir * M * GQK;
        bf16_t* od = dir == 0 ? of : ob;
        for (int e = tid; e < 128 * 33; e += NTHREADS) SL[e] = 0.f;
        __syncthreads();
        for (int st = 0; st < NCH; ++st) {
            const int n = dir == 0 ? st : (NCH - 1 - st);
            const size_t tok0 = (size_t)b * SEQ + n * CH;
            {
                const int i = tid >> 3, ds = (tid & 7) * 16;
                const u32x4* qp = (const u32x4*)(qed + (tok0 + i) * GQK + h * GDK + ds);
                const u32x4* kp = (const u32x4*)(ked + (tok0 + i) * GQK + h * GDK + ds);
#pragma unroll
                for (int hh = 0; hh < 2; ++hh) { const u32x4 a = qp[hh], c = kp[hh];
#pragma unroll
                    for (int j = 0; j < 4; ++j) { qeL[i * 129 + ds + hh * 8 + 2 * j] = bflo(a[j]); qeL[i * 129 + ds + hh * 8 + 2 * j + 1] = bfhi(a[j]);
                                                  keL[i * 129 + ds + hh * 8 + 2 * j] = bflo(c[j]); keL[i * 129 + ds + hh * 8 + 2 * j + 1] = bfhi(c[j]); } }
                if (tid < 256) { const int iv = tid >> 2, vs = (tid & 3) * 8;
                    const u32x4 a = *(const u32x4*)(v + (tok0 + iv) * GV + h * GDV + js * 32 + vs);
#pragma unroll
                    for (int j = 0; j < 4; ++j) { vL[iv * 33 + vs + 2 * j] = bflo(a[j]); vL[iv * 33 + vs + 2 * j + 1] = bfhi(a[j]); } }
                if (tid < 128) dL[tid] = decay[((((size_t)b * GH + h) * 2 + dir) * NCH + n) * GDK + tid];
            }
            __syncthreads();
            {
                const int i = tid >> 3, jg = tid & 7;
                float a[8];
#pragma unroll
                for (int e = 0; e < 8; ++e) a[e] = 0.f;
                for (int d = 0; d < GDK; ++d) { const float qv = qeL[i * 129 + d];
#pragma unroll
                    for (int e = 0; e < 8; ++e) a[e] += qv * keL[(jg + 8 * e) * 129 + d]; }
#pragma unroll
                for (int e = 0; e < 8; ++e) { const int j = jg + 8 * e; const bool keep = dir == 0 ? (j <= i) : (j >= i); AL[i * 65 + j] = keep ? a[e] : 0.f; }
            }
            __syncthreads();
            {
                const int i = tid >> 3, vg = (tid & 7) * 4;
                float o[4] = {0.f, 0.f, 0.f, 0.f};
                for (int j = 0; j < CH; ++j) { const float a = AL[i * 65 + j];
#pragma unroll
                    for (int e = 0; e < 4; ++e) o[e] += a * vL[j * 33 + vg + e]; }
                for (int d = 0; d < GDK; ++d) { const float qv = qeL[i * 129 + d];
#pragma unroll
                    for (int e = 0; e < 4; ++e) o[e] += qv * SL[d * 33 + vg + e]; }
                u32x2 w; w.x = pk2(o[0], o[1]); w.y = pk2(o[2], o[3]);
                *(u32x2*)(od + (tok0 + i) * GV + h * GDV + js * 32 + vg) = w;
            }
            __syncthreads();
            {
                const int d = tid >> 2, vg = (tid & 3) * 8;
                float s[8];
#pragma unroll
                for (int e = 0; e < 8; ++e) s[e] = SL[d * 33 + vg + e];
                for (int j = 0; j < CH; ++j) { const float kv = keL[j * 129 + d];
#pragma unroll
                    for (int e = 0; e < 8; ++e) s[e] += kv * vL[j * 33 + vg + e]; }
                const float dc = dL[d];
#pragma unroll
                for (int e = 0; e < 8; ++e) SL[d * 33 + vg + e] = dc * s[e];
            }
            __syncthreads();
        }
    }
}


typedef short s16x4 __attribute__((ext_vector_type(4)));
__device__ __forceinline__ s16x4 ds_tr16(const LAS unsigned char* p) { return __builtin_amdgcn_ds_read_tr16_b64_v4i16((LAS s16x4*)p); }
__device__ __forceinline__ bf16x8 cat8(s16x4 lo, s16x4 hi) { return (bf16x8){lo[0], lo[1], lo[2], lo[3], hi[0], hi[1], hi[2], hi[3]}; }
constexpr int GS_QSTR = 272, GS_VSTR = 80;
constexpr int GS_QE = 0, GS_KE = 64 * GS_QSTR, GS_V = 2 * 64 * GS_QSTR, GS_BUF = GS_V + 64 * GS_VSTR;
constexpr int GS_ST = 2 * GS_BUF, GS_STB = 32 * GS_QSTR;
static_assert(GS_ST + 2 * GS_STB <= RING_BYTES, "GLA scan LDS");
__device__ __forceinline__ void gs_step_body(LAS unsigned char* lds, const int cur, const int dir, const int n, const int b, const int tb, const int c, const int T0, const int fr, const int fq,
                                             const int trq, const int trp, bf16_t* od, f32x4& S0, f32x4& S1, const f32x4 (&dcur)[2]) {
            const LAS unsigned char* Bq = lds + cur * GS_BUF + GS_QE; const LAS unsigned char* Bk = lds + cur * GS_BUF + GS_KE; const LAS unsigned char* Bv = lds + cur * GS_BUF + GS_V;
            const LAS unsigned char* St = lds + GS_ST + cur * GS_STB; LAS unsigned char* Stn = lds + GS_ST + (cur ^ 1) * GS_STB;
            bf16x8 qf[4];
#pragma unroll
            for (int ks = 0; ks < 4; ++ks) qf[ks] = *(const LAS bf16x8*)(Bq + (16 * tb + fr) * GS_QSTR + (32 * ks + 8 * fq) * 2);
            f32x4 at[4];
#pragma unroll
            for (int a = 0; a < 4; ++a) {
                f32x4 acc = (f32x4){0.f, 0.f, 0.f, 0.f};
                if (dir == 0 ? (a <= tb) : (a >= tb)) {
#pragma unroll
                    for (int ks = 0; ks < 4; ++ks) { const bf16x8 kf = *(const LAS bf16x8*)(Bk + (16 * a + fr) * GS_QSTR + (32 * ks + 8 * fq) * 2);
                        acc = __builtin_amdgcn_mfma_f32_16x16x32_bf16(kf, qf[ks], acc, 0, 0, 0); }
                    if (a == tb) {
#pragma unroll
                        for (int r = 0; r < 4; ++r) { const int tjl = 4 * fq + r; const bool keep = dir == 0 ? (tjl <= fr) : (tjl >= fr); acc[r] = keep ? acc[r] : 0.f; }
                    }
                }
                at[a] = acc;
            }
            bf16x8 vf[2];
#pragma unroll
            for (int ks = 0; ks < 2; ++ks) { const LAS unsigned char* p = Bv + (32 * ks + 4 * fq + trq) * GS_VSTR + (16 * c + 4 * trp) * 2;
                vf[ks] = cat8(ds_tr16(p), ds_tr16(p + 16 * GS_VSTR)); }
            f32x4 o = (f32x4){0.f, 0.f, 0.f, 0.f};
#pragma unroll
            for (int ks = 0; ks < 4; ++ks) { const bf16x8 sf = *(const LAS bf16x8*)(St + (16 * c + fr) * GS_QSTR + (32 * ks + 8 * fq) * 2);
                o = __builtin_amdgcn_mfma_f32_16x16x32_bf16(sf, qf[ks], o, 0, 0, 0); }
#pragma unroll
            for (int ks = 0; ks < 2; ++ks) { u32x4 w; w.x = pk2(at[2 * ks][0], at[2 * ks][1]); w.y = pk2(at[2 * ks][2], at[2 * ks][3]); w.z = pk2(at[2 * ks + 1][0], at[2 * ks + 1][1]); w.w = pk2(at[2 * ks + 1][2], at[2 * ks + 1][3]);
                o = __builtin_amdgcn_mfma_f32_16x16x32_bf16(vf[ks], __builtin_bit_cast(bf16x8, w), o, 0, 0, 0); }
            { u32x2 w; w.x = pk2(o[0], o[1]); w.y = pk2(o[2], o[3]);
              *(u32x2*)(od + ((size_t)b * SEQ + (size_t)n * CH + 16 * tb + fr) * GV + 16 * c + 4 * fq) = w; }
#pragma unroll
            for (int ks = 0; ks < 2; ++ks) {
                const LAS unsigned char* p0 = Bk + (32 * ks + 4 * fq + trq) * GS_QSTR + (16 * T0 + 4 * trp) * 2;
                const bf16x8 k0 = cat8(ds_tr16(p0), ds_tr16(p0 + 16 * GS_QSTR));
                const bf16x8 k1 = cat8(ds_tr16(p0 + 32), ds_tr16(p0 + 32 + 16 * GS_QSTR));
                S0 = __builtin_amdgcn_mfma_f32_16x16x32_bf16(k0, vf[ks], S0, 0, 0, 0);
                S1 = __builtin_amdgcn_mfma_f32_16x16x32_bf16(k1, vf[ks], S1, 0, 0, 0);
            }
            S0 = S0 * dcur[0]; S1 = S1 * dcur[1];
            { u32x2 w0, w1; w0.x = pk2(S0[0], S0[1]); w0.y = pk2(S0[2], S0[3]); w1.x = pk2(S1[0], S1[1]); w1.y = pk2(S1[2], S1[3]);
              *(LAS u32x2*)(Stn + (16 * c + fr) * GS_QSTR + (16 * T0 + 4 * fq) * 2) = w0; *(LAS u32x2*)(Stn + (16 * c + fr) * GS_QSTR + (16 * T0 + 16 + 4 * fq) * 2) = w1; }
}
__device__ __forceinline__ void gla_scan_mfma(const bf16_t* qe, const bf16_t* ke, const bf16_t* v, const float* decay, bf16_t* of, bf16_t* ob, LAS unsigned char* lds, int wg, int nwg, const int tid) {
    const int lane = tid & 63, wave = __builtin_amdgcn_readfirstlane(tid >> 6), fr = lane & 15, fq = lane >> 4;
    const int tb = wave >> 1, c = wave & 1, T0 = 2 * (wave >> 1);
    const int trq = (lane & 15) >> 2, trp = lane & 3;
    const int vwg = (nwg % 8 == 0) ? (wg % 8) * (nwg / 8) + wg / 8 : wg;
    for (int it = vwg; it < BATCH * GH * 2 * 8; it += nwg) {
        const int js = it & 7, dir = (it >> 3) & 1, h = (it >> 4) & 3, b = it >> 6;
        const bf16_t* qed = qe + (size_t)dir * M * GQK + h * GDK; const bf16_t* ked = ke + (size_t)dir * M * GQK + h * GDK;
        const bf16_t* vd = v + h * GDV + js * 32;
        bf16_t* od = (dir == 0 ? of : ob) + h * GDV + js * 32;
        const float* decp = decay + ((((size_t)b * GH + h) * 2 + dir) * NCH) * GDK;
        f32x4 S0 = (f32x4){0.f, 0.f, 0.f, 0.f}, S1 = (f32x4){0.f, 0.f, 0.f, 0.f};
        u32x4 lqA[2], lkA[2], lvA = (u32x4){0u, 0u, 0u, 0u}, lqB[2], lkB[2], lvB = (u32x4){0u, 0u, 0u, 0u}; f32x4 dcur[2], dnA[2], dnB[2];
#define GS_ISSUE(n_, LQ, LK, LV, DN) do { const size_t tok0_ = (size_t)b * SEQ + (size_t)(n_) * CH; \
            _Pragma("unroll") for (int i_ = 0; i_ < 2; ++i_) { const size_t r_ = tok0_ + (tid >> 4) + 32 * i_; \
                LQ[i_] = *(const u32x4*)(qed + r_ * GQK + (tid & 15) * 8); LK[i_] = *(const u32x4*)(ked + r_ * GQK + (tid & 15) * 8); } \
            if (tid < 256) LV = *(const u32x4*)(vd + (tok0_ + (tid >> 2)) * GV + (tid & 3) * 8); \
            DN[0] = *(const f32x4*)(decp + (size_t)(n_) * GDK + 16 * T0 + 4 * fq); DN[1] = *(const f32x4*)(decp + (size_t)(n_) * GDK + 16 * T0 + 16 + 4 * fq); } while (0)
#define GS_COMMIT(buf_, LQ, LK, LV, DN) do { LAS unsigned char* B_ = lds + (buf_) * GS_BUF; \
            _Pragma("unroll") for (int i_ = 0; i_ < 2; ++i_) { const int r_ = (tid >> 4) + 32 * i_; \
                *(LAS u32x4*)(B_ + GS_QE + r_ * GS_QSTR + (tid & 15) * 16) = LQ[i_]; *(LAS u32x4*)(B_ + GS_KE + r_ * GS_QSTR + (tid & 15) * 16) = LK[i_]; } \
            if (tid < 256) *(LAS u32x4*)(B_ + GS_V + (tid >> 2) * GS_VSTR + (tid & 3) * 16) = LV; dcur[0] = DN[0]; dcur[1] = DN[1]; } while (0)
#define GS_CHUNK(s_) (dir == 0 ? (s_) : NCH - 1 - (s_))
        for (int e = tid; e < GS_STB / 16; e += NTHREADS) *(LAS u32x4*)(lds + GS_ST + e * 16) = (u32x4){0u, 0u, 0u, 0u};
        GS_ISSUE(GS_CHUNK(0), lqA, lkA, lvA, dnA); GS_COMMIT(0, lqA, lkA, lvA, dnA); GS_ISSUE(GS_CHUNK(1), lqB, lkB, lvB, dnB);
#define GS_STEP(s_, cur, LQI, LKI, LVI, DNI, LQC, LKC, LVC, DNC) do { const int s = (s_); const int n = GS_CHUNK(s); \
            asm volatile("s_waitcnt lgkmcnt(0)" ::: "memory"); __builtin_amdgcn_s_barrier(); asm volatile("" ::: "memory"); \
            if (s + 2 < NCH) GS_ISSUE(GS_CHUNK(s + 2), LQI, LKI, LVI, DNI); \
            gs_step_body(lds, cur, dir, n, b, tb, c, T0, fr, fq, trq, trp, od, S0, S1, dcur); \
            if (s + 1 < NCH) GS_COMMIT((cur) ^ 1, LQC, LKC, LVC, DNC); } while (0)
        for (int s2 = 0; s2 < NCH; s2 += 2) {
            GS_STEP(s2, 0, lqA, lkA, lvA, dnA, lqB, lkB, lvB, dnB);
            GS_STEP(s2 + 1, 1, lqB, lkB, lvB, dnB, lqA, lkA, lvA, dnA);
        }
        asm volatile("s_waitcnt lgkmcnt(0)" ::: "memory"); __builtin_amdgcn_s_barrier(); asm volatile("" ::: "memory");
#undef GS_ISSUE
#undef GS_COMMIT
#undef GS_CHUNK
#undef GS_STEP
    }
}

__device__ __forceinline__ void gla_combine(const bf16_t* of, const bf16_t* ob, const bf16_t* r, const float* og, bf16_t* Gout, int gw, int ngw, int lane) {
    for (int row = gw; row < M; row += ngw) {
        const size_t off = (size_t)row * GV + lane * 16;
        const u32x4 a0 = *(const u32x4*)(of + off), a1 = *(const u32x4*)(of + off + 8);
        const u32x4 b0 = *(const u32x4*)(ob + off), b1 = *(const u32x4*)(ob + off + 8);
        const u32x4 r0 = *(const u32x4*)(r + off), r1 = *(const u32x4*)(r + off + 8);
        float o[16], rr[16];
#pragma unroll
        for (int j = 0; j < 4; ++j) { o[2 * j] = bflo(a0[j]) + bflo(b0[j]); o[2 * j + 1] = bfhi(a0[j]) + bfhi(b0[j]); o[8 + 2 * j] = bflo(a1[j]) + bflo(b1[j]); o[8 + 2 * j + 1] = bfhi(a1[j]) + bfhi(b1[j]);
            rr[2 * j] = bflo(r0[j]); rr[2 * j + 1] = bfhi(r0[j]); rr[8 + 2 * j] = bflo(r1[j]); rr[8 + 2 * j + 1] = bfhi(r1[j]); }
        float ss = 0.f;
#pragma unroll
        for (int j = 0; j < 16; ++j) ss += o[j] * o[j];
        ss += __shfl_xor(ss, 1); ss += __shfl_xor(ss, 2); ss += __shfl_xor(ss, 4); ss += __shfl_xor(ss, 8);
        const float rs = 1.0f / sqrtf(ss * (1.0f / GDV) + EPS);
        const int dv0 = (lane & 15) * 16;
        float g[16];
#pragma unroll
        for (int j = 0; j < 16; ++j) { const float y = o[j] * rs * og[dv0 + j]; const float x = rr[j]; g[j] = y * x / (1.0f + __expf(-x)); }
        u32x4 w0, w1;
#pragma unroll
        for (int j = 0; j < 4; ++j) { w0[j] = pk2(g[2 * j], g[2 * j + 1]); w1[j] = pk2(g[8 + 2 * j], g[8 + 2 * j + 1]); }
        *(u32x4*)(Gout + off) = w0; *(u32x4*)(Gout + off + 8) = w1;
    }
}

struct Args { const float* in[15]; float* out; unsigned char* ws; int ph_lo, ph_hi; };
static_assert(sizeof(Args) == 15 * 8 + 8 + 8 + 8, "Args has no padding");

__global__ void __launch_bounds__(NTHREADS, 2) fwd_kernel(Args args) {
    extern __shared__ __attribute__((aligned(16))) unsigned char lds_raw[];
    LAS unsigned char* lds = (LAS unsigned char*)lds_raw;
    const int tid0 = threadIdx.x;
#define KARG_BASE() const __attribute__((address_space(4))) unsigned char* ka_ = (const __attribute__((address_space(4))) unsigned char*)__builtin_amdgcn_kernarg_segment_ptr(); asm volatile("" : "+s"(ka_))
#define IN_PTR(i) (*(const float* const __attribute__((address_space(4)))*)(ka_ + 8 * (i)))
#define OUT_PTR() (*(float* const __attribute__((address_space(4)))*)(ka_ + 8 * 15))
#define WS_PTR() (*(unsigned char* const __attribute__((address_space(4)))*)(ka_ + 8 * 16))
#define WSP(T, off) ((T*)(ws + (off)))
    for (int u = tid0; u < (LDS_BYTES - LDSCTL_OFF) / 4; u += NTHREADS) ((LAS unsigned*)(lds + LDSCTL_OFF))[u] = 0u;
    __syncthreads();
    volatile LAS unsigned* MISC = (volatile LAS unsigned*)(lds + MISC_OFF);
    const int lo = args.ph_lo, hi = args.ph_hi;
    const bool multi = (hi - lo) > 1;
    XcdBarrier bar; bar.bar = (unsigned*)(args.ws + WS_CTL) + 4096; bar.x = 0; bar.st = nullptr;
    if (multi) bar = xcd_barrier_post((unsigned*)(args.ws + WS_CTL) + 4096, MISC + 8);
#ifndef FAST_GEMM
#define FAST_GEMM 15
#endif
    bool rep_done = false;
    for (int ph = lo; ph < hi; ++ph) {
        int tid = threadIdx.x; asm volatile("" : "+v"(tid));
        int wg = blockIdx.x, G = gridDim.x; asm volatile("" : "+s"(wg), "+s"(G));
        const int lane = tid & 63, wave = __builtin_amdgcn_readfirstlane(tid >> 6);
        const int gw = wg * NWAVES + wave, ngw = G * NWAVES;
        switch (ph) {
        case 0: {
            KARG_BASE(); unsigned char* ws = WS_PTR();
            const float* x = IN_PTR(0); const float* norm_mix = IN_PTR(1); const float* attn_w_qkv = IN_PTR(3); const float* attn_w_o = IN_PTR(6);
            bf16_t* Wqkv = WSP(bf16_t, W_QKV); bf16_t* Wo0 = WSP(bf16_t, W_O0); bf16_t* Wgin = WSP(bf16_t, W_GIN);
            bf16_t* XB = WSP(bf16_t, WS_XB); float* SSQ0 = WSP(float, WS_SSQ); f32x2* ROPE = WSP(f32x2, WS_ROPE);
            LAS float* scr = (LAS float*)(lds + wave * 16384);
            constexpr int I_QKV = 16 * 48, I_O = 16 * 32;
            for (int it = gw; it < I_QKV + I_O; it += ngw) {
                if (it < I_QKV) transpose_item(attn_w_qkv, norm_mix, D, QKV_N, Wqkv, scr, it, lane);
                else transpose_item(attn_w_o, nullptr, D, D, Wo0, scr, it - I_QKV, lane);
            }
            for (int e = gw * 64 + lane; e < 32 * D / 8; e += ngw * 64) *(u32x4*)(Wgin + (size_t)GIN * D + (size_t)e * 8) = (u32x4){0u, 0u, 0u, 0u};
            for (int m = gw; m < M; m += ngw) {
                const f32x4* xr = (const f32x4*)(x + (size_t)m * D) + lane;
                f32x4 v[4]; float s = 0.f;
#pragma unroll
                for (int j = 0; j < 4; ++j) { v[j] = xr[64 * j]; s += (v[j].x * v[j].x + v[j].y * v[j].y) + (v[j].z * v[j].z + v[j].w * v[j].w); }
                s = wave_sum(s);
                u32x2* o8 = (u32x2*)(XB + (size_t)m * D) + lane;
#pragma unroll
                for (int j = 0; j < 4; ++j) { u32x2 w; w.x = pk2(v[j].x, v[j].y); w.y = pk2(v[j].z, v[j].w); o8[64 * j] = w; }
                if (lane < 16) SSQ0[(size_t)m * 16 + lane] = lane == 0 ? s : 0.f;
            }
            if (wg == 0) {
                for (int e = tid; e < 64 * 16; e += NTHREADS) {
                    const int pos = e >> 4, i = e & 15;
                    double invd = (i & 3) == 0 ? 1.0 : (i & 3) == 1 ? 0.56234132519034908 : (i & 3) == 2 ? 0.31622776601683794 : 0.17782794100389228;
                    invd *= (i >> 2) == 0 ? 1.0 : (i >> 2) == 1 ? 0.1 : (i >> 2) == 2 ? 0.01 : 0.001;
                    const float invf = (float)invd; const float ang = (float)pos * invf;
                    double s, c; sincos_d((double)ang, s, c);
                    ROPE[e] = (f32x2){(float)c, (float)s};
                }
            }
        } break;
        case 1: {
            KARG_BASE(); unsigned char* ws = WS_PTR(); const float* attn_qn = IN_PTR(4); const float* attn_kn = IN_PTR(5);
            const bf16_t* XB = WSP(bf16_t, WS_XB); const bf16_t* Wqkv = WSP(bf16_t, W_QKV); const float* SSQ0 = WSP(float, WS_SSQ); const f32x2* ROPE = WSP(f32x2, WS_ROPE);
            bf16_t* Qb = WSP(bf16_t, WS_BIG); bf16_t* Kb = WSP(bf16_t, WS_BIG + 32 * MiB); bf16_t* Vb = WSP(bf16_t, WS_BIG + 40 * MiB);
            if (FAST_GEMM & 1) { pg8::Gemm g{XB, Wqkv, M, QKV_N, D}; pg8::StaticOrder S; S.init(M, QKV_N, G, wg);
                pg8::EpiQKV8 E{SSQ0, attn_qn, attn_kn, ROPE, Qb, Kb, Vb};
                pg8::gemm_phase<pg8::EpiQKV8, pg8::StaticOrder, true, true>(lds, g, S, E, tid); }
            else { EpiQKV E{SSQ0, attn_qn, attn_kn, ROPE, Qb, Kb, Vb}; gemm_simple(XB, Wqkv, M, QKV_N, D, E, gw, ngw, lane); }
            {
                const int nun = (M / 256) * (QKV_N / 256), maxu = (nun + G - 1) / G, c0 = (nun % G == 0) ? 0 : nun - (maxu - 1) * G, nlight = G - c0;
                if (wg >= c0) {
                    const float* norm_mix = IN_PTR(1); const float* norm_mlp = IN_PTR(2); const float* gla_w_in = IN_PTR(7); const float* gla_w_o = IN_PTR(11); const float* mlp_w_in = IN_PTR(12); const float* mlp_w_out = IN_PTR(13);
                    bf16_t* W1a = WSP(bf16_t, W_1A); bf16_t* W2a = WSP(bf16_t, W_2A); bf16_t* Wgin = WSP(bf16_t, W_GIN); bf16_t* Wo1 = WSP(bf16_t, W_O1); bf16_t* W1b = WSP(bf16_t, W_1B); bf16_t* W2b = WSP(bf16_t, W_2B);
                    LAS float* scr = (LAS float*)(lds + wave * 16384);
                    constexpr int I_O = 16 * 32, I_1 = 16 * 128, I_2 = 64 * 32, I_GIN = 16 * 97, NITEMS = I_1 + I_2 + I_GIN + I_O + I_1 + I_2;
                    for (int it = (wg - c0) * NWAVES + wave; it < NITEMS; it += nlight * NWAVES) {
                        int r = it;
                        if (r < I_1) { transpose_item(mlp_w_in, norm_mlp, D, FF, W1a, scr, r, lane); continue; } r -= I_1;
                        if (r < I_2) { transpose_item(mlp_w_out, nullptr, FF, D, W2a, scr, r, lane); continue; } r -= I_2;
                        if (r < I_GIN) { transpose_item(gla_w_in, norm_mix + D, D, GIN, Wgin, scr, r, lane); continue; } r -= I_GIN;
                        if (r < I_O) { transpose_item(gla_w_o, nullptr, D, D, Wo1, scr, r, lane); continue; } r -= I_O;
                        if (r < I_1) { transpose_item(mlp_w_in + (size_t)D * FF, norm_mlp + D, D, FF, W1b, scr, r, lane); continue; } r -= I_1;
                        transpose_item(mlp_w_out + (size_t)FF * D, nullptr, FF, D, W2b, scr, r, lane);
                    }
                }
            }
        } break;
        case 2: {
            KARG_BASE(); unsigned char* ws = WS_PTR();
            bf16_t* Qb = WSP(bf16_t, WS_BIG); bf16_t* Kb = WSP(bf16_t, WS_BIG + 32 * MiB); bf16_t* Vb = WSP(bf16_t, WS_BIG + 40 * MiB);
#ifndef FAST_ATTN
#define FAST_ATTN 1
#endif
            if (FAST_ATTN) {
                const attn_body::AttnTensors AT{(const attn_body::bf16*)Qb, (const attn_body::bf16*)Kb, (const attn_body::bf16*)Vb, (attn_body::bf16*)WSP(bf16_t, WS_BIG + 48 * MiB)};
                const attn_body::StaticOrder S(G, wg);
                attn_body::attn_phase<attn_body::StaticOrder>((char*)lds_raw, AT, S, tid);
            } else attn_simple(Qb, Kb, Vb, WSP(bf16_t, WS_BIG + 48 * MiB), gw, ngw, lane);
        } break;
        case 3: case 5: case 10: case 12: {
            KARG_BASE(); unsigned char* ws = WS_PTR();
            const bf16_t* A = WSP(bf16_t, ph == 3 ? WS_BIG + 48 * MiB : ph == 10 ? WS_BIG + 64 * MiB : WS_BIG);
            const bf16_t* Bt = WSP(bf16_t, ph == 3 ? W_O0 : ph == 5 ? W_2A : ph == 10 ? W_O1 : W_2B);
            const int K = (ph == 3 || ph == 10) ? D : FF;
            const float* basef = ph == 3 ? IN_PTR(0) : nullptr;
            bf16_t* xb = WSP(bf16_t, WS_XB);
            float* ssq = WSP(float, WS_SSQ + (ph == 3 ? 1 : ph == 5 ? 2 : ph == 10 ? 3 : 4) * (size_t)M * 64);
            if (FAST_GEMM & 2) { pg8::Gemm g{A, Bt, M, D, K}; pg8::StaticOrder S; S.init(M, D, G, wg);
                pg8::EpiRes8 E{basef, xb, ssq};
                pg8::gemm_phase<pg8::EpiRes8, pg8::StaticOrder, true, true>(lds, g, S, E, tid); }
            else { EpiRes E{basef, xb, ssq}; gemm_simple(A, Bt, M, D, K, E, gw, ngw, lane); }
        } break;
        case 4: case 11: {
            KARG_BASE(); unsigned char* ws = WS_PTR();
            const bf16_t* XB = WSP(bf16_t, WS_XB); bf16_t* HB = WSP(bf16_t, WS_BIG);
            const bf16_t* Bt = WSP(bf16_t, ph == 4 ? W_1A : W_1B); const float* ssq = WSP(float, WS_SSQ + (ph == 4 ? 1 : 3) * (size_t)M * 64);
            if (FAST_GEMM & 4) { pg8::Gemm g{XB, Bt, M, FF, D}; pg8::StaticOrder S; S.init(M, FF, G, wg);
                pg8::EpiUp8 E{ssq, HB};
                pg8::gemm_phase<pg8::EpiUp8, pg8::StaticOrder, true, true>(lds, g, S, E, tid); }
            else { EpiUp E{ssq, HB}; gemm_simple(XB, Bt, M, FF, D, E, gw, ngw, lane); }
        } break;
        case 6: {
            KARG_BASE(); unsigned char* ws = WS_PTR();
            const bf16_t* XB = WSP(bf16_t, WS_XB); const bf16_t* Wgin = WSP(bf16_t, W_GIN); const float* SSQ2 = WSP(float, WS_SSQ + 2 * (size_t)M * 64); float* Zb = WSP(float, WS_Z);
            bf16_t* Gv = WSP(bf16_t, WS_BIG); bf16_t* Gr = WSP(bf16_t, WS_BIG + 32 * MiB); bf16_t* Gq = WSP(bf16_t, WS_QK); bf16_t* Gk = WSP(bf16_t, WS_QK + 16 * MiB);
            if (FAST_GEMM & 8) { pg8::Gemm g{XB, Wgin, M, 3072, D}; pg8::StaticOrder S; S.init(M, 3072, G, wg);
                pg8::EpiGin8 E{SSQ2, Gq, Gk, Gv, Gr};
                pg8::gemm_phase<pg8::EpiGin8, pg8::StaticOrder, true, true>(lds, g, S, E, tid); }
            else { EpiGin E{SSQ2, Gq, Gk, Gv, Gr}; gemm_simple(XB, Wgin, M, 3072, D, E, gw, ngw, lane); }
#ifndef FAST_PRE
#define FAST_PRE 1
#endif
            if (!FAST_PRE) { EpiZ Ez{SSQ2, Zb}; gemm_simple(XB, Wgin + (size_t)3072 * D, M, 64, D, Ez, gw, ngw, lane); }
        } break;
        case 7: {
            KARG_BASE(); unsigned char* ws = WS_PTR();
            if (FAST_PRE) gla_pre2(WSP(bf16_t, WS_XB), WSP(bf16_t, W_GIN) + (size_t)3072 * D, WSP(float, WS_SSQ + 2 * (size_t)M * 64), WSP(bf16_t, WS_QK), WSP(bf16_t, WS_QK + 16 * MiB), IN_PTR(8), IN_PTR(9), WSP(bf16_t, WS_BIG + 64 * MiB), WSP(bf16_t, WS_BIG + 96 * MiB), WSP(float, WS_DECAY), lds, wg, G, tid);
            else gla_pre(WSP(bf16_t, WS_QK), WSP(bf16_t, WS_QK + 16 * MiB), WSP(float, WS_Z), IN_PTR(8), IN_PTR(9), WSP(bf16_t, WS_BIG + 64 * MiB), WSP(bf16_t, WS_BIG + 96 * MiB), WSP(float, WS_DECAY), wg, G, tid);
        } break;
        case 8: {
            KARG_BASE(); unsigned char* ws = WS_PTR();
#ifndef FAST_SCAN
#define FAST_SCAN 1
#endif
            if (FAST_SCAN) gla_scan_mfma(WSP(bf16_t, WS_BIG + 64 * MiB), WSP(bf16_t, WS_BIG + 96 * MiB), WSP(bf16_t, WS_BIG), WSP(float, WS_DECAY), WSP(bf16_t, WS_QK), (bf16_t*)OUT_PTR(), lds, wg, G, tid);
            else gla_scan_simple(WSP(bf16_t, WS_BIG + 64 * MiB), WSP(bf16_t, WS_BIG + 96 * MiB), WSP(bf16_t, WS_BIG), WSP(float, WS_DECAY), WSP(bf16_t, WS_QK), (bf16_t*)OUT_PTR(), lds, wg, G, tid);
        } break;
        case 9: {
            KARG_BASE(); unsigned char* ws = WS_PTR();
            gla_combine(WSP(bf16_t, WS_QK), (const bf16_t*)OUT_PTR(), WSP(bf16_t, WS_BIG + 32 * MiB), IN_PTR(10), WSP(bf16_t, WS_BIG + 64 * MiB), gw, ngw, lane);
        } break;
        default: {
            KARG_BASE(); unsigned char* ws = WS_PTR(); float* out = OUT_PTR(); const float* final_norm = IN_PTR(14);
            const bf16_t* XB = WSP(bf16_t, WS_XB); const float* SSQ4 = WSP(float, WS_SSQ + 4 * (size_t)M * 64);
            f32x4 g[4];
#pragma unroll
            for (int j = 0; j < 4; ++j) g[j] = *((const f32x4*)final_norm + lane + 64 * j);
            for (int m = gw; m < M; m += ngw) {
                const float rs = rstd_from_slots(SSQ4, m);
                const u32x2* xr = (const u32x2*)(XB + (size_t)m * D) + lane;
                f32x4* orow = (f32x4*)(out + (size_t)m * D) + lane;
                u32x2 v[4];
#pragma unroll
                for (int j = 0; j < 4; ++j) v[j] = xr[64 * j];
#pragma unroll
                for (int j = 0; j < 4; ++j) orow[64 * j] = (f32x4){bflo(v[j].x), bfhi(v[j].x), bflo(v[j].y), bfhi(v[j].y)} * rs * g[j];
            }
        } break;
        }
#ifndef REPEAT_MASK
#define REPEAT_MASK 0
#endif
        if (REPEAT_MASK && ((REPEAT_MASK >> ph) & 1) && !rep_done) { rep_done = true; xcd_barrier(bar); --ph; continue; }
        rep_done = false;
        if (ph + 1 < hi) xcd_barrier(bar);
    }
}

#ifndef MK_SINGLE
#define MK_SINGLE 1
#endif
extern "C" void kernel_launch(void* const* d_in, const int* in_sizes, int n_in, void* d_out, int out_size, void* d_ws, size_t ws_size, hipStream_t stream) {
    static int grid = 0;
    if (grid == 0) {
        if (n_in != 15 || in_sizes[0] != M * D || out_size != M * D || ws_size < WS_END) { fprintf(stderr, "kernel_launch: unexpected shapes (n_in %d, in0 %d, out %d, ws %zu)\n", n_in, n_in > 0 ? in_sizes[0] : -1, out_size, ws_size); grid = -1; return; }
        int dev = 0, cus = 0, per_cu = 0;
        if (hipGetDevice(&dev) != hipSuccess || hipDeviceGetAttribute(&cus, hipDeviceAttributeMultiprocessorCount, dev) != hipSuccess) { grid = -1; return; }
        if (hipFuncSetAttribute((const void*)fwd_kernel, hipFuncAttributeMaxDynamicSharedMemorySize, LDS_BYTES) != hipSuccess) { fprintf(stderr, "kernel_launch: hipFuncSetAttribute failed\n"); grid = -1; return; }
        if (hipOccupancyMaxActiveBlocksPerMultiprocessor(&per_cu, (const void*)fwd_kernel, NTHREADS, LDS_BYTES) != hipSuccess || per_cu < 1) { fprintf(stderr, "kernel_launch: occupancy query says %d\n", per_cu); }
        (void)hipGetLastError();
        grid = cus;
    }
    if (grid < 0) return;
    (void)hipMemsetAsync((char*)d_ws + WS_CTL, 0, CTL_ZERO_BYTES, stream);
    Args a{};
    for (int i = 0; i < 15; ++i) a.in[i] = (const float*)d_in[i];
    a.out = (float*)d_out; a.ws = (unsigned char*)d_ws;
#if MK_SINGLE
    a.ph_lo = 0; a.ph_hi = NPHASES;
    hipLaunchKernelGGL(fwd_kernel, dim3(grid), dim3(NTHREADS), LDS_BYTES, stream, a);
#else
    for (int p = 0; p < NPHASES; ++p) { a.ph_lo = p; a.ph_hi = p + 1; hipLaunchKernelGGL(fwd_kernel, dim3(grid), dim3(NTHREADS), LDS_BYTES, stream, a); }
#endif
}
```
